# Optimizing an MI355X kernel written in HIP

```python
import math
import jax, jax.numpy as jnp
from jax import lax
import numpy as np

D_MODEL = 1024
BATCH = 2
SEQ = 8192
DEPTH = 1

HEAD_DIM = 64
NSA_HEADS = 8
NSA_KV_GROUPS = 2
NSA_HPG = NSA_HEADS // NSA_KV_GROUPS
FOX_HEADS = 8
CMP_LEN = 32
CMP_STRIDE = 16
SEL_LEN = 64
N_SEL = 16
WINDOW = 512
Q_BLOCK = 128
N_EXPERT_GROUPS = 4
EXPERTS_PER_GROUP = 8
N_EXPERTS = N_EXPERT_GROUPS * EXPERTS_PER_GROUP
EXPERT_TOP_K = 2
D_EXPERT = D_MODEL // 2
MOE_BLOCK = 128
NORM_EPS = 1e-6
NEG = -1e30
FORCE = 1e9

NSA_W = NSA_HEADS * HEAD_DIM
NSA_KV_W = NSA_KV_GROUPS * HEAD_DIM
FOX_W = FOX_HEADS * HEAD_DIM
IN_SIZES = (NSA_W, 6 * NSA_KV_W, 3 * NSA_HEADS, 3 * FOX_W, FOX_HEADS, 2 * D_MODEL)
D_IN = sum(IN_SIZES)
IN_SPLITS = tuple(int(v) for v in np.cumsum(IN_SIZES)[:-1])

kernel_name = "hybrid_nsa_fox_hmoe_block"


def rmsnorm(x, g):
    xf = x.astype(jnp.float32)
    y = xf * lax.rsqrt(jnp.mean(xf * xf, axis=-1, keepdims=True) + NORM_EPS)
    return (y * g.astype(jnp.float32)).astype(x.dtype)


def masked_softmax(logits, mask):
    l = jnp.where(mask, logits.astype(jnp.float32), NEG)
    m = jnp.max(l, axis=-1, keepdims=True)
    e = jnp.where(mask, jnp.exp(l - m), 0.0)
    return e / jnp.maximum(jnp.sum(e, axis=-1, keepdims=True), 1e-30)


def alibi_slopes(n):
    return jnp.exp2(-8.0 * jnp.arange(1, n + 1, dtype=jnp.float32) / n)


def compress_blocks(kv, pe, w1, w2):
    S = kv.shape[2]
    n_cmp = (S - CMP_LEN) // CMP_STRIDE + 1
    idx = jnp.arange(n_cmp)[:, None] * CMP_STRIDE + jnp.arange(CMP_LEN)[None, :]
    blocks = kv[:, :, idx] + pe
    hid = jax.nn.gelu(jnp.einsum('bgnld,lde->bgne', blocks, w1))
    return hid @ w2


def nsa_attention(q, k_cmp, v_cmp, k_slc, v_slc, k_win, v_win, gates,
                  pe_k, w1_k, w2_k, pe_v, w1_v, w2_v):
    B, S = q.shape[0], q.shape[1]
    G, HPG, dh = NSA_KV_GROUPS, NSA_HPG, HEAD_DIM
    n_cmp = (S - CMP_LEN) // CMP_STRIDE + 1
    n_slc = S // SEL_LEN
    n_sel = min(N_SEL, n_slc)
    scale = HEAD_DIM ** -0.5
    tr = lambda a: a.transpose(0, 2, 1, 3)
    kc = compress_blocks(tr(k_cmp), pe_k, w1_k, w2_k)
    vc = compress_blocks(tr(v_cmp), pe_v, w1_v, w2_v)
    cmp_start = jnp.arange(n_cmp) * CMP_STRIDE
    cmp_end = cmp_start + CMP_LEN - 1
    slc_start = jnp.arange(n_slc) * SEL_LEN
    overlap = ((cmp_start[:, None] < slc_start[None, :] + SEL_LEN)
               & (cmp_end[:, None] >= slc_start[None, :])).astype(jnp.float32)
    ks_blocks = tr(k_slc).reshape(B, G, n_slc, SEL_LEN * dh)
    vs_blocks = tr(v_slc).reshape(B, G, n_slc, SEL_LEN * dh)
    pad = ((0, 0), (0, 0), (WINDOW, 0), (0, 0))
    kw = jnp.pad(tr(k_win), pad)
    vw = jnp.pad(tr(v_win), pad)
    qg = q.reshape(B, S, G, HPG, dh).transpose(0, 2, 3, 1, 4)
    gt = gates.reshape(B, S, G, HPG, 3).transpose(0, 2, 3, 1, 4)
    slopes = alibi_slopes(NSA_HEADS).reshape(G, HPG)[None, :, :, None, None]
    j_idx = jnp.arange(n_slc)

    def block(i):
        q0 = i * Q_BLOCK
        qb = lax.dynamic_slice_in_dim(qg, q0, Q_BLOCK, axis=3)
        gb = lax.dynamic_slice_in_dim(gt, q0, Q_BLOCK, axis=3)
        t = q0 + jnp.arange(Q_BLOCK)
        dc = (t[:, None] - cmp_end[None, :]).astype(jnp.float32)
        lc = jnp.einsum('bghqd,bgnd->bghqn', qb, kc).astype(jnp.float32) * scale - slopes * dc
        pc = masked_softmax(lc, dc >= 0)
        oc = jnp.einsum('bghqn,bgnd->bghqd', pc.astype(vc.dtype), vc)
        imp = jnp.einsum('bghqn,nj->bgqj', pc, overlap)
        cur = (t // SEL_LEN)[:, None]
        forced = (j_idx[None] == 0) | (j_idx[None] == cur) | (j_idx[None] == cur - 1)
        imp = jnp.where(j_idx[None] > cur, -FORCE, jnp.where(forced, FORCE, imp))
        _, sel = lax.top_k(imp, n_sel)
        flat = sel.reshape(B, G, Q_BLOCK * n_sel, 1)
        ks = jnp.take_along_axis(ks_blocks, flat, axis=2).reshape(B, G, Q_BLOCK, n_sel * SEL_LEN, dh)
        vs = jnp.take_along_axis(vs_blocks, flat, axis=2).reshape(B, G, Q_BLOCK, n_sel * SEL_LEN, dh)
        pos = (sel[..., None] * SEL_LEN + jnp.arange(SEL_LEN)).reshape(B, G, Q_BLOCK, n_sel * SEL_LEN)
        ds = (t[:, None] - pos)[:, :, None]
        ls = jnp.einsum('bghqd,bgqkd->bghqk', qb, ks).astype(jnp.float32) * scale - slopes * ds.astype(jnp.float32)
        ps = masked_softmax(ls, ds >= 0)
        osel = jnp.einsum('bghqk,bgqkd->bghqd', ps.astype(vs.dtype), vs)
        kwb = lax.dynamic_slice_in_dim(kw, q0, WINDOW + Q_BLOCK, axis=2)
        vwb = lax.dynamic_slice_in_dim(vw, q0, WINDOW + Q_BLOCK, axis=2)
        s = q0 - WINDOW + jnp.arange(WINDOW + Q_BLOCK)
        dw = t[:, None] - s[None, :]
        mw = (dw >= 0) & (dw < WINDOW) & (s[None, :] >= 0)
        lw = jnp.einsum('bghqd,bgkd->bghqk', qb, kwb).astype(jnp.float32) * scale - slopes * dw.astype(jnp.float32)
        pw = masked_softmax(lw, mw)
        ow = jnp.einsum('bghqk,bgkd->bghqd', pw.astype(vwb.dtype), vwb)
        return gb[..., 0:1] * oc + gb[..., 1:2] * osel + gb[..., 2:3] * ow

    out = lax.map(block, jnp.arange(S // Q_BLOCK))
    return out.transpose(1, 0, 4, 2, 3, 5).reshape(B, S, NSA_W)


def forgetting_attention(q, k, v, f_logit):
    B, S = q.shape[0], q.shape[1]
    scale = HEAD_DIM ** -0.5
    F = jnp.cumsum(jax.nn.log_sigmoid(f_logit.astype(jnp.float32)), axis=1).transpose(0, 2, 1)
    qh, kh, vh = (a.transpose(0, 2, 1, 3) for a in (q, k, v))
    outs = []
    for i in range(S // Q_BLOCK):
        q0, kend = i * Q_BLOCK, (i + 1) * Q_BLOCK
        l = (jnp.einsum('bhqd,bhkd->bhqk', qh[:, :, q0:kend], kh[:, :, :kend]).astype(jnp.float32) * scale
             + F[:, :, q0:kend, None] - F[:, :, None, :kend])
        mask = jnp.arange(kend)[None, :] <= jnp.arange(q0, kend)[:, None]
        p = masked_softmax(l, mask)
        outs.append(jnp.einsum('bhqk,bhkd->bhqd', p.astype(vh.dtype), vh[:, :, :kend]))
    o = jnp.concatenate(outs, axis=2)
    return o.transpose(0, 2, 1, 3).reshape(B, S, FOX_W)


def hierarchical_moe(h, w_rg, b_rg, w_re, b_re, w_gate, w_up, w_down):
    T, D = h.shape
    pg = jax.nn.softmax((h @ w_rg + b_rg).astype(jnp.float32), axis=-1)
    pg_top, g_idx = lax.top_k(pg, 1)
    le = (h @ w_re + b_re).astype(jnp.float32).reshape(T, N_EXPERT_GROUPS, EXPERTS_PER_GROUP)
    le = jnp.take_along_axis(le, g_idx[:, :, None], axis=1)[:, 0]
    top_l, e_local = lax.top_k(le, EXPERT_TOP_K)
    weight = pg_top * jax.nn.softmax(top_l, axis=-1)
    expert = g_idx * EXPERTS_PER_GROUP + e_local
    A = T * EXPERT_TOP_K
    e_flat = expert.reshape(A)
    w_flat = weight.reshape(A)
    tok = jnp.arange(A, dtype=jnp.int32) // EXPERT_TOP_K
    order = jnp.argsort(e_flat)
    e_s, tok_s, w_s = e_flat[order], tok[order], w_flat[order]
    counts = jnp.bincount(e_flat, length=N_EXPERTS)
    padded = (counts + MOE_BLOCK - 1) // MOE_BLOCK * MOE_BLOCK
    pad_end = jnp.cumsum(padded)
    pad_start = pad_end - padded
    raw_start = jnp.cumsum(counts) - counts
    dest = pad_start[e_s] + jnp.arange(A) - raw_start[e_s]
    cap = -(-(A + N_EXPERTS * (MOE_BLOCK - 1)) // MOE_BLOCK) * MOE_BLOCK
    n_blocks = cap // MOE_BLOCK
    buf_tok = jnp.zeros((cap,), jnp.int32).at[dest].set(tok_s)
    buf_w = jnp.zeros((cap,), jnp.float32).at[dest].set(w_s)
    block_expert = jnp.minimum(jnp.searchsorted(pad_end, jnp.arange(n_blocks) * MOE_BLOCK, side='right'), N_EXPERTS - 1)
    xb = h[buf_tok].reshape(n_blocks, MOE_BLOCK, D)

    def expert_block(args):
        xe, e = args
        return (jax.nn.silu(xe @ w_gate[e]) * (xe @ w_up[e])) @ w_down[e]

    yb = lax.map(expert_block, (xb, block_expert)).reshape(cap, D)
    return jnp.zeros((T, D), h.dtype).at[buf_tok].add(yb * buf_w[:, None].astype(h.dtype))


def setup_inputs(seed: int = 0) -> dict:
    key = jax.random.key(seed)
    ks = jax.random.split(key, 26)
    f32 = jnp.float32
    L = DEPTH
    nrm = lambda k, shape, fan: jax.random.normal(k, shape, f32) * fan ** -0.5
    gain = lambda k: 1.0 + 0.05 * jax.random.normal(k, (L, D_MODEL), f32)
    return {
        "x": jax.random.normal(ks[0], (BATCH, SEQ, D_MODEL), f32),
        "c": jax.random.normal(ks[1], (BATCH, D_MODEL), f32),
        "w_ada": 0.5 * nrm(ks[2], (L, D_MODEL, 6 * D_MODEL), D_MODEL),
        "b_ada": 0.02 * jax.random.normal(ks[3], (L, 6 * D_MODEL), f32),
        "g_pre_mix": gain(ks[4]),
        "g_post_mix": gain(ks[5]),
        "g_pre_ffn": gain(ks[6]),
        "g_post_ffn": gain(ks[7]),
        "w_in": nrm(ks[8], (L, D_MODEL, D_IN), D_MODEL),
        "b_forget": jax.random.uniform(ks[9], (L, FOX_HEADS), f32, 1.0, 6.0),
        "cmp_pe_k": 0.1 * jax.random.normal(ks[10], (L, CMP_LEN, HEAD_DIM), f32),
        "cmp_w1_k": nrm(ks[11], (L, CMP_LEN, HEAD_DIM, HEAD_DIM), CMP_LEN * HEAD_DIM),
        "cmp_w2_k": nrm(ks[12], (L, HEAD_DIM, HEAD_DIM), HEAD_DIM),
        "cmp_pe_v": 0.1 * jax.random.normal(ks[13], (L, CMP_LEN, HEAD_DIM), f32),
        "cmp_w1_v": nrm(ks[14], (L, CMP_LEN, HEAD_DIM, HEAD_DIM), CMP_LEN * HEAD_DIM),
        "cmp_w2_v": nrm(ks[15], (L, HEAD_DIM, HEAD_DIM), HEAD_DIM),
        "w_o_nsa": nrm(ks[16], (L, NSA_W, D_MODEL), NSA_W),
        "w_o_fox": nrm(ks[17], (L, FOX_W, D_MODEL), FOX_W),
        "w_out": nrm(ks[18], (L, D_MODEL, D_MODEL), D_MODEL),
        "w_router_group": nrm(ks[19], (L, D_MODEL, N_EXPERT_GROUPS), D_MODEL),
        "b_router_group": 0.01 * jax.random.normal(ks[20], (L, N_EXPERT_GROUPS), f32),
        "w_router_expert": nrm(ks[21], (L, D_MODEL, N_EXPERTS), D_MODEL),
        "b_router_expert": 0.01 * jax.random.normal(ks[22], (L, N_EXPERTS), f32),
        "w_exp_gate": nrm(ks[23], (L, N_EXPERTS, D_MODEL, D_EXPERT), D_MODEL),
        "w_exp_up": nrm(ks[24], (L, N_EXPERTS, D_MODEL, D_EXPERT), D_MODEL),
        "w_exp_down": nrm(ks[25], (L, N_EXPERTS, D_EXPERT, D_MODEL), D_EXPERT),
    }


def reference(x, c, w_ada, b_ada, g_pre_mix, g_post_mix, g_pre_ffn, g_post_ffn, w_in, b_forget,
              cmp_pe_k, cmp_w1_k, cmp_w2_k, cmp_pe_v, cmp_w1_v, cmp_w2_v,
              w_o_nsa, w_o_fox, w_out, w_router_group, b_router_group, w_router_expert, b_router_expert,
              w_exp_gate, w_exp_up, w_exp_down):
    B, S, D = x.shape
    for l in range(DEPTH):
        mod = jax.nn.silu(c) @ w_ada[l] + b_ada[l]
        sh_m, sc_m, gt_m, sh_f, sc_f, gt_f = (m[:, None, :] for m in jnp.split(mod, 6, axis=-1))
        h = rmsnorm(x, g_pre_mix[l]) * (1 + sc_m) + sh_m
        proj = h @ w_in[l]
        q_a, kv_a, gl_a, qkv_b, f_b, mg = jnp.split(proj, IN_SPLITS, axis=-1)
        q_a = q_a.reshape(B, S, NSA_HEADS, HEAD_DIM)
        kcmp, vcmp, kslc, vslc, kwin, vwin = (a.reshape(B, S, NSA_KV_GROUPS, HEAD_DIM)
                                              for a in jnp.split(kv_a, 6, axis=-1))
        g_a = jax.nn.sigmoid(gl_a).reshape(B, S, NSA_HEADS, 3)
        y_a = nsa_attention(q_a, kcmp, vcmp, kslc, vslc, kwin, vwin, g_a,
                            cmp_pe_k[l], cmp_w1_k[l], cmp_w2_k[l], cmp_pe_v[l], cmp_w1_v[l], cmp_w2_v[l])
        q_b, k_b, v_b = (a.reshape(B, S, FOX_HEADS, HEAD_DIM) for a in jnp.split(qkv_b, 3, axis=-1))
        y_b = forgetting_attention(q_b, k_b, v_b, f_b + b_forget[l])
        g_merge_a, g_merge_b = jnp.split(jax.nn.sigmoid(mg), 2, axis=-1)
        mixed = (g_merge_a * (y_a @ w_o_nsa[l]) + g_merge_b * (y_b @ w_o_fox[l])) @ w_out[l]
        x = x + gt_m * rmsnorm(mixed, g_post_mix[l])
        h2 = rmsnorm(x, g_pre_ffn[l]) * (1 + sc_f) + sh_f
        y = hierarchical_moe(h2.reshape(B * S, D), w_router_group[l], b_router_group[l],
                             w_router_expert[l], b_router_expert[l],
                             w_exp_gate[l], w_exp_up[l], w_exp_down[l]).reshape(B, S, D)
        x = x + gt_f * rmsnorm(y, g_post_ffn[l])
    return x
```

```cpp
#define MK_N_LAUNCHES 11
#include <hip/hip_runtime.h>
#include <hip/hip_bf16.h>
#include <cstdio>
#include <cstdint>
#include <cmath>

#define LAS __attribute__((address_space(3)))
#define GAS __attribute__((address_space(1)))
typedef unsigned short bf16_t;
typedef short bf16x8 __attribute__((ext_vector_type(8)));
typedef short s16x4 __attribute__((ext_vector_type(4)));
typedef float f32x4 __attribute__((ext_vector_type(4)));
typedef float f32x2 __attribute__((ext_vector_type(2)));
typedef float f32x16 __attribute__((ext_vector_type(16)));
typedef unsigned u32x4 __attribute__((ext_vector_type(4)));
typedef unsigned u32x2 __attribute__((ext_vector_type(2)));
typedef __bf16 bf16x2_t __attribute__((ext_vector_type(2)));

__device__ __forceinline__ unsigned cvtpk(float lo, float hi) { f32x2 v = {lo, hi}; bf16x2_t b = __builtin_convertvector(v, bf16x2_t); return __builtin_bit_cast(unsigned, b); }
__device__ __forceinline__ float bf2f(unsigned short h) { return __uint_as_float(((unsigned)h) << 16); }
__device__ __forceinline__ float bflo(unsigned w) { return __uint_as_float(w << 16); }
__device__ __forceinline__ float bfhi(unsigned w) { return __uint_as_float(w & 0xffff0000u); }
__device__ __forceinline__ float sigmoidf_(float x) { return 1.0f / (1.0f + __expf(-x)); }

namespace pg8 {
constexpr int BM = 256, BK = 64, HALF = 128, HTB = HALF * BK * 2  , STAGE_BYTES = 8 * HTB, NXCD = 8, WGM = 8;

__host__ __device__ __forceinline__ int lds_byte(int r, int c) { const int st = (r >> 4) * 2 + (c >> 5), rr = r & 15, cc = c & 31, ob = rr * 64 + cc * 2; return st * 1024 + (ob ^ (((ob >> 9) & 1) << 5)); }
__host__ __device__ __forceinline__ void stage_rc(int b, int& R, int& C) { const int st = b / 1024, sb = b % 1024, swz = sb ^ (((sb >> 9) & 1) << 5); R = (st >> 1) * 16 + swz / 64; C = (st & 1) * 32 + (swz % 64) / 2; }
__host__ __device__ __forceinline__ int perm32(int rho) { const int n = rho >> 4, i = rho & 15; return 8 * (i >> 2) + 4 * n + (i & 3); }

struct Unit { int pm, pn; };
struct Gemm { const bf16_t* A; const bf16_t* Bt; int M, N, K; };

struct StaticOrder {
    int nM, nN, nwg, G, c;
    __host__ __device__ void init(int M, int N, int G_, int c_) { nM = M / BM; nN = N / BM; nwg = nM * nN; G = G_; c = c_; }
    __host__ __device__ bool next(int i, Unit& u) const {
        const long L = (long)i * G + c; if (L >= nwg) return false;
        int wgid = (int)L; { const int q = nwg / NXCD, r = nwg % NXCD, xcd = wgid % NXCD, off = wgid / NXCD; wgid = (xcd < r ? xcd * (q + 1) : r * (q + 1) + (xcd - r) * q) + off; }
        const int nig = WGM * nN, gid = wgid / nig, fm = gid * WGM, gsz = (nM - fm) < WGM ? (nM - fm) : WGM;
        u.pm = fm + ((wgid % nig) % gsz); u.pn = (wgid % nig) / gsz; return true;
    }
};
struct NoGather { __device__ __forceinline__ int row(const Unit&, int) const { return 0; } };

template <bool GATHER, class Epi, class Sched, class Gath>
__device__ __forceinline__ void gemm_phase(LAS unsigned char* lds, const Gemm g, const Sched& S, const Epi& E, const Gath& GT) {
    const int tid = threadIdx.x, wid = __builtin_amdgcn_readfirstlane(tid >> 6), lane = tid & 63, wr = wid >> 2, wc = wid & 3, fr = lane & 15, fq = lane >> 4;
    const int K = g.K, nt = K / BK;
    unsigned voffA[2], voffB[2];
#pragma unroll
    for (int i = 0; i < 2; ++i) { int R, C; stage_rc(tid * 16 + i * 8192, R, C); const int Rb = (R & ~31) + perm32(R & 31);
        voffA[i] = (unsigned)(R * K + C) * 2u; voffB[i] = (unsigned)(Rb * K + C) * 2u; }
    const size_t kstep = (size_t)(BK * 2);
    const size_t hstep = (size_t)HALF * K * 2;
    const size_t tstep = 2 * hstep;
    const unsigned ldsw = (unsigned)wid * 1024u;
    const int aoff = lds_byte(wr * 64 + fr, fq * 8), boff = lds_byte(wc * 32 + fr, fq * 8);
#define PG8_SA(b, h) (((b) * 2 + (h)) * HTB)
#define PG8_SB(b, h) ((4 + (b) * 2 + (h)) * HTB)
#define PG8_STG2(bufoff, gbase, o0, o1) do { \
        __builtin_amdgcn_global_load_lds((const unsigned*)((const char*)(gbase) + (o0)), (LAS unsigned*)(lds + (bufoff) + ldsw), 16, 0, 0); \
        __builtin_amdgcn_global_load_lds((const unsigned*)((const char*)(gbase) + (o1)), (LAS unsigned*)(lds + (bufoff) + ldsw + 8192), 16, 0, 0); } while (0)
#define PG8_STAGE(bufoff, gbase, voff) PG8_STG2(bufoff, gbase, (voff)[0], (voff)[1])
#define PG8_STAGE_A(bufoff, h, kt, NX) do { if constexpr (GATHER) { const char* _b = (const char*)g.A + (size_t)(kt) * kstep; \
            const u32x2 _o = *(const LAS u32x2*)(gtab + ((NX) ? 4 : 0) + (h) * 2); PG8_STG2(bufoff, _b, _o.x, _o.y); } \
        else { const char* _b = ((NX) ? nA : cA) + (size_t)(h) * hstep + (size_t)(kt) * kstep; PG8_STG2(bufoff, _b, voffA[0], voffA[1]); } } while (0)
#define PG8_GOFF(U, s) do { _Pragma("unroll") for (int _h = 0; _h < 2; ++_h) _Pragma("unroll") for (int _i = 0; _i < 2; ++_i) { int _R, _C; stage_rc(tid * 16 + _i * 8192, _R, _C); \
            gtab[(s) * 4 + _h * 2 + _i] = (unsigned)(GT.row(U, _h * HALF + _R) * K + _C) * 2u; } } while (0)
#define PG8_LDA(dst, b, h) do { _Pragma("unroll") for (int m = 0; m < 4; ++m) _Pragma("unroll") for (int k = 0; k < 2; ++k) dst[m][k] = *(const LAS bf16x8*)(lds + PG8_SA(b, h) + aoff + m * 2048 + k * 1024); } while (0)
#define PG8_LDB(dst, b, h) do { _Pragma("unroll") for (int n = 0; n < 2; ++n) _Pragma("unroll") for (int k = 0; k < 2; ++k) dst[n][k] = *(const LAS bf16x8*)(lds + PG8_SB(b, h) + boff + n * 2048 + k * 1024); } while (0)
#define PG8_MMA(ai, bj, At, Bt) do { __builtin_amdgcn_s_setprio(1); _Pragma("unroll") for (int m = 0; m < 4; ++m) _Pragma("unroll") for (int n = 0; n < 2; ++n) _Pragma("unroll") for (int k = 0; k < 2; ++k) \
        acc[ai][bj][m][n] = __builtin_amdgcn_mfma_f32_16x16x32_bf16(Bt[n][k], At[m][k], acc[ai][bj][m][n], 0, 0, 0); __builtin_amdgcn_s_setprio(0); } while (0)
#define PG8_WAIT_V(n) asm volatile("s_waitcnt vmcnt(" #n ")" ::: "memory")
#define PG8_WAIT_L(n) asm volatile("s_waitcnt lgkmcnt(" #n ")" ::: "memory")
#define PG8_BAR __builtin_amdgcn_s_barrier()
#define PG8_SCHED __builtin_amdgcn_sched_barrier(0)
    Unit cur, nxt; int ui = 0;
    if (!S.next(0, cur)) return;
    f32x4 acc[2][2][4][2];
#pragma unroll
    for (int a = 0; a < 2; ++a)
#pragma unroll
        for (int b = 0; b < 2; ++b)
#pragma unroll
            for (int m = 0; m < 4; ++m)
#pragma unroll
                for (int n = 0; n < 2; ++n) acc[a][b][m][n] = (f32x4){0.f, 0.f, 0.f, 0.f};
    bf16x8 At[4][2], B0[2][2], B1[2][2];
    LAS unsigned* const gtab = (LAS unsigned*)(lds + STAGE_BYTES) + tid * 8;
    const char* cA = (const char*)g.A + (size_t)cur.pm * tstep; const char* cB = (const char*)g.Bt + (size_t)cur.pn * tstep;
    const char* nA = cA;
    if constexpr (GATHER) { PG8_GOFF(cur, 0); }
    PG8_STAGE(PG8_SB(0, 0), cB, voffB); PG8_STAGE(PG8_SB(0, 1), cB + hstep, voffB); PG8_STAGE_A(PG8_SA(0, 0), 0, 0, false); PG8_STAGE_A(PG8_SA(0, 1), 1, 0, false);
    if (wr == 1) PG8_BAR;
    PG8_WAIT_V(2); PG8_BAR;
    PG8_STAGE(PG8_SB(1, 0), cB + kstep, voffB); PG8_STAGE_A(PG8_SA(1, 0), 0, 1, false); PG8_STAGE(PG8_SB(1, 1), cB + hstep + kstep, voffB);
    PG8_WAIT_V(6); PG8_BAR;
    for (;;) {
        const bool has_next = S.next(ui + 1, nxt);
        nA = has_next ? (const char*)g.A + (size_t)nxt.pm * tstep : cA; const char* nB = has_next ? (const char*)g.Bt + (size_t)nxt.pn * tstep : cB;
        if constexpr (GATHER) { if (has_next) PG8_GOFF(nxt, 1); else { *(LAS u32x4*)(gtab + 4) = *(const LAS u32x4*)gtab; } }
        for (int t = 0; t < nt; t += 2) {
            const bool last = (t == nt - 2);
            const char* b2 = last ? nB : cB + (size_t)(t + 2) * kstep;
            const char* b3 = b2 + kstep;
            const int k2 = last ? 0 : t + 2, k3 = k2 + 1;
            PG8_LDB(B0, 0, 0); PG8_LDB(B1, 0, 1); PG8_SCHED; PG8_LDA(At, 0, 0); PG8_STAGE_A(PG8_SA(1, 1), 1, t + 1, false);
            PG8_WAIT_V(8); PG8_WAIT_L(0); PG8_BAR; PG8_MMA(0, 0, At, B0); PG8_MMA(0, 1, At, B1); PG8_BAR; PG8_SCHED;
            PG8_LDA(At, 0, 1); PG8_STAGE(PG8_SB(0, 0), b2, voffB); PG8_STAGE(PG8_SB(0, 1), b2 + hstep, voffB);
            if (last) PG8_STAGE_A(PG8_SA(0, 0), 0, k2, true); else PG8_STAGE_A(PG8_SA(0, 0), 0, k2, false);
            PG8_WAIT_V(8); PG8_WAIT_L(0); PG8_BAR; PG8_MMA(1, 0, At, B0); PG8_MMA(1, 1, At, B1); PG8_BAR; PG8_SCHED;
            PG8_LDB(B0, 1, 0); PG8_LDB(B1, 1, 1); PG8_SCHED; PG8_LDA(At, 1, 0);
            if (last) PG8_STAGE_A(PG8_SA(0, 1), 1, k2, true); else PG8_STAGE_A(PG8_SA(0, 1), 1, k2, false);
            PG8_WAIT_V(8); PG8_WAIT_L(0); PG8_BAR; PG8_MMA(0, 0, At, B0); PG8_MMA(0, 1, At, B1); PG8_BAR; PG8_SCHED;
            PG8_LDA(At, 1, 1); PG8_STAGE(PG8_SB(1, 0), b3, voffB); PG8_STAGE(PG8_SB(1, 1), b3 + hstep, voffB);
            if (last) PG8_STAGE_A(PG8_SA(1, 0), 0, k3, true); else PG8_STAGE_A(PG8_SA(1, 0), 0, k3, false);
            PG8_WAIT_V(8); PG8_WAIT_L(0); PG8_BAR; PG8_MMA(1, 0, At, B0); PG8_MMA(1, 1, At, B1); PG8_BAR; PG8_SCHED;
        }
        if (wr == 0) PG8_BAR;
        E(acc, cur, wr, wc, fr, fq);
        if (!has_next) break;
#pragma unroll
        for (int a = 0; a < 2; ++a)
#pragma unroll
            for (int b = 0; b < 2; ++b)
#pragma unroll
                for (int m = 0; m < 4; ++m)
#pragma unroll
                    for (int n = 0; n < 2; ++n) acc[a][b][m][n] = (f32x4){0.f, 0.f, 0.f, 0.f};
        cur = nxt; cA = nA; cB = nB; ++ui;
        if constexpr (GATHER) { *(LAS u32x4*)gtab = *(const LAS u32x4*)(gtab + 4); }
        if (wr == 1) PG8_BAR;
    }
    PG8_WAIT_V(0);
    PG8_BAR;
#undef PG8_SA
#undef PG8_SB
#undef PG8_STG2
#undef PG8_STAGE
#undef PG8_STAGE_A
#undef PG8_GOFF
#undef PG8_LDA
#undef PG8_LDB
#undef PG8_MMA
#undef PG8_WAIT_V
#undef PG8_WAIT_L
#undef PG8_BAR
#undef PG8_SCHED
}
}
constexpr int NWAVES = 8;
constexpr int BATCH = 2, SEQ = 8192, DM = 1024, M = BATCH * SEQ;
constexpr int DIN = 4896, PP = 4864  , NPAD = 5120  ;
constexpr int C_QA = 0, C_KCMP = 512, C_VCMP = 640, C_KSLC = 768, C_VSLC = 896, C_KWIN = 1024, C_VWIN = 1152, C_FQ = 1280, C_FK = 1792, C_FV = 2304, C_MG = 2816;
constexpr float LOG2E = 1.4426950408889634f;
constexpr float C2 = 0.125f * LOG2E;
constexpr float NORM_EPS = 1e-6f;
constexpr float NEGF = -1e30f;
constexpr int NEXP = 32, DEXP = 512;
constexpr int HROWS_MAX = 2 * M + NEXP * 256;

constexpr size_t MiB = 1u << 20;
constexpr size_t WS_CTL = 0, CTL_ZERO_BYTES = 1 * MiB;
constexpr size_t WS_MODP = 1 * MiB;
constexpr size_t WS_MOD = WS_MODP + 512 * 1024;
constexpr size_t WS_PEB = WS_MOD + 64 * 1024;
constexpr size_t WS_W1T = WS_PEB + 64 * 1024;
constexpr size_t WS_KC = WS_W1T + 512 * 1024;
constexpr size_t WS_VC = WS_KC + 256 * 1024;
constexpr size_t WS_FB2 = WS_VC + 256 * 1024;
constexpr size_t WS_LF = WS_FB2 + 512 * 1024;
constexpr size_t WS_GATES = WS_LF + 512 * 1024;
constexpr size_t WS_ROUTE = WS_GATES + 1536 * 1024;
constexpr size_t WS_LIST = 6 * MiB;
constexpr size_t WS_WINT = 10 * MiB;
constexpr size_t WS_WOT = 20 * MiB;
constexpr size_t WS_WOUTT = 22 * MiB;
constexpr size_t WS_HN = 24 * MiB;
constexpr size_t WS_PROJ = 56 * MiB;
constexpr size_t WS_WGUT = WS_PROJ;
constexpr size_t WS_WDT = WS_PROJ + 64 * MiB;
constexpr size_t WS_HBUF = WS_PROJ + 96 * MiB;
constexpr size_t WS_YY = 208 * MiB;
constexpr size_t WS_END = 272 * MiB;
static_assert(WS_ROUTE + 64 * 1024 <= WS_LIST && WS_LIST + 4 * MiB <= WS_WINT && WS_HBUF + (size_t)HROWS_MAX * 1024 <= WS_YY, "d_ws map");
constexpr int CW_QCTR = 64;
constexpr int CW_ECNT = 128;
constexpr int CW_BAR = 4096;

constexpr int RING_BYTES = 131072;
constexpr int LDS_BYTES = 163840;
constexpr int MISC_OFF = 160 * 1024 - 1024;

#define RLX_AGENT __ATOMIC_RELAXED, __HIP_MEMORY_SCOPE_AGENT
#define LDS_WAIT() asm volatile("s_waitcnt lgkmcnt(0)" ::: "memory")
#define VM_WAIT() asm volatile("s_waitcnt vmcnt(0)" ::: "memory")

#define XB_TMO      128
#define XB_XCNT(j)  (256  + 64 * (j))
#define XB_XSUB(j)  (1280 + 64 * (j))
#define XB_XGEN(j)  (2304 + 64 * (j))
#define XB_TOP      3328
#define XB_TOPGEN   3392
#define XCD_BAR_WORDS 3456
#define XB_SPIN_CAP (1u << 22)
__device__ __forceinline__ unsigned xb_ld(unsigned* p)              { return __hip_atomic_load(p, __ATOMIC_RELAXED, __HIP_MEMORY_SCOPE_AGENT); }
__device__ __forceinline__ unsigned xb_add(unsigned* p, unsigned v) { return __hip_atomic_fetch_add(p, v, __ATOMIC_RELAXED, __HIP_MEMORY_SCOPE_AGENT); }
__device__ __forceinline__ unsigned xb_xcc_id() { return (unsigned)__builtin_amdgcn_s_getreg((3 << 11) | 20) & 0xFu; }
#define XB_SPIN(cond, bar) do { unsigned _sp = 0; while (cond) { __builtin_amdgcn_s_sleep(1); \
    if ((++_sp & 255u) == 0u) { if (xb_ld(&(bar)[XB_TMO])) break; if (_sp > XB_SPIN_CAP) { atomicAdd(&(bar)[XB_TMO], 1u); break; } } } } while (0)
struct XcdBarrier { unsigned* bar; unsigned x; volatile LAS unsigned* st; };
__device__ __forceinline__ XcdBarrier xcd_barrier_post(unsigned* bar, volatile LAS unsigned* st) {
    XcdBarrier b; b.bar = bar; b.x = xb_xcc_id(); b.st = st;
    if (threadIdx.x == 0) (void)xb_add(&bar[XB_XCNT(b.x)], 1u);
    return b;
}
__device__ __forceinline__ void xcd_barrier_complete(unsigned* bar, unsigned x, unsigned& nloc, unsigned& nx) {
    const unsigned G = gridDim.x * gridDim.y * gridDim.z;
    unsigned sum, cnt, mine, sp = 0u;
    for (;;) {
        sum = 0u; cnt = 0u; mine = 0u;
#pragma unroll
        for (unsigned j = 0; j < 16; ++j) { const unsigned c = xb_ld(&bar[XB_XCNT(j)]); sum += c; cnt += (c > 0u) ? 1u : 0u; mine = (j == x) ? c : mine; }
        if (sum == G) break;
        __builtin_amdgcn_s_sleep(1);
        if ((++sp & 255u) == 0u) { if (xb_ld(&bar[XB_TMO])) break; if (sp > XB_SPIN_CAP) { atomicAdd(&bar[XB_TMO], 1u); break; } }
    }
    nloc = mine > 0u ? mine : 1u; nx = cnt > 0u ? cnt : 1u;
}
__device__ __forceinline__ void xcd_barrier(const XcdBarrier& b) {
    asm volatile("s_waitcnt vmcnt(0)" ::: "memory");
    __syncthreads();
    if (threadIdx.x == 0) {
        unsigned* bar = b.bar;
        __builtin_amdgcn_s_waitcnt(0);
        unsigned nloc = b.st[0], nx = b.st[1];
        if (nloc == 0u) { xcd_barrier_complete(bar, b.x, nloc, nx); b.st[0] = nloc; b.st[1] = nx; }
        const unsigned old = xb_add(&bar[XB_XSUB(b.x)], 1u);
        const unsigned gen = old / nloc;
        if (old + 1u == (gen + 1u) * nloc) {
            __builtin_amdgcn_fence(__ATOMIC_RELEASE, "agent");
            asm volatile("s_waitcnt vmcnt(0)" ::: "memory");
            const unsigned og = xb_add(&bar[XB_TOP], 1u);
            const unsigned tg = og / nx;
            if (og + 1u == (tg + 1u) * nx) xb_add(&bar[XB_TOPGEN], 1u);
            else XB_SPIN(xb_ld(&bar[XB_TOPGEN]) == tg, bar);
            __builtin_amdgcn_fence(__ATOMIC_ACQUIRE, "agent");
            xb_add(&bar[XB_XGEN(b.x)], 1u);
            asm volatile("s_waitcnt vmcnt(0)" ::: "memory");
        } else {
            XB_SPIN(xb_ld(&bar[XB_XGEN(b.x)]) == gen, bar);
            __builtin_amdgcn_fence(__ATOMIC_ACQUIRE, "agent");
            asm volatile("s_waitcnt vmcnt(0)" ::: "memory");
        }
    }
    __syncthreads();
}

struct Frame {
    LAS unsigned char* lds;
    volatile LAS unsigned* MISC;
    unsigned* ctl;
    int tid, lane, wave, G;
    const float *x, *c, *w_ada, *b_ada, *g_pre_mix, *g_post_mix, *g_pre_ffn, *g_post_ffn, *w_in, *b_forget;
    const float *pe_k, *w1_k, *w2_k, *pe_v, *w1_v, *w2_v, *w_o_nsa, *w_o_fox, *w_out, *w_rg, *b_rg, *w_re, *b_re, *w_eg, *w_eu, *w_ed;
    float* out;
    unsigned char* ws;
};

__device__ __forceinline__ float wave_sum(float v) {
#pragma unroll
    for (int o = 1; o < 64; o <<= 1) v += __shfl_xor(v, o);
    return v;
}

#define EPI_LOOP_BEGIN _Pragma("unroll") for (int ai = 0; ai < 2; ++ai) _Pragma("unroll") for (int m = 0; m < 4; ++m) { const int rin = ai * 128 + wr * 64 + m * 16 + fr; (void)rin;
#define EPI_LOOP_END }

struct EpiProj {
    bf16_t* P; float* gates; float* lf; const float* b_forget;
    __device__ __forceinline__ void operator()(const f32x4 (&acc)[2][2][4][2], const pg8::Unit& u, int wr, int wc, int fr, int fq) const {
        const int pn = u.pn;
        if (pn < 19) {
            const int mode = (pn < 2 || pn == 5 || pn == 6) ? 1 : (pn >= 11 ? 2 : 0);
            EPI_LOOP_BEGIN
                bf16_t* rowp = P + (size_t)(u.pm * 256 + rin) * PP + pn * 256 + wc * 32 + 8 * fq;
#pragma unroll
                for (int bj = 0; bj < 2; ++bj) { f32x4 v0 = acc[ai][bj][m][0], v1 = acc[ai][bj][m][1];
                    if (mode == 1) { v0 = v0 * C2; v1 = v1 * C2; }
                    else if (mode == 2) {
#pragma unroll
                        for (int i = 0; i < 4; ++i) { v0[i] = sigmoidf_(v0[i]); v1[i] = sigmoidf_(v1[i]); } }
                    u32x4 w; w.x = cvtpk(v0[0], v0[1]); w.y = cvtpk(v0[2], v0[3]); w.z = cvtpk(v1[0], v1[1]); w.w = cvtpk(v1[2], v1[3]);
                    *(u32x4*)(rowp + bj * 128) = w; }
            EPI_LOOP_END
        } else {
            if (wc == 0) {
                EPI_LOOP_BEGIN
                    const int row = u.pm * 256 + rin; const f32x4 v0 = acc[ai][0][m][0], v1 = acc[ai][0][m][1];
                    if (fq < 3) { f32x4 a, b;
#pragma unroll
                        for (int i = 0; i < 4; ++i) { a[i] = sigmoidf_(v0[i]); b[i] = sigmoidf_(v1[i]); }
                        *(f32x4*)(gates + (size_t)row * 24 + 8 * fq) = a; *(f32x4*)(gates + (size_t)row * 24 + 8 * fq + 4) = b; }
                    else { f32x4 a, b;
#pragma unroll
                        for (int i = 0; i < 4; ++i) { const float xa = v0[i] + b_forget[i], xb = v1[i] + b_forget[4 + i];
                            a[i] = fminf(xa, 0.f) - log1pf(__expf(-fabsf(xa))); b[i] = fminf(xb, 0.f) - log1pf(__expf(-fabsf(xb))); }
                        *(f32x4*)(lf + (size_t)row * 8) = a; *(f32x4*)(lf + (size_t)row * 8 + 4) = b; }
                EPI_LOOP_END
            }
        }
    }
};
struct EpiOut {
    bf16_t* U; const bf16_t* P;
    __device__ __forceinline__ void operator()(const f32x4 (&acc)[2][2][4][2], const pg8::Unit& u, int wr, int wc, int fr, int fq) const {
        const int p = u.pm >= 64 ? 1 : 0, pm = u.pm - 64 * p, pn = u.pn - 4 * p;
        EPI_LOOP_BEGIN
            const size_t row = (size_t)(pm * 256 + rin); const int col = pn * 256 + wc * 32 + 8 * fq;
#pragma unroll
            for (int bj = 0; bj < 2; ++bj) { f32x4 v0 = acc[ai][bj][m][0], v1 = acc[ai][bj][m][1];
                const u32x4 gw = *(const u32x4*)(P + row * PP + C_MG + p * 1024 + col + bj * 128);
                float r[8] = {v0[0] * bflo(gw.x), v0[1] * bfhi(gw.x), v0[2] * bflo(gw.y), v0[3] * bfhi(gw.y), v1[0] * bflo(gw.z), v1[1] * bfhi(gw.z), v1[2] * bflo(gw.w), v1[3] * bfhi(gw.w)};
                bf16_t* up = U + row * DM + col + bj * 128;
                if (p == 1) { const u32x4 o = *(const u32x4*)up;
                    r[0] += bflo(o.x); r[1] += bfhi(o.x); r[2] += bflo(o.y); r[3] += bfhi(o.y); r[4] += bflo(o.z); r[5] += bfhi(o.z); r[6] += bflo(o.w); r[7] += bfhi(o.w); }
                u32x4 w; w.x = cvtpk(r[0], r[1]); w.y = cvtpk(r[2], r[3]); w.z = cvtpk(r[4], r[5]); w.w = cvtpk(r[6], r[7]);
                *(u32x4*)up = w; }
        EPI_LOOP_END
    }
};
struct EpiF32 {
    float* O; int ldc;
    __device__ __forceinline__ void operator()(const f32x4 (&acc)[2][2][4][2], const pg8::Unit& u, int wr, int wc, int fr, int fq) const {
        EPI_LOOP_BEGIN
            float* rowp = O + (size_t)(u.pm * 256 + rin) * ldc + u.pn * 256 + wc * 32 + 8 * fq;
#pragma unroll
            for (int bj = 0; bj < 2; ++bj) { *(f32x4*)(rowp + bj * 128) = acc[ai][bj][m][0]; *(f32x4*)(rowp + bj * 128 + 4) = acc[ai][bj][m][1]; }
        EPI_LOOP_END
    }
};
struct EpiSwiglu {
    bf16_t* H;
    __device__ __forceinline__ void operator()(const f32x4 (&acc)[2][2][4][2], const pg8::Unit& u, int wr, int wc, int fr, int fq) const {
        EPI_LOOP_BEGIN
            bf16_t* hp = H + (size_t)(u.pm * 256 + rin) * DEXP + (u.pn & 3) * 128 + wc * 32 + 8 * fq;
            float r[8];
#pragma unroll
            for (int i = 0; i < 4; ++i) { const float g0 = acc[ai][0][m][0][i], g1 = acc[ai][0][m][1][i];
                r[i] = g0 * sigmoidf_(g0) * acc[ai][1][m][0][i]; r[4 + i] = g1 * sigmoidf_(g1) * acc[ai][1][m][1][i]; }
            u32x4 w; w.x = cvtpk(r[0], r[1]); w.y = cvtpk(r[2], r[3]); w.z = cvtpk(r[4], r[5]); w.w = cvtpk(r[6], r[7]);
            *(u32x4*)hp = w;
        EPI_LOOP_END
    }
};
struct EpiDown {
    bf16_t* Y2; const u32x2* list; volatile LAS unsigned* tstart; volatile LAS unsigned* ecnt;
    __device__ __forceinline__ void operator()(const f32x4 (&acc)[2][2][4][2], const pg8::Unit& u, int wr, int wc, int fr, int fq) const {
        const int e = u.pn >> 2, rt = u.pm - (int)tstart[e], cnt = (int)ecnt[e];
        EPI_LOOP_BEGIN
            const int rank = rt * 256 + rin;
            if (rank < cnt) { const u32x2 ent = list[(size_t)e * M + rank]; const float w = __uint_as_float(ent.y);
                bf16_t* yp = Y2 + (size_t)ent.x * DM + (u.pn & 3) * 256 + wc * 32 + 8 * fq;
#pragma unroll
                for (int bj = 0; bj < 2; ++bj) { const f32x4 v0 = acc[ai][bj][m][0] * w, v1 = acc[ai][bj][m][1] * w;
                    u32x4 o; o.x = cvtpk(v0[0], v0[1]); o.y = cvtpk(v0[2], v0[3]); o.z = cvtpk(v1[0], v1[1]); o.w = cvtpk(v1[2], v1[3]);
                    *(u32x4*)(yp + bj * 128) = o; } }
        EPI_LOOP_END
    }
};
struct OutOrder {
    int G, c;
    __device__ bool next(int i, pg8::Unit& u) const { const int T = c + (i >> 1) * G; if (T >= 256) return false; const int p = i & 1; u.pm = (T >> 2) + 64 * p; u.pn = (T & 3) + 4 * p; return true; }
};
struct MoeOrder {
    volatile LAS unsigned* tstart; int G, c;
    __device__ bool next(int i, pg8::Unit& u) const {
        const int L = i * G + c; const int NT = (int)tstart[32];
        if (L >= 4 * NT) return false;
        int e = 0;
        for (int k = 1; k < 32; ++k) if (L >= 4 * (int)tstart[k]) e = k;
        const int ts = (int)tstart[e], nte = (int)tstart[e + 1] - ts, rem = L - 4 * ts;
        const int j = rem / nte, rt = rem - j * nte;
        u.pm = ts + rt; u.pn = e * 4 + j; return true;
    }
};
struct MoeGather {
    const u32x2* list; volatile LAS unsigned* tstart; volatile LAS unsigned* ecnt;
    __device__ __forceinline__ int row(const pg8::Unit& u, int r) const {
        const int e = u.pn >> 2, rank = (u.pm - (int)tstart[e]) * 256 + r;
        if (rank >= (int)ecnt[e]) return 0;
        return (int)(list[(size_t)e * M + rank].x >> 1);
    }
};
constexpr int TR_SCR = 64 * 65 * 4;
template <class MapF>
__device__ __forceinline__ void tr_item(const float* __restrict__ W, int N, bf16_t* WT, int ldwt, MapF map, LAS float* scr, int kb, int nb, int lane) {
    const int k0 = 64 * kb, n0 = 64 * nb, c4 = 4 * (lane & 15);
    f32x4 v[16];
    const bool okc = (n0 + c4) < N;
#pragma unroll
    for (int i = 0; i < 16; ++i) { const int k = 4 * i + (lane >> 4); v[i] = okc ? *(const f32x4*)(W + (size_t)(k0 + k) * N + n0 + c4) : (f32x4){0.f, 0.f, 0.f, 0.f}; }
#pragma unroll
    for (int i = 0; i < 16; ++i) { const int k = 4 * i + (lane >> 4); LAS float* s = scr + k * 65 + c4; s[0] = v[i][0]; s[1] = v[i][1]; s[2] = v[i][2]; s[3] = v[i][3]; }
    LDS_WAIT(); asm volatile("" ::: "memory");
    const int c = lane & 7;
#pragma unroll
    for (int jj = 0; jj < 8; ++jj) { const int n = (lane >> 3) + 8 * jj; const LAS float* s = scr + (8 * c) * 65 + n;
        u32x4 o; o.x = cvtpk(s[0 * 65], s[1 * 65]); o.y = cvtpk(s[2 * 65], s[3 * 65]); o.z = cvtpk(s[4 * 65], s[5 * 65]); o.w = cvtpk(s[6 * 65], s[7 * 65]);
        if (n0 + n < N) *(u32x4*)(WT + (size_t)map(n0 + n) * ldwt + k0 + 8 * c) = o; }
    LDS_WAIT(); asm volatile("" ::: "memory");
}
struct MapId { int off; __device__ __forceinline__ int operator()(int n) const { return off + n; } };
struct MapWin { __device__ __forceinline__ int operator()(int n) const {
    if (n < 1280) return n; if (n < 1304) return 4864 + (n - 1280); if (n < 2840) return 1280 + (n - 1304); if (n < 2848) return 4888 + (n - 2840); return 2816 + (n - 2848); } };
struct MapGU { int e, up; __device__ __forceinline__ int operator()(int n) const { return (e * 4 + (n >> 7)) * 256 + (n & 127) + up * 128; } };

__device__ __forceinline__ void p0_prologue(Frame& F) {
    LAS float* scr = (LAS float*)(F.lds + F.wave * TR_SCR);
    LAS float* sil = (LAS float*)(F.lds + 8 * TR_SCR);
    for (int i = F.tid; i < 2048; i += NWAVES * 64) { const float cv = F.c[i]; sil[i] = cv / (1.f + __expf(-cv)); }
    __syncthreads();
    const int gw = blockIdx.x * NWAVES + F.wave, NGW = F.G * NWAVES, lane = F.lane;
    float* MODP = (float*)(F.ws + WS_MODP); float* PEB = (float*)(F.ws + WS_PEB);
    bf16_t* W1T = (bf16_t*)(F.ws + WS_W1T); bf16_t* WINT = (bf16_t*)(F.ws + WS_WINT); bf16_t* WOT = (bf16_t*)(F.ws + WS_WOT); bf16_t* WOUTT = (bf16_t*)(F.ws + WS_WOUTT);
    constexpr int I_GEMV = 768, I_PEB = 64, I_W1T = 64, I_WIN = 16 * 77, I_WO = 128, I_WOUT = 256;
    constexpr int NITEMS = I_GEMV + I_PEB + I_W1T + I_WIN + 2 * I_WO + I_WOUT;
    for (int it = gw; it < NITEMS; it += NGW) {
        int r = it;
        if (r < I_GEMV) {
            const int cg = r % 96, kc = r / 96; const int col = cg * 64 + lane; float a0 = 0.f, a1 = 0.f;
            const float* wp = F.w_ada + (size_t)(kc * 128) * 6144 + col;
#pragma unroll 16
            for (int k = 0; k < 128; ++k) { const float w = wp[(size_t)k * 6144]; a0 += sil[kc * 128 + k] * w; a1 += sil[1024 + kc * 128 + k] * w; }
            MODP[(kc * 2 + 0) * 6144 + col] = a0; MODP[(kc * 2 + 1) * 6144 + col] = a1; continue; }
        r -= I_GEMV;
        if (r < I_PEB) {
            const int kind = r >> 5, ch = r & 31; const float* pe = kind ? F.pe_v : F.pe_k; const float* w1 = kind ? F.w1_v : F.w1_k; float a = 0.f;
#pragma unroll 16
            for (int k = 0; k < 64; ++k) a += pe[ch * 64 + k] * w1[(size_t)(ch * 64 + k) * 64 + lane];
            PEB[(kind * 32 + ch) * 64 + lane] = a; continue; }
        r -= I_PEB;
        if (r < I_W1T) { const int kind = r >> 5, kb = r & 31; tr_item(kind ? F.w1_v : F.w1_k, 64, W1T + (size_t)kind * 64 * 2048, 2048, MapId{0}, scr, kb, 0, lane); continue; }
        r -= I_W1T;
        if (r < I_WIN) { tr_item(F.w_in, DIN, WINT, 1024, MapWin{}, scr, r / 77, r % 77, lane); continue; }
        r -= I_WIN;
        if (r < I_WO) { tr_item(F.w_o_nsa, 1024, WOT, 512, MapId{0}, scr, r >> 4, r & 15, lane); continue; }
        r -= I_WO;
        if (r < I_WO) { tr_item(F.w_o_fox, 1024, WOT, 512, MapId{1024}, scr, r >> 4, r & 15, lane); continue; }
        r -= I_WO;
        tr_item(F.w_out, 1024, WOUTT, 1024, MapId{0}, scr, r >> 4, r & 15, lane);
    }
}
__device__ __forceinline__ void expert_convert(Frame& F) {
    LAS float* scr = (LAS float*)(F.lds + F.wave * TR_SCR);
    const int gw = blockIdx.x * NWAVES + F.wave, NGW = F.G * NWAVES, lane = F.lane;
    bf16_t* WGUT = (bf16_t*)(F.ws + WS_WGUT); bf16_t* WDT = (bf16_t*)(F.ws + WS_WDT);
    for (int it = gw; it < 32 * 384; it += NGW) {
        const int e = it / 384, r = it % 384, mat = r >> 7, q = r & 127;
        if (mat == 0) tr_item(F.w_eg + (size_t)e * 1024 * 512, 512, WGUT, 1024, MapGU{e, 0}, scr, q >> 3, q & 7, lane);
        else if (mat == 1) tr_item(F.w_eu + (size_t)e * 1024 * 512, 512, WGUT, 1024, MapGU{e, 1}, scr, q >> 3, q & 7, lane);
        else tr_item(F.w_ed + (size_t)e * 512 * 1024, 1024, WDT, 512, MapId{e * 1024}, scr, q >> 4, q & 15, lane);
    }
}

__device__ __forceinline__ void mod_from_partials(Frame& F, int b, int ch, f32x4 (&o)[4]) {
    const float* MODP = (const float*)(F.ws + WS_MODP);
#pragma unroll
    for (int j = 0; j < 4; ++j) { const int col = ch * 1024 + 256 * j + 4 * F.lane; f32x4 a = *(const f32x4*)(F.b_ada + col);
#pragma unroll
        for (int kc = 0; kc < 8; ++kc) a += *(const f32x4*)(MODP + (size_t)(kc * 2 + b) * 6144 + col);
        o[j] = a; }
}
__device__ __forceinline__ void mod_final(Frame& F, int b, int ch, f32x4 (&o)[4]) {
    const float* MOD = (const float*)(F.ws + WS_MOD);
#pragma unroll
    for (int j = 0; j < 4; ++j) o[j] = *(const f32x4*)(MOD + (size_t)b * 6144 + ch * 1024 + 256 * j + 4 * F.lane);
}
__device__ __forceinline__ void ld_row4(const float* p, int lane, f32x4 (&o)[4]) {
#pragma unroll
    for (int j = 0; j < 4; ++j) o[j] = *(const f32x4*)(p + 256 * j + 4 * lane);
}
__device__ __forceinline__ float sumsq4(const f32x4 (&v)[4]) { float s = 0.f;
#pragma unroll
    for (int j = 0; j < 4; ++j) s += (v[j][0] * v[j][0] + v[j][1] * v[j][1]) + (v[j][2] * v[j][2] + v[j][3] * v[j][3]);
    return s; }
__device__ __forceinline__ void st_row_bf16(bf16_t* p, int lane, const f32x4 (&v)[4]) {
#pragma unroll
    for (int j = 0; j < 4; ++j) { u32x2 w; w.x = cvtpk(v[j][0], v[j][1]); w.y = cvtpk(v[j][2], v[j][3]); *(u32x2*)(p + 256 * j + 4 * lane) = w; }
}

__device__ __forceinline__ void p0b_rows(Frame& F) {
    const int gw = blockIdx.x * NWAVES + F.wave, NGW = F.G * NWAVES, lane = F.lane;
    {
        const float* MODP = (const float*)(F.ws + WS_MODP); float* MOD = (float*)(F.ws + WS_MOD);
        for (int j = gw * 64 + lane; j < 2 * 6144; j += NGW * 64) { const int b = j / 6144, col = j % 6144; float a = F.b_ada[col];
#pragma unroll
            for (int kc = 0; kc < 8; ++kc) a += MODP[(size_t)(kc * 2 + b) * 6144 + col];
            MOD[j] = a; }
    }
    bf16_t* HN = (bf16_t*)(F.ws + WS_HN);
    f32x4 g[4]; ld_row4(F.g_pre_mix, lane, g);
    int curb = -1; f32x4 mul[4], add[4];
    for (int m = gw; m < M; m += NGW) {
        const int b = m >> 13;
        if (b != curb) { f32x4 sc[4]; mod_from_partials(F, b, 0, add); mod_from_partials(F, b, 1, sc); curb = b;
#pragma unroll
            for (int j = 0; j < 4; ++j) mul[j] = g[j] * (sc[j] + 1.0f); }
        f32x4 v[4]; ld_row4(F.x + (size_t)m * DM, lane, v);
        const float rstd = 1.0f / sqrtf(wave_sum(sumsq4(v)) * (1.0f / DM) + NORM_EPS);
#pragma unroll
        for (int j = 0; j < 4; ++j) v[j] = v[j] * rstd * mul[j] + add[j];
        st_row_bf16(HN + (size_t)m * DM, lane, v);
    }
}

__device__ __forceinline__ float gelu_tanh(float x) { const float u = 0.7978845608028654f * (x + 0.044715f * x * x * x); const float t = 1.0f - 2.0f / (1.0f + __expf(2.0f * u)); return 0.5f * x * (1.0f + t); }
__device__ __forceinline__ void p2a_item_cmp(Frame& F, int item) {
    const int kind = item >> 6, bg = (item >> 4) & 3, nt = item & 15, b = bg >> 1, g = bg & 1, n0 = 32 * nt;
    const int lane = F.lane, r32 = lane & 31, hi = lane >> 5, w = F.wave, tid = F.tid;
    const bf16_t* PROJ = (const bf16_t*)(F.ws + WS_PROJ); const bf16_t* W1T = (const bf16_t*)(F.ws + WS_W1T) + (size_t)kind * 64 * 2048;
    const int col = (kind ? C_VCMP : C_KCMP) + g * 64;
    int n = n0 + r32; if (n > 510) n = 510;
    const bf16_t* ap = PROJ + (size_t)(b * SEQ + 16 * n) * PP + col + 8 * hi;
    const bf16_t* bp0 = W1T + (size_t)r32 * 2048 + 256 * w + 8 * hi; const bf16_t* bp1 = bp0 + (size_t)32 * 2048;
    f32x16 acc0 = {}, acc1 = {};
#pragma unroll 4
    for (int ks = 0; ks < 16; ++ks) { const int l = 4 * w + (ks >> 2), d = (ks & 3) * 16;
        const bf16x8 a = *(const bf16x8*)(ap + (size_t)l * PP + d);
        const bf16x8 b0 = *(const bf16x8*)(bp0 + 16 * ks), b1 = *(const bf16x8*)(bp1 + 16 * ks);
        acc0 = __builtin_amdgcn_mfma_f32_32x32x16_bf16(a, b0, acc0, 0, 0, 0); acc1 = __builtin_amdgcn_mfma_f32_32x32x16_bf16(a, b1, acc1, 0, 0, 0); }
    LAS float* RED = (LAS float*)F.lds;
    LAS float* BIAS = (LAS float*)(F.lds + 65536);
    LAS float* HID = (LAS float*)(F.lds + 65536 + 256);
#pragma unroll
    for (int r = 0; r < 16; ++r) { const int nl = (r & 3) + 8 * (r >> 2) + 4 * hi; RED[(w * 32 + nl) * 64 + r32] = acc0[r]; RED[(w * 32 + nl) * 64 + 32 + r32] = acc1[r]; }
    if (tid < 64) { const float* PEB = (const float*)(F.ws + WS_PEB) + kind * 32 * 64; float a = 0.f;
        for (int ch = 0; ch < 32; ++ch) a += PEB[ch * 64 + tid];
        BIAS[tid] = a; }
    __syncthreads();
    { const int idx = tid * 4, nl = idx >> 6, e = idx & 63; f32x4 s = *(const LAS f32x4*)(BIAS + e);
#pragma unroll
      for (int ww = 0; ww < 8; ++ww) s += *(const LAS f32x4*)(RED + (ww * 32 + nl) * 64 + e);
      f32x4 h; for (int i = 0; i < 4; ++i) h[i] = gelu_tanh(s[i]);
      *(LAS f32x4*)(HID + nl * 64 + e) = h; }
    __syncthreads();
    { const int nl = tid >> 4, e2 = (tid & 15) * 4; const float* w2 = kind ? F.w2_v : F.w2_k; f32x4 o = {0.f, 0.f, 0.f, 0.f};
#pragma unroll 8
      for (int e = 0; e < 64; ++e) { const float hv = HID[nl * 64 + e]; o += *(const f32x4*)(w2 + e * 64 + e2) * hv; }
      bf16_t* KC = (bf16_t*)(F.ws + (kind ? WS_VC : WS_KC));
      u32x2 pk; pk.x = cvtpk(o[0], o[1]); pk.y = cvtpk(o[2], o[3]);
      *(u32x2*)(KC + (size_t)(bg * 512 + n0 + nl) * 64 + e2) = pk; }
    __syncthreads();
}
__device__ __forceinline__ void p2a_item_cumsum(Frame& F, int bh) {
    const int b = bh >> 3, h = bh & 7, tid = F.tid, lane = F.lane, w = F.wave;
    const float* LF = (const float*)(F.ws + WS_LF); float* FB2 = (float*)(F.ws + WS_FB2);
    LAS float* WT = (LAS float*)F.lds;
    float v[16]; float s = 0.f;
#pragma unroll
    for (int i = 0; i < 16; ++i) { s += LF[(size_t)(b * SEQ + tid * 16 + i) * 8 + h]; v[i] = s; }
    float inc = s;
#pragma unroll
    for (int o = 1; o < 64; o <<= 1) { const float t = __shfl_up(inc, o); if (lane >= o) inc += t; }
    if (lane == 63) WT[w] = inc;
    __syncthreads();
    float base = inc - s;
    for (int ww = 0; ww < w; ++ww) base += WT[ww];
#pragma unroll
    for (int i = 0; i < 16; ++i) FB2[(size_t)bh * SEQ + tid * 16 + i] = -(base + v[i]) * LOG2E;
    __syncthreads();
}
namespace att {
__device__ __forceinline__ int crow(int r, int hi) { return (r & 3) + 8 * (r >> 2) + 4 * hi; }
constexpr int KVBUF = 16384;
__device__ __forceinline__ void issue_kv(LAS unsigned char* buf, const bf16_t* kp, const bf16_t* vp, int wid) {
    __builtin_amdgcn_global_load_lds((const unsigned*)kp, (LAS unsigned*)(buf + wid * 1024), 16, 0, 0);
    __builtin_amdgcn_global_load_lds((const unsigned*)vp, (LAS unsigned*)(buf + 8192 + wid * 1024), 16, 0, 0);
}
template <int PITCH> __device__ __forceinline__ const bf16_t* kptr(const bf16_t* base, int row0, int kc, int wid, int lane) { return base + (size_t)(row0 + lane) * PITCH + kc + wid * 8; }
template <int PITCH> __device__ __forceinline__ const bf16_t* vptr(const bf16_t* base, int row0, int vc, int wid, int lane) { return base + (size_t)(row0 + 16 * (wid & 3) + (lane >> 2)) * PITCH + vc + (wid >> 2) * 32 + (lane & 3) * 8; }

__device__ __forceinline__ void qkt(f32x16& p0, f32x16& p1, const LAS unsigned char* Ks, const bf16x8 (&qr)[4], int r32, int hi) {
    const LAS unsigned char* kb = Ks + hi * 1024 + r32 * 16;
#pragma unroll
    for (int d0 = 0; d0 < 4; ++d0) {
        const bf16x8 b0 = *(const LAS bf16x8*)(kb + d0 * 2048);
        const bf16x8 b1 = *(const LAS bf16x8*)(kb + d0 * 2048 + 512);
        p0 = __builtin_amdgcn_mfma_f32_32x32x16_bf16(b0, qr[d0], p0, 0, 0, 0);
        p1 = __builtin_amdgcn_mfma_f32_32x32x16_bf16(b1, qr[d0], p1, 0, 0, 0);
    }
}
typedef short v4i16_t __attribute__((ext_vector_type(4)));
__device__ __forceinline__ s16x4 vtr(const LAS unsigned char* p) { return __builtin_bit_cast(s16x4, __builtin_amdgcn_ds_read_tr16_b64_v4i16((LAS v4i16_t*)p)); }
__device__ __forceinline__ float half_swap_max(float v) { auto rr = __builtin_amdgcn_permlane32_swap(__float_as_uint(v), __float_as_uint(v), false, false); return fmaxf(__uint_as_float(rr[0]), __uint_as_float(rr[1])); }
__device__ __forceinline__ float half_swap_sum(float v) { auto rr = __builtin_amdgcn_permlane32_swap(__float_as_uint(v), __float_as_uint(v), false, false); return __uint_as_float(rr[0]) + __uint_as_float(rr[1]); }
__device__ __forceinline__ float rowmax32(const f32x16& p0, const f32x16& p1) {
    float a = fmaxf(p0[0], p1[0]);
#pragma unroll
    for (int r = 1; r < 16; ++r) a = fmaxf(a, fmaxf(p0[r], p1[r]));
    return half_swap_max(a);
}
__device__ __forceinline__ void pv(f32x16& o0, f32x16& o1, const LAS unsigned char* buf, const f32x16& p0, const f32x16& p1, int lane) {
    const int hi = lane >> 5;
    const LAS unsigned char* vb = buf + 8192 + ((lane >> 4) & 1) * 32 + (lane & 3) * 8 + (4 * hi + ((lane & 15) >> 2)) * 64;
    u32x4 w0 = {cvtpk(p0[0], p0[1]), cvtpk(p0[2], p0[3]), cvtpk(p0[4], p0[5]), cvtpk(p0[6], p0[7])};
    u32x4 w1 = {cvtpk(p0[8], p0[9]), cvtpk(p0[10], p0[11]), cvtpk(p0[12], p0[13]), cvtpk(p0[14], p0[15])};
    u32x4 w2 = {cvtpk(p1[0], p1[1]), cvtpk(p1[2], p1[3]), cvtpk(p1[4], p1[5]), cvtpk(p1[6], p1[7])};
    u32x4 w3 = {cvtpk(p1[8], p1[9]), cvtpk(p1[10], p1[11]), cvtpk(p1[12], p1[13]), cvtpk(p1[14], p1[15])};
    const bf16x8 pa[4] = {__builtin_bit_cast(bf16x8, w0), __builtin_bit_cast(bf16x8, w1), __builtin_bit_cast(bf16x8, w2), __builtin_bit_cast(bf16x8, w3)};
#pragma unroll
    for (int ks = 0; ks < 4; ++ks) {
        const s16x4 l0 = vtr(vb + ks * 1024), h0 = vtr(vb + ks * 1024 + 512);
        const s16x4 l1 = vtr(vb + 4096 + ks * 1024), h1 = vtr(vb + 4096 + ks * 1024 + 512);
        const bf16x8 v0 = {l0[0], l0[1], l0[2], l0[3], h0[0], h0[1], h0[2], h0[3]};
        const bf16x8 v1 = {l1[0], l1[1], l1[2], l1[3], h1[0], h1[1], h1[2], h1[3]};
        o0 = __builtin_amdgcn_mfma_f32_32x32x16_bf16(v0, pa[ks], o0, 0, 0, 0);
        o1 = __builtin_amdgcn_mfma_f32_32x32x16_bf16(v1, pa[ks], o1, 0, 0, 0);
    }
}
template <bool EMASK>
__device__ __forceinline__ void tile_step(const LAS unsigned char* buf, const bf16x8 (&qr)[4], f32x16 p0, f32x16 p1, int lo, int hb,
                                          f32x16& o0, f32x16& o1, float& m, float& l, int lane) {
    const int r32 = lane & 31, hi = lane >> 5;
    qkt(p0, p1, buf, qr, r32, hi);
    if (EMASK) {
#pragma unroll
        for (int r = 0; r < 16; ++r) { const int kl = crow(r, hi); if (kl < lo || kl > hb) p0[r] = NEGF; if (kl + 32 < lo || kl + 32 > hb) p1[r] = NEGF; }
    }
    const float rm = rowmax32(p0, p1);
    const float mn = fmaxf(m, rm);
    const float al = __builtin_amdgcn_exp2f(m - mn);
    m = mn; l *= al;
#pragma unroll
    for (int r = 0; r < 16; ++r) { o0[r] *= al; o1[r] *= al; }
    float s = 0.f;
#pragma unroll
    for (int r = 0; r < 16; ++r) { p0[r] = __builtin_amdgcn_exp2f(p0[r] - mn); p1[r] = __builtin_amdgcn_exp2f(p1[r] - mn); s += p0[r] + p1[r]; }
    l += s;
    pv(o0, o1, buf, p0, p1, lane);
}
__device__ __forceinline__ void store_cols(bf16_t* dst, const f32x16& y0, const f32x16& y1, int hi) {
#pragma unroll
    for (int q = 0; q < 4; ++q) {
        u32x2 a; a.x = cvtpk(y0[4 * q], y0[4 * q + 1]); a.y = cvtpk(y0[4 * q + 2], y0[4 * q + 3]);
        u32x2 b; b.x = cvtpk(y1[4 * q], y1[4 * q + 1]); b.y = cvtpk(y1[4 * q + 2], y1[4 * q + 3]);
        *(u32x2*)(dst + 8 * q + 4 * hi) = a; *(u32x2*)(dst + 32 + 8 * q + 4 * hi) = b;
    }
}

__device__ __forceinline__ int next_below(unsigned u0, unsigned u1, unsigned u2, unsigned u3, int from) {
    if (from > 96) { const unsigned v = (from < 128) ? (u3 & ((1u << (from - 96)) - 1u)) : u3; if (v) return 96 + 31 - __builtin_clz(v); }
    if (from > 64) { const unsigned v = (from < 96) ? (u2 & ((1u << (from - 64)) - 1u)) : u2; if (v) return 64 + 31 - __builtin_clz(v); }
    if (from > 32) { const unsigned v = (from < 64) ? (u1 & ((1u << (from - 32)) - 1u)) : u1; if (v) return 32 + 31 - __builtin_clz(v); }
    if (from > 0) { const unsigned v = (from < 32) ? (u0 & ((1u << from) - 1u)) : u0; if (v) return 31 - __builtin_clz(v); }
    return -1;
}
__device__ __forceinline__ void fox_unit(Frame& F, int b, int h, int qb) {
    int lane = F.lane; asm volatile("" : "+v"(lane));
    const int wid = F.wave, r32 = lane & 31, hi = lane >> 5;
    const bf16_t* PROJ = (const bf16_t*)(F.ws + WS_PROJ) + (size_t)b * SEQ * PP;
    const float* FB2 = (const float*)(F.ws + WS_FB2) + (size_t)(b * 8 + h) * SEQ;
    bf16_t* YB = (bf16_t*)(F.ws + WS_YY) + (size_t)M * 512 + (size_t)b * SEQ * 512;
    LAS unsigned char* kv = F.lds;
    const int t0 = 256 * qb, tw0 = t0 + 32 * wid, t = tw0 + r32;
    const int kcol = C_FK + h * 64, vcol = C_FV + h * 64;
    bf16x8 qr[4];
#pragma unroll
    for (int d0 = 0; d0 < 4; ++d0) qr[d0] = *(const bf16x8*)(PROJ + (size_t)t * PP + C_FQ + h * 64 + d0 * 16 + hi * 8);
    f32x16 o0 = {}, o1 = {}; float m = NEGF, l = 0.f;
    const int NT = 4 * (qb + 1);
    __syncthreads();
    issue_kv(kv + ((NT - 1) & 1) * KVBUF, kptr<PP>(PROJ, (NT - 1) * 64, kcol, wid, lane), vptr<PP>(PROJ, (NT - 1) * 64, vcol, wid, lane), wid);
    for (int j = NT - 1; j >= 0; --j) {
        f32x16 c0, c1;
        const bool active = (64 * j <= tw0 + 31);
        if (active) {
            const float* fb = FB2 + 64 * j + 4 * hi;
#pragma unroll
            for (int q = 0; q < 4; ++q) { const f32x4 a = *(const f32x4*)(fb + 8 * q), bb = *(const f32x4*)(fb + 32 + 8 * q);
                c0[4 * q] = a[0]; c0[4 * q + 1] = a[1]; c0[4 * q + 2] = a[2]; c0[4 * q + 3] = a[3];
                c1[4 * q] = bb[0]; c1[4 * q + 1] = bb[1]; c1[4 * q + 2] = bb[2]; c1[4 * q + 3] = bb[3]; }
        }
        VM_WAIT(); __syncthreads();
        if (j > 0) issue_kv(kv + ((j - 1) & 1) * KVBUF, kptr<PP>(PROJ, (j - 1) * 64, kcol, wid, lane), vptr<PP>(PROJ, (j - 1) * 64, vcol, wid, lane), wid);
        if (active) {
            const LAS unsigned char* buf = kv + (j & 1) * KVBUF;
            if (64 * j + 63 > tw0) tile_step<true>(buf, qr, c0, c1, 0, t - 64 * j, o0, o1, m, l, lane);
            else tile_step<false>(buf, qr, c0, c1, 0, 63, o0, o1, m, l, lane);
        }
    }
    const float inv = 1.0f / half_swap_sum(l);
#pragma unroll
    for (int r = 0; r < 16; ++r) { o0[r] *= inv; o1[r] *= inv; }
    store_cols(YB + (size_t)t * 512 + h * 64, o0, o1, hi);
}

constexpr int IMP_OFF = 2 * KVBUF;
constexpr int SELM_OFF = IMP_OFF + 64 * 128 * 4;
constexpr int YSV_OFF = SELM_OFF + 1024;
__device__ __forceinline__ void nsa_unit(Frame& F, int b, int g, int cur) {
    int lane = F.lane; asm volatile("" : "+v"(lane));
    const int wid = F.wave, r32 = lane & 31, hi = lane >> 5;
    const bf16_t* PROJ = (const bf16_t*)(F.ws + WS_PROJ) + (size_t)b * SEQ * PP;
    const float* GATES = (const float*)(F.ws + WS_GATES) + (size_t)b * SEQ * 24;
    bf16_t* YA = (bf16_t*)(F.ws + WS_YY) + (size_t)b * SEQ * 512;
    LAS unsigned char* kv = F.lds;
    LAS float* IMP = (LAS float*)(F.lds + IMP_OFF);
    LAS unsigned* SELM = (LAS unsigned*)(F.lds + SELM_OFF);
    const int t0 = 64 * cur, ql = 8 * wid + (r32 >> 2), hl = r32 & 3, head = 4 * g + hl, t = t0 + ql;
    const float a = __builtin_amdgcn_exp2f(-(float)(head + 1)) * LOG2E;
    bf16x8 qr[4];
#pragma unroll
    for (int d0 = 0; d0 < 4; ++d0) qr[d0] = *(const bf16x8*)(PROJ + (size_t)t * PP + C_QA + head * 64 + d0 * 16 + hi * 8);
    const float* gp = GATES + (size_t)t * 24 + head * 3;
    LAS float* YSV = (LAS float*)(F.lds + YSV_OFF) + (wid * 64 + lane);
    float kc_r[16];
#pragma unroll
    for (int r = 0; r < 16; ++r) kc_r[r] = (float)((r & 3) + 8 * (r >> 2));
    {
        const bf16_t* KC = (const bf16_t*)(F.ws + WS_KC) + (size_t)(b * 2 + g) * 512 * 64;
        const bf16_t* VC = (const bf16_t*)(F.ws + WS_VC) + (size_t)(b * 2 + g) * 512 * 64;
        const int nmaxU = (t0 + 32) >> 4, ntile = (nmaxU >> 6) + 1;
        const int nmax_l = (t - 31) >> 4;
        const float a16 = a * 16.0f;
#pragma unroll
        for (int i = 0; i < 16; ++i) IMP[(8 * wid) * 128 + i * 64 + lane] = 0.f;
        float m = NEGF, l = 0.f;
        __syncthreads();
        issue_kv(kv, kptr<64>(KC, 0, 0, wid, lane), vptr<64>(VC, 0, 0, wid, lane), wid);
        for (int jt = 0; jt < ntile; ++jt) {
            VM_WAIT(); __syncthreads();
            if (jt + 1 < ntile) issue_kv(kv + ((jt + 1) & 1) * KVBUF, kptr<64>(KC, (jt + 1) * 64, 0, wid, lane), vptr<64>(VC, (jt + 1) * 64, 0, wid, lane), wid);
            const float base = a16 * (float)(64 * jt + 4 * hi);
            f32x16 p0, p1;
#pragma unroll
            for (int r = 0; r < 16; ++r) { p0[r] = fmaf(a16, kc_r[r], base); p1[r] = p0[r] + a16 * 32.0f; }
            qkt(p0, p1, kv + (jt & 1) * KVBUF, qr, r32, hi);
            const int lim = nmax_l - 64 * jt;
#pragma unroll
            for (int r = 0; r < 16; ++r) { const int kl = crow(r, hi); if (kl > lim) p0[r] = NEGF; if (kl + 32 > lim) p1[r] = NEGF; }
            const float rm = rowmax32(p0, p1), mn = fmaxf(m, rm);
            float s = 0.f;
#pragma unroll
            for (int r = 0; r < 16; ++r) { const int kl = crow(r, hi);
                s += (kl <= lim) ? __builtin_amdgcn_exp2f(p0[r] - mn) : 0.f; s += (kl + 32 <= lim) ? __builtin_amdgcn_exp2f(p1[r] - mn) : 0.f; }
            l = l * __builtin_amdgcn_exp2f(m - mn) + s; m = mn;
        }
        const float lt = half_swap_sum(l);
        const float inv = lt > 0.f ? 1.0f / lt : 0.f;
        f32x16 o0 = {}, o1 = {};
        __syncthreads();
        issue_kv(kv, kptr<64>(KC, 0, 0, wid, lane), vptr<64>(VC, 0, 0, wid, lane), wid);
        for (int jt = 0; jt < ntile; ++jt) {
            VM_WAIT(); __syncthreads();
            if (jt + 1 < ntile) issue_kv(kv + ((jt + 1) & 1) * KVBUF, kptr<64>(KC, (jt + 1) * 64, 0, wid, lane), vptr<64>(VC, (jt + 1) * 64, 0, wid, lane), wid);
            const float base = a16 * (float)(64 * jt + 4 * hi);
            f32x16 p0, p1;
#pragma unroll
            for (int r = 0; r < 16; ++r) { p0[r] = fmaf(a16, kc_r[r], base); p1[r] = p0[r] + a16 * 32.0f; }
            qkt(p0, p1, kv + (jt & 1) * KVBUF, qr, r32, hi);
            const int lim = nmax_l - 64 * jt;
#pragma unroll
            for (int r = 0; r < 16; ++r) { const int kl = crow(r, hi);
                p0[r] = (kl <= lim) ? __builtin_amdgcn_exp2f(p0[r] - m) * inv : 0.f; p1[r] = (kl + 32 <= lim) ? __builtin_amdgcn_exp2f(p1[r] - m) * inv : 0.f; }
#pragma unroll
            for (int r2 = 0; r2 < 4; ++r2) {
                float A0 = (p0[4 * r2] + p0[4 * r2 + 1]) + (p0[4 * r2 + 2] + p0[4 * r2 + 3]), L0 = p0[4 * r2 + 3];
                float A1 = (p1[4 * r2] + p1[4 * r2 + 1]) + (p1[4 * r2 + 2] + p1[4 * r2 + 3]), L1 = p1[4 * r2 + 3];
                A0 += __shfl_xor(A0, 1); A0 += __shfl_xor(A0, 2); L0 += __shfl_xor(L0, 1); L0 += __shfl_xor(L0, 2);
                A1 += __shfl_xor(A1, 1); A1 += __shfl_xor(A1, 2); L1 += __shfl_xor(L1, 1); L1 += __shfl_xor(L1, 2);
                if (hl == 0) {
                    const int j0 = 16 * jt + 2 * r2 + hi, j1 = j0 + 8;
                    LAS float* ip = IMP + ql * 128;
                    __hip_atomic_fetch_add(ip + j0, A0, __ATOMIC_RELAXED, __HIP_MEMORY_SCOPE_WORKGROUP);
                    __hip_atomic_fetch_add(ip + j0 + 1, L0, __ATOMIC_RELAXED, __HIP_MEMORY_SCOPE_WORKGROUP);
                    __hip_atomic_fetch_add(ip + j1, A1, __ATOMIC_RELAXED, __HIP_MEMORY_SCOPE_WORKGROUP);
                    if (j1 + 1 < 128) __hip_atomic_fetch_add(ip + j1 + 1, L1, __ATOMIC_RELAXED, __HIP_MEMORY_SCOPE_WORKGROUP);
                }
            }
            pv(o0, o1, kv + (jt & 1) * KVBUF, p0, p1, lane);
        }
        const float g0 = gp[0];
#pragma unroll
        for (int r = 0; r < 16; ++r) { YSV[r * 512] = g0 * o0[r]; YSV[(16 + r) * 512] = g0 * o1[r]; }
        LDS_WAIT();
        for (int qi = 0; qi < 8; ++qi) {
            const int q = 8 * wid + qi;
            const unsigned k0 = __float_as_uint(IMP[q * 128 + lane]), k1 = __float_as_uint(IMP[q * 128 + 64 + lane]);
            const bool c0 = (lane >= 1) && (lane <= cur - 2), c1 = (64 + lane <= cur - 2);
            unsigned long long s0, s1;
            if (cur - 2 <= 13) { s0 = __ballot(c0); s1 = __ballot(c1); }
            else {
                unsigned T = 0u;
                for (int bit = 30; bit >= 0; --bit) { const unsigned cand = T | (1u << bit);
                    const int cnt = __popcll(__ballot(c0 && k0 >= cand)) + __popcll(__ballot(c1 && k1 >= cand));
                    if (cnt >= 13) T = cand; }
                s0 = __ballot(c0 && k0 > T); s1 = __ballot(c1 && k1 > T);
                int need = 13 - __popcll(s0) - __popcll(s1);
                unsigned long long e0 = __ballot(c0 && k0 == T), e1 = __ballot(c1 && k1 == T);
                while (need > 0) { if (e0) { const unsigned long long bb = e0 & (0ull - e0); s0 |= bb; e0 ^= bb; } else if (e1) { const unsigned long long bb = e1 & (0ull - e1); s1 |= bb; e1 ^= bb; } else break; --need; }
            }
            s0 |= 1ull;
            if (cur < 64) s0 |= 1ull << cur; else s1 |= 1ull << (cur - 64);
            if (cur >= 1) { if (cur - 1 < 64) s0 |= 1ull << (cur - 1); else s1 |= 1ull << (cur - 65); }
            if (lane == 0) { SELM[q * 4 + 0] = (unsigned)s0; SELM[q * 4 + 1] = (unsigned)(s0 >> 32); SELM[q * 4 + 2] = (unsigned)s1; SELM[q * 4 + 3] = (unsigned)(s1 >> 32); }
        }
    }
    LDS_WAIT(); __syncthreads();
    unsigned um[4], mym[4];
#pragma unroll
    for (int w = 0; w < 4; ++w) { unsigned v = SELM[lane * 4 + w];
#pragma unroll
        for (int o = 1; o < 64; o <<= 1) v |= (unsigned)__shfl_xor((int)v, o);
        um[w] = (unsigned)__builtin_amdgcn_readfirstlane((int)v); mym[w] = SELM[ql * 4 + w]; }
    const float a64 = a * 64.0f;
    const bf16_t* PK = PROJ;
    {
        f32x16 o0 = {}, o1 = {}; float m = NEGF, l = 0.f;
        int j = cur, jn = next_below(um[0], um[1], um[2], um[3], cur), par = 0;
        __syncthreads();
        issue_kv(kv, kptr<PP>(PK, 64 * j, C_KSLC + g * 64, wid, lane), vptr<PP>(PK, 64 * j, C_VSLC + g * 64, wid, lane), wid);
        while (j >= 0) {
            VM_WAIT(); __syncthreads();
            if (jn >= 0) issue_kv(kv + (par ^ 1) * KVBUF, kptr<PP>(PK, 64 * jn, C_KSLC + g * 64, wid, lane), vptr<PP>(PK, 64 * jn, C_VSLC + g * 64, wid, lane), wid);
            const unsigned mw = (j < 32) ? mym[0] : (j < 64) ? mym[1] : (j < 96) ? mym[2] : mym[3];
            const bool mine = (mw >> (j & 31)) & 1u;
            const float base = mine ? (a64 * (float)(j - cur) + a * (float)(4 * hi)) : NEGF;
            f32x16 p0, p1;
#pragma unroll
            for (int r = 0; r < 16; ++r) { p0[r] = fmaf(a, kc_r[r], base); p1[r] = p0[r] + a * 32.0f; }
            if (j == cur) tile_step<true>(kv + par * KVBUF, qr, p0, p1, 0, ql, o0, o1, m, l, lane);
            else tile_step<false>(kv + par * KVBUF, qr, p0, p1, 0, 63, o0, o1, m, l, lane);
            j = jn; if (jn >= 0) jn = next_below(um[0], um[1], um[2], um[3], jn); par ^= 1;
        }
        const float sc = gp[1] / half_swap_sum(l);
#pragma unroll
        for (int r = 0; r < 16; ++r) { YSV[r * 512] += sc * o0[r]; YSV[(16 + r) * 512] += sc * o1[r]; }
    }
    {
        f32x16 o0 = {}, o1 = {}; float m = NEGF, l = 0.f;
        const int jlo = cur >= 8 ? cur - 8 : 0;
        __syncthreads();
        issue_kv(kv + (cur & 1) * KVBUF, kptr<PP>(PK, 64 * cur, C_KWIN + g * 64, wid, lane), vptr<PP>(PK, 64 * cur, C_VWIN + g * 64, wid, lane), wid);
        for (int j = cur; j >= jlo; --j) {
            VM_WAIT(); __syncthreads();
            if (j > jlo) issue_kv(kv + ((j - 1) & 1) * KVBUF, kptr<PP>(PK, 64 * (j - 1), C_KWIN + g * 64, wid, lane), vptr<PP>(PK, 64 * (j - 1), C_VWIN + g * 64, wid, lane), wid);
            const float base = a64 * (float)(j - cur) + a * (float)(4 * hi);
            f32x16 p0, p1;
#pragma unroll
            for (int r = 0; r < 16; ++r) { p0[r] = fmaf(a, kc_r[r], base); p1[r] = p0[r] + a * 32.0f; }
            const LAS unsigned char* buf = kv + (j & 1) * KVBUF;
            if (j == cur) tile_step<true>(buf, qr, p0, p1, 0, ql, o0, o1, m, l, lane);
            else if (j == cur - 8) tile_step<true>(buf, qr, p0, p1, ql + 1, 63, o0, o1, m, l, lane);
            else tile_step<false>(buf, qr, p0, p1, 0, 63, o0, o1, m, l, lane);
        }
        const float sc = gp[2] / half_swap_sum(l);
#pragma unroll
        for (int r = 0; r < 16; ++r) { o0[r] = YSV[r * 512] + sc * o0[r]; o1[r] = YSV[(16 + r) * 512] + sc * o1[r]; }
        store_cols(YA + (size_t)t * 512 + head * 64, o0, o1, hi);
    }
}
}
__device__ __forceinline__ void p3c_rows(Frame& F) {
    LAS float* WR = (LAS float*)F.lds;
    for (int i = F.tid; i < 4096; i += NWAVES * 64) { const int k = i >> 2, e = i & 3; WR[e * 1024 + k] = F.w_rg[i]; }
    for (int i = F.tid; i < 32768; i += NWAVES * 64) { const int k = i >> 5, e = i & 31; WR[(4 + e) * 1024 + k] = F.w_re[i]; }
    __syncthreads();
    const int gw = blockIdx.x * NWAVES + F.wave, NGW = F.G * NWAVES, lane = F.lane;
    const float* MIXED = (const float*)(F.ws + WS_YY); bf16_t* H2 = (bf16_t*)(F.ws + WS_HN);
    u32x2* LIST = (u32x2*)(F.ws + WS_LIST);
    f32x4 gpost[4], gpre[4]; ld_row4(F.g_post_mix, lane, gpost); ld_row4(F.g_pre_ffn, lane, gpre);
    int curb = -1; f32x4 gt[4], mul[4], add[4];
    for (int m = gw; m < M; m += NGW) {
        const int b = m >> 13;
        if (b != curb) { f32x4 sc[4]; mod_final(F, b, 2, gt); mod_final(F, b, 3, add); mod_final(F, b, 4, sc); curb = b;
#pragma unroll
            for (int j = 0; j < 4; ++j) { gt[j] = gt[j] * gpost[j]; mul[j] = gpre[j] * (sc[j] + 1.0f); } }
        f32x4 v[4], xr[4]; ld_row4(MIXED + (size_t)m * DM, lane, v); ld_row4(F.x + (size_t)m * DM, lane, xr);
        const float rstd = 1.0f / sqrtf(wave_sum(sumsq4(v)) * (1.0f / DM) + NORM_EPS);
#pragma unroll
        for (int j = 0; j < 4; ++j) { xr[j] = xr[j] + gt[j] * (v[j] * rstd); *(f32x4*)(F.out + (size_t)m * DM + 256 * j + 4 * lane) = xr[j]; }
        const float rstd2 = 1.0f / sqrtf(wave_sum(sumsq4(xr)) * (1.0f / DM) + NORM_EPS);
#pragma unroll
        for (int j = 0; j < 4; ++j) v[j] = xr[j] * rstd2 * mul[j] + add[j];
        st_row_bf16(H2 + (size_t)m * DM, lane, v);
        float lg[4];
#pragma unroll
        for (int e = 0; e < 4; ++e) { float s = 0.f;
#pragma unroll
            for (int j = 0; j < 4; ++j) { const f32x4 w = *(const LAS f32x4*)(WR + e * 1024 + 256 * j + 4 * lane); s += (v[j][0] * w[0] + v[j][1] * w[1]) + (v[j][2] * w[2] + v[j][3] * w[3]); }
            lg[e] = wave_sum(s) + F.b_rg[e]; }
        float pe[32];
#pragma unroll
        for (int e = 0; e < 32; ++e) { float s = 0.f;
#pragma unroll
            for (int j = 0; j < 4; ++j) { const f32x4 w = *(const LAS f32x4*)(WR + (4 + e) * 1024 + 256 * j + 4 * lane); s += (v[j][0] * w[0] + v[j][1] * w[1]) + (v[j][2] * w[2] + v[j][3] * w[3]); }
            pe[e] = s;
            if ((e & 3) == 3) asm volatile("" ::: "memory"); }
        { const bool b5 = (lane & 32) != 0;
#pragma unroll
          for (int i = 0; i < 16; ++i) { const float keep = b5 ? pe[i + 16] : pe[i], give = b5 ? pe[i] : pe[i + 16]; pe[i] = keep + __shfl_xor(give, 32); } }
        { const bool b4 = (lane & 16) != 0;
#pragma unroll
          for (int i = 0; i < 8; ++i) { const float keep = b4 ? pe[i + 8] : pe[i], give = b4 ? pe[i] : pe[i + 8]; pe[i] = keep + __shfl_xor(give, 16); } }
        { const bool b3 = (lane & 8) != 0;
#pragma unroll
          for (int i = 0; i < 4; ++i) { const float keep = b3 ? pe[i + 4] : pe[i], give = b3 ? pe[i] : pe[i + 4]; pe[i] = keep + __shfl_xor(give, 8); } }
        { const bool b2 = (lane & 4) != 0;
#pragma unroll
          for (int i = 0; i < 2; ++i) { const float keep = b2 ? pe[i + 2] : pe[i], give = b2 ? pe[i] : pe[i + 2]; pe[i] = keep + __shfl_xor(give, 4); } }
        { const bool b1 = (lane & 2) != 0; const float keep = b1 ? pe[1] : pe[0], give = b1 ? pe[0] : pe[1]; pe[0] = keep + __shfl_xor(give, 2); }
        const float le_l = pe[0] + __shfl_xor(pe[0], 1);
        int gi = 0; float gm = lg[0];
#pragma unroll
        for (int e = 1; e < 4; ++e) if (lg[e] > gm) { gm = lg[e]; gi = e; }
        float gs = 0.f;
#pragma unroll
        for (int e = 0; e < 4; ++e) gs += __expf(lg[e] - gm);
        const float pg = 1.0f / gs;
        float l0 = -INFINITY, l1 = -INFINITY; int e0 = 0, e1 = 0;
#pragma unroll
        for (int i = 0; i < 8; ++i) { const float lv = __shfl(le_l, 2 * (gi * 8 + i)) + F.b_re[gi * 8 + i];
            if (lv > l0) { l1 = l0; e1 = e0; l0 = lv; e0 = i; } else if (lv > l1) { l1 = lv; e1 = i; } }
        const float w0 = 1.0f / (1.0f + __expf(l1 - l0)), w1 = 1.0f - w0;
        if (lane == 0) {
            const int x0 = gi * 8 + e0, x1 = gi * 8 + e1;
            const unsigned r0 = __hip_atomic_fetch_add(F.ctl + CW_ECNT + 64 * x0, 1u, RLX_AGENT);
            const unsigned r1 = __hip_atomic_fetch_add(F.ctl + CW_ECNT + 64 * x1, 1u, RLX_AGENT);
            u32x2 a; a.x = (unsigned)(2 * m); a.y = __float_as_uint(pg * w0); LIST[(size_t)x0 * M + r0] = a;
            u32x2 c; c.x = (unsigned)(2 * m + 1); c.y = __float_as_uint(pg * w1); LIST[(size_t)x1 * M + r1] = c;
        }
    }
}
__device__ __forceinline__ void p5_rows(Frame& F) {
    const int gw = blockIdx.x * NWAVES + F.wave, NGW = F.G * NWAVES, lane = F.lane;
    const bf16_t* Y2 = (const bf16_t*)(F.ws + WS_YY);
    f32x4 gpost[4]; ld_row4(F.g_post_ffn, lane, gpost);
    int curb = -1; f32x4 gt[4];
    for (int m = gw; m < M; m += NGW) {
        const int b = m >> 13;
        if (b != curb) { mod_final(F, b, 5, gt); curb = b;
#pragma unroll
            for (int j = 0; j < 4; ++j) gt[j] = gt[j] * gpost[j]; }
        f32x4 y[4], xr[4]; ld_row4(F.out + (size_t)m * DM, lane, xr);
#pragma unroll
        for (int j = 0; j < 4; ++j) { const u32x2 a = *(const u32x2*)(Y2 + (size_t)(2 * m) * DM + 256 * j + 4 * lane), c = *(const u32x2*)(Y2 + (size_t)(2 * m + 1) * DM + 256 * j + 4 * lane);
            y[j] = (f32x4){bflo(a.x) + bflo(c.x), bfhi(a.x) + bfhi(c.x), bflo(a.y) + bflo(c.y), bfhi(a.y) + bfhi(c.y)}; }
        const float rstd = 1.0f / sqrtf(wave_sum(sumsq4(y)) * (1.0f / DM) + NORM_EPS);
#pragma unroll
        for (int j = 0; j < 4; ++j) *(f32x4*)(F.out + (size_t)m * DM + 256 * j + 4 * lane) = xr[j] + gt[j] * (y[j] * rstd);
    }
}

#ifndef MK_N_LAUNCHES
#define MK_N_LAUNCHES 1
#endif
constexpr int N_PHASES = 11;
struct Args { const float* in[26]; float* out; unsigned char* ws; int ph_lo, ph_hi; };
__global__ void __launch_bounds__(NWAVES * 64, 2) fwd_kernel(Args args) {
    extern __shared__ __attribute__((aligned(16))) unsigned char lds[];
    Frame F;
    F.lds = (LAS unsigned char*)lds;
    F.MISC = (volatile LAS unsigned*)(F.lds + MISC_OFF);
    F.tid = threadIdx.x; F.lane = F.tid & 63; F.wave = __builtin_amdgcn_readfirstlane(F.tid >> 6); F.G = gridDim.x;
    F.ws = args.ws; F.ctl = (unsigned*)(args.ws + WS_CTL); F.out = args.out;
    F.x = args.in[0]; F.c = args.in[1]; F.w_ada = args.in[2]; F.b_ada = args.in[3]; F.g_pre_mix = args.in[4]; F.g_post_mix = args.in[5]; F.g_pre_ffn = args.in[6]; F.g_post_ffn = args.in[7];
    F.w_in = args.in[8]; F.b_forget = args.in[9]; F.pe_k = args.in[10]; F.w1_k = args.in[11]; F.w2_k = args.in[12]; F.pe_v = args.in[13]; F.w1_v = args.in[14]; F.w2_v = args.in[15];
    F.w_o_nsa = args.in[16]; F.w_o_fox = args.in[17]; F.w_out = args.in[18]; F.w_rg = args.in[19]; F.b_rg = args.in[20]; F.w_re = args.in[21]; F.b_re = args.in[22];
    F.w_eg = args.in[23]; F.w_eu = args.in[24]; F.w_ed = args.in[25];
    for (int u = F.tid; u < 256; u += NWAVES * 64) F.MISC[u] = 0u;
    __syncthreads();
    const int lo = args.ph_lo, hi = args.ph_hi;
    XcdBarrier bar; bar.bar = F.ctl + CW_BAR; bar.x = 0; bar.st = nullptr;
    if (hi - lo > 1) bar = xcd_barrier_post(F.ctl + CW_BAR, F.MISC + 8);
#ifndef PH_MASK
#define PH_MASK 0x7ff
#endif
#define IN(k) (((PH_MASK >> (k)) & 1) && lo <= (k) && (k) < hi)
#define SEAM(k) do { if (IN(k) && IN((k) + 1)) xcd_barrier(bar); } while (0)
    bf16_t* const HN = (bf16_t*)(F.ws + WS_HN);
    bf16_t* const PROJ = (bf16_t*)(F.ws + WS_PROJ);
    if (IN(0)) { p0_prologue(F); SEAM(0); }
    if (IN(1)) { p0b_rows(F); SEAM(1); }
    if (IN(2)) {
        pg8::Gemm g{HN, (const bf16_t*)(F.ws + WS_WINT), M, NPAD, DM}; pg8::StaticOrder S; S.init(M, NPAD, F.G, (int)blockIdx.x);
        EpiProj E{PROJ, (float*)(F.ws + WS_GATES), (float*)(F.ws + WS_LF), F.b_forget};
        pg8::gemm_phase<false>(F.lds, g, S, E, pg8::NoGather{});
        SEAM(2);
    }
    if (IN(3)) {
        for (int it = blockIdx.x; it < 144; it += F.G) { if (it < 128) p2a_item_cmp(F, it); else p2a_item_cumsum(F, it - 128); }
        SEAM(3);
    }
    if (IN(4)) {
        for (;;) {
            __syncthreads();
            if (F.tid == 0) F.MISC[16] = __hip_atomic_fetch_add(F.ctl + CW_QCTR, 1u, RLX_AGENT);
            __syncthreads();
            const int idx = (int)F.MISC[16];
            if (idx >= 1024) break;
            const int lev = 31 - (idx >> 5), w = idx & 31;
#ifndef ATT_NO_FOX
            if (w < 16) att::fox_unit(F, w >> 3, w & 7, lev);
#endif
#ifndef ATT_NO_NSA
            if (w >= 16) { const int k = w - 16; att::nsa_unit(F, (k & 3) >> 1, k & 1, 4 * lev + 3 - (k >> 2)); }
#endif
        }
        SEAM(4);
    }
    if (IN(5)) {
        pg8::Gemm g{(const bf16_t*)(F.ws + WS_YY), (const bf16_t*)(F.ws + WS_WOT), 2 * M, 2048, 512}; OutOrder S{F.G, (int)blockIdx.x};
        EpiOut E{HN, PROJ};
        pg8::gemm_phase<false>(F.lds, g, S, E, pg8::NoGather{});
        SEAM(5);
    }
    if (IN(6)) {
        pg8::Gemm g{HN, (const bf16_t*)(F.ws + WS_WOUTT), M, DM, DM}; pg8::StaticOrder S; S.init(M, DM, F.G, (int)blockIdx.x);
        EpiF32 E{(float*)(F.ws + WS_YY), DM};
        pg8::gemm_phase<false>(F.lds, g, S, E, pg8::NoGather{});
        expert_convert(F);
        SEAM(6);
    }
    if (IN(7)) { __syncthreads(); p3c_rows(F); SEAM(7); }
    if (IN(8) || IN(9)) {
        __syncthreads();
        if (F.tid < 32) F.MISC[96 + F.tid] = __hip_atomic_load(F.ctl + CW_ECNT + 64 * F.tid, RLX_AGENT);
        __syncthreads();
        if (F.tid == 0) { unsigned s = 0; for (int e = 0; e < 32; ++e) { F.MISC[32 + e] = s; s += (F.MISC[96 + e] + 255u) >> 8; } F.MISC[64] = s; }
        __syncthreads();
    }
    if (IN(8)) {
        pg8::Gemm g{HN, (const bf16_t*)(F.ws + WS_WGUT), M, 32768, DM}; MoeOrder S{F.MISC + 32, F.G, (int)blockIdx.x};
        EpiSwiglu E{(bf16_t*)(F.ws + WS_HBUF)}; MoeGather GT{(const u32x2*)(F.ws + WS_LIST), F.MISC + 32, F.MISC + 96};
        pg8::gemm_phase<true>(F.lds, g, S, E, GT);
        SEAM(8);
    }
    if (IN(9)) {
        pg8::Gemm g{(const bf16_t*)(F.ws + WS_HBUF), (const bf16_t*)(F.ws + WS_WDT), HROWS_MAX, 32768, DEXP}; MoeOrder S{F.MISC + 32, F.G, (int)blockIdx.x};
        EpiDown E{(bf16_t*)(F.ws + WS_YY), (const u32x2*)(F.ws + WS_LIST), F.MISC + 32, F.MISC + 96};
        pg8::gemm_phase<false>(F.lds, g, S, E, pg8::NoGather{});
        SEAM(9);
    }
    if (IN(10)) { p5_rows(F); }
#undef IN
#undef SEAM
}

extern "C" void kernel_launch(void* const* d_in, const int* in_sizes, int n_in, void* d_out, int out_size, void* d_ws, size_t ws_size, hipStream_t stream) {
    static int grid = 0;
    if (grid == 0) {
        if (n_in != 26 || in_sizes[0] != M * DM || out_size != M * DM || ws_size < WS_END) { fprintf(stderr, "kernel_launch: unexpected shapes (n_in %d, in0 %d, out %d, ws %zu < %zu); nothing launched\n", n_in, n_in > 0 ? in_sizes[0] : -1, out_size, ws_size, (size_t)WS_END); grid = -1; return; }
        int dev = 0, cus = 0, per_cu = 0;
        if (hipGetDevice(&dev) != hipSuccess || hipDeviceGetAttribute(&cus, hipDeviceAttributeMultiprocessorCount, dev) != hipSuccess) { grid = -1; return; }
        if (hipFuncSetAttribute((const void*)fwd_kernel, hipFuncAttributeMaxDynamicSharedMemorySize, LDS_BYTES) != hipSuccess) { fprintf(stderr, "kernel_launch: hipFuncSetAttribute failed\n"); grid = -1; return; }
        if (hipOccupancyMaxActiveBlocksPerMultiprocessor(&per_cu, (const void*)fwd_kernel, NWAVES * 64, LDS_BYTES) != hipSuccess || per_cu < 1) { fprintf(stderr, "kernel_launch: occupancy query failed (%d)\n", per_cu); per_cu = 1; }
        (void)hipGetLastError();
        grid = cus * (per_cu > 1 ? 1 : per_cu);
    }
    if (grid < 0) return;
    if (hipMemsetAsync((char*)d_ws + WS_CTL, 0, CTL_ZERO_BYTES, stream) != hipSuccess) { fprintf(stderr, "kernel_launch: memset failed\n"); return; }
    Args a{};
    for (int i = 0; i < 26; ++i) a.in[i] = (const float*)d_in[i];
    a.out = (float*)d_out; a.ws = (unsigned char*)d_ws;
#if MK_N_LAUNCHES == 1
    a.ph_lo = 0; a.ph_hi = N_PHASES;
    void* kargs[] = {&a};
    const hipError_t le = hipLaunchCooperativeKernel((const void*)fwd_kernel, dim3(grid), dim3(NWAVES * 64), kargs, LDS_BYTES, stream);
    if (le != hipSuccess) fprintf(stderr, "kernel_launch: cooperative launch failed: %s (grid %d)\n", hipGetErrorName(le), grid);
#else
    for (int p = 0; p < N_PHASES; ++p) {
        a.ph_lo = p; a.ph_hi = p + 1;
        hipLaunchKernelGGL(fwd_kernel, dim3(grid), dim3(NWAVES * 64), LDS_BYTES, stream, a);
    }
    const hipError_t le = hipPeekAtLastError();
    if (le != hipSuccess) fprintf(stderr, "kernel_launch: launch failed: %s\n", hipGetErrorName(le));
#endif
}
```

```cpp
#include <hip/hip_runtime.h>
#include <hip/hip_bf16.h>
#include <cstdio>
#include <cstdint>
#include <cmath>

#define LAS __attribute__((address_space(3)))
#define GAS __attribute__((address_space(1)))
typedef unsigned short bf16_t;
typedef short bf16x8 __attribute__((ext_vector_type(8)));
typedef short s16x4 __attribute__((ext_vector_type(4)));
typedef float f32x4 __attribute__((ext_vector_type(4)));
typedef float f32x2 __attribute__((ext_vector_type(2)));
typedef float f32x16 __attribute__((ext_vector_type(16)));
typedef unsigned u32x4 __attribute__((ext_vector_type(4)));
typedef unsigned u32x2 __attribute__((ext_vector_type(2)));
typedef __bf16 bf16x2_t __attribute__((ext_vector_type(2)));

__device__ __forceinline__ unsigned cvtpk(float lo, float hi) { f32x2 v = {lo, hi}; bf16x2_t b = __builtin_convertvector(v, bf16x2_t); return __builtin_bit_cast(unsigned, b); }
__device__ __forceinline__ float bf2f(unsigned short h) { return __uint_as_float(((unsigned)h) << 16); }
__device__ __forceinline__ float bflo(unsigned w) { return __uint_as_float(w << 16); }
__device__ __forceinline__ float bfhi(unsigned w) { return __uint_as_float(w & 0xffff0000u); }
__device__ __forceinline__ float sigmoidf_(float x) { return 1.0f / (1.0f + __expf(-x)); }

namespace pg8 {
constexpr int BM = 256, BK = 64, HALF = 128, HTB = HALF * BK * 2  , STAGE_BYTES = 8 * HTB, NXCD = 8, WGM = 8;

__host__ __device__ __forceinline__ int lds_byte(int r, int c) { const int st = (r >> 4) * 2 + (c >> 5), rr = r & 15, cc = c & 31, ob = rr * 64 + cc * 2; return st * 1024 + (ob ^ (((ob >> 9) & 1) << 5)); }
__host__ __device__ __forceinline__ void stage_rc(int b, int& R, int& C) { const int st = b / 1024, sb = b % 1024, swz = sb ^ (((sb >> 9) & 1) << 5); R = (st >> 1) * 16 + swz / 64; C = (st & 1) * 32 + (swz % 64) / 2; }
__host__ __device__ __forceinline__ int perm32(int rho) { const int n = rho >> 4, i = rho & 15; return 8 * (i >> 2) + 4 * n + (i & 3); }

struct Unit { int pm, pn; };
struct Gemm { const bf16_t* A; const bf16_t* Bt; int M, N, K; };

struct StaticOrder {
    int nM, nN, nwg, G, c;
    __host__ __device__ void init(int M, int N, int G_, int c_) { nM = M / BM; nN = N / BM; nwg = nM * nN; G = G_; c = c_; }
    __host__ __device__ bool next(int i, Unit& u) const {
        const long L = (long)i * G + c; if (L >= nwg) return false;
        int wgid = (int)L; { const int q = nwg / NXCD, r = nwg % NXCD, xcd = wgid % NXCD, off = wgid / NXCD; wgid = (xcd < r ? xcd * (q + 1) : r * (q + 1) + (xcd - r) * q) + off; }
        const int nig = WGM * nN, gid = wgid / nig, fm = gid * WGM, gsz = (nM - fm) < WGM ? (nM - fm) : WGM;
        u.pm = fm + ((wgid % nig) % gsz); u.pn = (wgid % nig) / gsz; return true;
    }
};
struct NoGather { __device__ __forceinline__ int row(const Unit&, int) const { return 0; } };

template <bool GATHER, class Epi, class Sched, class Gath>
__device__ __forceinline__ void gemm_phase(LAS unsigned char* lds, const Gemm g, const Sched& S, const Epi& E, const Gath& GT) {
    const int tid = threadIdx.x, wid = __builtin_amdgcn_readfirstlane(tid >> 6), lane = tid & 63, wr = wid >> 2, wc = wid & 3, fr = lane & 15, fq = lane >> 4;
    const int K = g.K, nt = K / BK;
    unsigned voffA[2], voffB[2];
#pragma unroll
    for (int i = 0; i < 2; ++i) { int R, C; stage_rc(tid * 16 + i * 8192, R, C); const int Rb = (R & ~31) + perm32(R & 31);
        voffA[i] = (unsigned)(R * K + C) * 2u; voffB[i] = (unsigned)(Rb * K + C) * 2u; }
    const size_t kstep = (size_t)(BK * 2);
    const size_t hstep = (size_t)HALF * K * 2;
    const size_t tstep = 2 * hstep;
    const unsigned ldsw = (unsigned)wid * 1024u;
    const int aoff = lds_byte(wr * 64 + fr, fq * 8), boff = lds_byte(wc * 32 + fr, fq * 8);
#define PG8_SA(b, h) (((b) * 2 + (h)) * HTB)
#define PG8_SB(b, h) ((4 + (b) * 2 + (h)) * HTB)
#define PG8_STG2(bufoff, gbase, o0, o1) do { \
        __builtin_amdgcn_global_load_lds((const unsigned*)((const char*)(gbase) + (o0)), (LAS unsigned*)(lds + (bufoff) + ldsw), 16, 0, 0); \
        __builtin_amdgcn_global_load_lds((const unsigned*)((const char*)(gbase) + (o1)), (LAS unsigned*)(lds + (bufoff) + ldsw + 8192), 16, 0, 0); } while (0)
#define PG8_STAGE(bufoff, gbase, voff) PG8_STG2(bufoff, gbase, (voff)[0], (voff)[1])
#define PG8_STAGE_A(bufoff, h, kt, NX) do { if constexpr (GATHER) { const char* _b = (const char*)g.A + (size_t)(kt) * kstep; \
            const u32x2 _o = *(const LAS u32x2*)(gtab + ((NX) ? 4 : 0) + (h) * 2); PG8_STG2(bufoff, _b, _o.x, _o.y); } \
        else { const char* _b = ((NX) ? nA : cA) + (size_t)(h) * hstep + (size_t)(kt) * kstep; PG8_STG2(bufoff, _b, voffA[0], voffA[1]); } } while (0)
#define PG8_GOFF(U, s) do { _Pragma("unroll") for (int _h = 0; _h < 2; ++_h) _Pragma("unroll") for (int _i = 0; _i < 2; ++_i) { int _R, _C; stage_rc(tid * 16 + _i * 8192, _R, _C); \
            gtab[(s) * 4 + _h * 2 + _i] = (unsigned)(GT.row(U, _h * HALF + _R) * K + _C) * 2u; } } while (0)
#define PG8_LDA(dst, b, h) do { _Pragma("unroll") for (int m = 0; m < 4; ++m) _Pragma("unroll") for (int k = 0; k < 2; ++k) dst[m][k] = *(const LAS bf16x8*)(lds + PG8_SA(b, h) + aoff + m * 2048 + k * 1024); } while (0)
#define PG8_LDB(dst, b, h) do { _Pragma("unroll") for (int n = 0; n < 2; ++n) _Pragma("unroll") for (int k = 0; k < 2; ++k) dst[n][k] = *(const LAS bf16x8*)(lds + PG8_SB(b, h) + boff + n * 2048 + k * 1024); } while (0)
#define PG8_MMA(ai, bj, At, Bt) do { __builtin_amdgcn_s_setprio(1); _Pragma("unroll") for (int m = 0; m < 4; ++m) _Pragma("unroll") for (int n = 0; n < 2; ++n) _Pragma("unroll") for (int k = 0; k < 2; ++k) \
        acc[ai][bj][m][n] = __builtin_amdgcn_mfma_f32_16x16x32_bf16(Bt[n][k], At[m][k], acc[ai][bj][m][n], 0, 0, 0); __builtin_amdgcn_s_setprio(0); } while (0)
#define PG8_WAIT_V(n) asm volatile("s_waitcnt vmcnt(" #n ")" ::: "memory")
#define PG8_WAIT_L(n) asm volatile("s_waitcnt lgkmcnt(" #n ")" ::: "memory")
#define PG8_BAR __builtin_amdgcn_s_barrier()
#define PG8_SCHED __builtin_amdgcn_sched_barrier(0)
    Unit cur, nxt; int ui = 0;
    if (!S.next(0, cur)) return;
    f32x4 acc[2][2][4][2];
#pragma unroll
    for (int a = 0; a < 2; ++a)
#pragma unroll
        for (int b = 0; b < 2; ++b)
#pragma unroll
            for (int m = 0; m < 4; ++m)
#pragma unroll
                for (int n = 0; n < 2; ++n) acc[a][b][m][n] = (f32x4){0.f, 0.f, 0.f, 0.f};
    bf16x8 At[4][2], B0[2][2], B1[2][2];
    LAS unsigned* const gtab = (LAS unsigned*)(lds + STAGE_BYTES) + tid * 8;
    const char* cA = (const char*)g.A + (size_t)cur.pm * tstep; const char* cB = (const char*)g.Bt + (size_t)cur.pn * tstep;
    const char* nA = cA;
    if constexpr (GATHER) { PG8_GOFF(cur, 0); }
    PG8_STAGE(PG8_SB(0, 0), cB, voffB); PG8_STAGE(PG8_SB(0, 1), cB + hstep, voffB); PG8_STAGE_A(PG8_SA(0, 0), 0, 0, false); PG8_STAGE_A(PG8_SA(0, 1), 1, 0, false);
    if (wr == 1) PG8_BAR;
    PG8_WAIT_V(2); PG8_BAR;
    PG8_STAGE(PG8_SB(1, 0), cB + kstep, voffB); PG8_STAGE_A(PG8_SA(1, 0), 0, 1, false); PG8_STAGE(PG8_SB(1, 1), cB + hstep + kstep, voffB);
    PG8_WAIT_V(6); PG8_BAR;
    for (;;) {
        const bool has_next = S.next(ui + 1, nxt);
        nA = has_next ? (const char*)g.A + (size_t)nxt.pm * tstep : cA; const char* nB = has_next ? (const char*)g.Bt + (size_t)nxt.pn * tstep : cB;
        if constexpr (GATHER) { if (has_next) PG8_GOFF(nxt, 1); else { *(LAS u32x4*)(gtab + 4) = *(const LAS u32x4*)gtab; } }
        for (int t = 0; t < nt; t += 2) {
            const bool last = (t == nt - 2);
            const char* b2 = last ? nB : cB + (size_t)(t + 2) * kstep;
            const char* b3 = b2 + kstep;
            const int k2 = last ? 0 : t + 2, k3 = k2 + 1;
            PG8_LDB(B0, 0, 0); PG8_LDB(B1, 0, 1); PG8_SCHED; PG8_LDA(At, 0, 0); PG8_STAGE_A(PG8_SA(1, 1), 1, t + 1, false);
            PG8_WAIT_V(8); PG8_WAIT_L(0); PG8_BAR; PG8_MMA(0, 0, At, B0); PG8_MMA(0, 1, At, B1); PG8_BAR; PG8_SCHED;
            PG8_LDA(At, 0, 1); PG8_STAGE(PG8_SB(0, 0), b2, voffB); PG8_STAGE(PG8_SB(0, 1), b2 + hstep, voffB);
            if (last) PG8_STAGE_A(PG8_SA(0, 0), 0, k2, true); else PG8_STAGE_A(PG8_SA(0, 0), 0, k2, false);
            PG8_WAIT_V(8); PG8_WAIT_L(0); PG8_BAR; PG8_MMA(1, 0, At, B0); PG8_MMA(1, 1, At, B1); PG8_BAR; PG8_SCHED;
            PG8_LDB(B0, 1, 0); PG8_LDB(B1, 1, 1); PG8_SCHED; PG8_LDA(At, 1, 0);
            if (last) PG8_STAGE_A(PG8_SA(0, 1), 1, k2, true); else PG8_STAGE_A(PG8_SA(0, 1), 1, k2, false);
            PG8_WAIT_V(8); PG8_WAIT_L(0); PG8_BAR; PG8_MMA(0, 0, At, B0); PG8_MMA(0, 1, At, B1); PG8_BAR; PG8_SCHED;
            PG8_LDA(At, 1, 1); PG8_STAGE(PG8_SB(1, 0), b3, voffB); PG8_STAGE(PG8_SB(1, 1), b3 + hstep, voffB);
            if (last) PG8_STAGE_A(PG8_SA(1, 0), 0, k3, true); else PG8_STAGE_A(PG8_SA(1, 0), 0, k3, false);
            PG8_WAIT_V(8); PG8_WAIT_L(0); PG8_BAR; PG8_MMA(1, 0, At, B0); PG8_MMA(1, 1, At, B1); PG8_BAR; PG8_SCHED;
        }
        if (wr == 0) PG8_BAR;
        E(acc, cur, wr, wc, fr, fq);
        if (!has_next) break;
#pragma unroll
        for (int a = 0; a < 2; ++a)
#pragma unroll
            for (int b = 0; b < 2; ++b)
#pragma unroll
                for (int m = 0; m < 4; ++m)
#pragma unroll
                    for (int n = 0; n < 2; ++n) acc[a][b][m][n] = (f32x4){0.f, 0.f, 0.f, 0.f};
        cur = nxt; cA = nA; cB = nB; ++ui;
        if constexpr (GATHER) { *(LAS u32x4*)gtab = *(const LAS u32x4*)(gtab + 4); }
        if (wr == 1) PG8_BAR;
    }
    PG8_WAIT_V(0);
    PG8_BAR;
#undef PG8_SA
#undef PG8_SB
#undef PG8_STG2
#undef PG8_STAGE
#undef PG8_STAGE_A
#undef PG8_GOFF
#undef PG8_LDA
#undef PG8_LDB
#undef PG8_MMA
#undef PG8_WAIT_V
#undef PG8_WAIT_L
#undef PG8_BAR
#undef PG8_SCHED
}
}
constexpr int NWAVES = 8;
constexpr int BATCH = 2, SEQ = 8192, DM = 1024, M = BATCH * SEQ;
constexpr int DIN = 4896, PP = 4864  , NPAD = 5120  ;
constexpr int C_QA = 0, C_KCMP = 512, C_VCMP = 640, C_KSLC = 768, C_VSLC = 896, C_KWIN = 1024, C_VWIN = 1152, C_FQ = 1280, C_FK = 1792, C_FV = 2304, C_MG = 2816;
constexpr float LOG2E = 1.4426950408889634f;
constexpr float C2 = 0.125f * LOG2E;
constexpr float NORM_EPS = 1e-6f;
constexpr float NEGF = -1e30f;
constexpr int NEXP = 32, DEXP = 512;
constexpr int HROWS_MAX = 2 * M + NEXP * 256;

constexpr size_t MiB = 1u << 20;
constexpr size_t WS_CTL = 0, CTL_ZERO_BYTES = 1 * MiB;
constexpr size_t WS_MODP = 1 * MiB;
constexpr size_t WS_MOD = WS_MODP + 512 * 1024;
constexpr size_t WS_PEB = WS_MOD + 64 * 1024;
constexpr size_t WS_W1T = WS_PEB + 64 * 1024;
constexpr size_t WS_KC = WS_W1T + 512 * 1024;
constexpr size_t WS_VC = WS_KC + 256 * 1024;
constexpr size_t WS_FB2 = WS_VC + 256 * 1024;
constexpr size_t WS_LF = WS_FB2 + 512 * 1024;
constexpr size_t WS_GATES = WS_LF + 512 * 1024;
constexpr size_t WS_ROUTE = WS_GATES + 1536 * 1024;
constexpr size_t WS_LIST = 6 * MiB;
constexpr size_t WS_WINT = 10 * MiB;
constexpr size_t WS_WOT = 20 * MiB;
constexpr size_t WS_WOUTT = 22 * MiB;
constexpr size_t WS_HN = 24 * MiB;
constexpr size_t WS_PROJ = 56 * MiB;
constexpr size_t WS_WGUT = WS_PROJ;
constexpr size_t WS_WDT = WS_PROJ + 64 * MiB;
constexpr size_t WS_HBUF = WS_PROJ + 96 * MiB;
constexpr size_t WS_YY = 208 * MiB;
constexpr size_t WS_END = 272 * MiB;
static_assert(WS_ROUTE + 64 * 1024 <= WS_LIST && WS_LIST + 4 * MiB <= WS_WINT && WS_HBUF + (size_t)HROWS_MAX * 1024 <= WS_YY, "d_ws map");
constexpr int CW_QCTR = 64;
constexpr int CW_ECNT = 128;
constexpr int CW_BAR = 4096;

constexpr int RING_BYTES = 131072;
constexpr int LDS_BYTES = 163840;
constexpr int MISC_OFF = 160 * 1024 - 1024;

#define RLX_AGENT __ATOMIC_RELAXED, __HIP_MEMORY_SCOPE_AGENT
#define LDS_WAIT() asm volatile("s_waitcnt lgkmcnt(0)" ::: "memory")
#define VM_WAIT() asm volatile("s_waitcnt vmcnt(0)" ::: "memory")

#define XB_TMO      128
#define XB_XCNT(j)  (256  + 64 * (j))
#define XB_XSUB(j)  (1280 + 64 * (j))
#define XB_XGEN(j)  (2304 + 64 * (j))
#define XB_TOP      3328
#define XB_TOPGEN   3392
#define XCD_BAR_WORDS 3456
#define XB_SPIN_CAP (1u << 22)
__device__ __forceinline__ unsigned xb_ld(unsigned* p)              { return __hip_atomic_load(p, __ATOMIC_RELAXED, __HIP_MEMORY_SCOPE_AGENT); }
__device__ __forceinline__ unsigned xb_add(unsigned* p, unsigned v) { return __hip_atomic_fetch_add(p, v, __ATOMIC_RELAXED, __HIP_MEMORY_SCOPE_AGENT); }
__device__ __forceinline__ unsigned xb_xcc_id() { return (unsigned)__builtin_amdgcn_s_getreg((3 << 11) | 20) & 0xFu; }
#define XB_SPIN(cond, bar) do { unsigned _sp = 0; while (cond) { __builtin_amdgcn_s_sleep(1); \
    if ((++_sp & 255u) == 0u) { if (xb_ld(&(bar)[XB_TMO])) break; if (_sp > XB_SPIN_CAP) { atomicAdd(&(bar)[XB_TMO], 1u); break; } } } } while (0)
struct XcdBarrier { unsigned* bar; unsigned x; volatile LAS unsigned* st; };
__device__ __forceinline__ XcdBarrier xcd_barrier_post(unsigned* bar, volatile LAS unsigned* st) {
    XcdBarrier b; b.bar = bar; b.x = xb_xcc_id(); b.st = st;
    if (threadIdx.x == 0) (void)xb_add(&bar[XB_XCNT(b.x)], 1u);
    return b;
}
__device__ __forceinline__ void xcd_barrier_complete(unsigned* bar, unsigned x, unsigned& nloc, unsigned& nx) {
    const unsigned G = gridDim.x * gridDim.y * gridDim.z;
    unsigned sum, cnt, mine, sp = 0u;
    for (;;) {
        sum = 0u; cnt = 0u; mine = 0u;
#pragma unroll
        for (unsigned j = 0; j < 16; ++j) { const unsigned c = xb_ld(&bar[XB_XCNT(j)]); sum += c; cnt += (c > 0u) ? 1u : 0u; mine = (j == x) ? c : mine; }
        if (sum == G) break;
        __builtin_amdgcn_s_sleep(1);
        if ((++sp & 255u) == 0u) { if (xb_ld(&bar[XB_TMO])) break; if (sp > XB_SPIN_CAP) { atomicAdd(&bar[XB_TMO], 1u); break; } }
    }
    nloc = mine > 0u ? mine : 1u; nx = cnt > 0u ? cnt : 1u;
}
__device__ __forceinline__ void xcd_barrier(const XcdBarrier& b) {
    asm volatile("s_waitcnt vmcnt(0)" ::: "memory");
    __syncthreads();
    if (threadIdx.x == 0) {
        unsigned* bar = b.bar;
        __builtin_amdgcn_s_waitcnt(0);
        unsigned nloc = b.st[0], nx = b.st[1];
        if (nloc == 0u) { xcd_barrier_complete(bar, b.x, nloc, nx); b.st[0] = nloc; b.st[1] = nx; }
        const unsigned old = xb_add(&bar[XB_XSUB(b.x)], 1u);
        const unsigned gen = old / nloc;
        if (old + 1u == (gen + 1u) * nloc) {
            __builtin_amdgcn_fence(__ATOMIC_RELEASE, "agent");
            asm volatile("s_waitcnt vmcnt(0)" ::: "memory");
            const unsigned og = xb_add(&bar[XB_TOP], 1u);
            const unsigned tg = og / nx;
            if (og + 1u == (tg + 1u) * nx) xb_add(&bar[XB_TOPGEN], 1u);
            else XB_SPIN(xb_ld(&bar[XB_TOPGEN]) == tg, bar);
            __builtin_amdgcn_fence(__ATOMIC_ACQUIRE, "agent");
            xb_add(&bar[XB_XGEN(b.x)], 1u);
            asm volatile("s_waitcnt vmcnt(0)" ::: "memory");
        } else {
            XB_SPIN(xb_ld(&bar[XB_XGEN(b.x)]) == gen, bar);
            __builtin_amdgcn_fence(__ATOMIC_ACQUIRE, "agent");
            asm volatile("s_waitcnt vmcnt(0)" ::: "memory");
        }
    }
    __syncthreads();
}

struct Frame {
    LAS unsigned char* lds;
    volatile LAS unsigned* MISC;
    unsigned* ctl;
    int tid, lane, wave, G;
    const float *x, *c, *w_ada, *b_ada, *g_pre_mix, *g_post_mix, *g_pre_ffn, *g_post_ffn, *w_in, *b_forget;
    const float *pe_k, *w1_k, *w2_k, *pe_v, *w1_v, *w2_v, *w_o_nsa, *w_o_fox, *w_out, *w_rg, *b_rg, *w_re, *b_re, *w_eg, *w_eu, *w_ed;
    float* out;
    unsigned char* ws;
};

__device__ __forceinline__ float wave_sum(float v) {
#pragma unroll
    for (int o = 1; o < 64; o <<= 1) v += __shfl_xor(v, o);
    return v;
}

#define EPI_LOOP_BEGIN _Pragma("unroll") for (int ai = 0; ai < 2; ++ai) _Pragma("unroll") for (int m = 0; m < 4; ++m) { const int rin = ai * 128 + wr * 64 + m * 16 + fr; (void)rin;
#define EPI_LOOP_END }

struct EpiProj {
    bf16_t* P; float* gates; float* lf; const float* b_forget;
    __device__ __forceinline__ void operator()(const f32x4 (&acc)[2][2][4][2], const pg8::Unit& u, int wr, int wc, int fr, int fq) const {
        const int pn = u.pn;
        if (pn < 19) {
            const int mode = (pn < 2 || pn == 5 || pn == 6) ? 1 : (pn >= 11 ? 2 : 0);
            EPI_LOOP_BEGIN
                bf16_t* rowp = P + (size_t)(u.pm * 256 + rin) * PP + pn * 256 + wc * 32 + 8 * fq;
#pragma unroll
                for (int bj = 0; bj < 2; ++bj) { f32x4 v0 = acc[ai][bj][m][0], v1 = acc[ai][bj][m][1];
                    if (mode == 1) { v0 = v0 * C2; v1 = v1 * C2; }
                    else if (mode == 2) {
#pragma unroll
                        for (int i = 0; i < 4; ++i) { v0[i] = sigmoidf_(v0[i]); v1[i] = sigmoidf_(v1[i]); } }
                    u32x4 w; w.x = cvtpk(v0[0], v0[1]); w.y = cvtpk(v0[2], v0[3]); w.z = cvtpk(v1[0], v1[1]); w.w = cvtpk(v1[2], v1[3]);
                    *(u32x4*)(rowp + bj * 128) = w; }
            EPI_LOOP_END
        } else {
            if (wc == 0) {
                EPI_LOOP_BEGIN
                    const int row = u.pm * 256 + rin; const f32x4 v0 = acc[ai][0][m][0], v1 = acc[ai][0][m][1];
                    if (fq < 3) { f32x4 a, b;
#pragma unroll
                        for (int i = 0; i < 4; ++i) { a[i] = sigmoidf_(v0[i]); b[i] = sigmoidf_(v1[i]); }
                        *(f32x4*)(gates + (size_t)row * 24 + 8 * fq) = a; *(f32x4*)(gates + (size_t)row * 24 + 8 * fq + 4) = b; }
                    else { f32x4 a, b;
#pragma unroll
                        for (int i = 0; i < 4; ++i) { const float xa = v0[i] + b_forget[i], xb = v1[i] + b_forget[4 + i];
                            a[i] = fminf(xa, 0.f) - log1pf(__expf(-fabsf(xa))); b[i] = fminf(xb, 0.f) - log1pf(__expf(-fabsf(xb))); }
                        *(f32x4*)(lf + (size_t)row * 8) = a; *(f32x4*)(lf + (size_t)row * 8 + 4) = b; }
                EPI_LOOP_END
            }
        }
    }
};
struct EpiOut {
    bf16_t* U; const bf16_t* P;
    __device__ __forceinline__ void operator()(const f32x4 (&acc)[2][2][4][2], const pg8::Unit& u, int wr, int wc, int fr, int fq) const {
        const int p = u.pm >= 64 ? 1 : 0, pm = u.pm - 64 * p, pn = u.pn - 4 * p;
        EPI_LOOP_BEGIN
            const size_t row = (size_t)(pm * 256 + rin); const int col = pn * 256 + wc * 32 + 8 * fq;
#pragma unroll
            for (int bj = 0; bj < 2; ++bj) { f32x4 v0 = acc[ai][bj][m][0], v1 = acc[ai][bj][m][1];
                const u32x4 gw = *(const u32x4*)(P + row * PP + C_MG + p * 1024 + col + bj * 128);
                float r[8] = {v0[0] * bflo(gw.x), v0[1] * bfhi(gw.x), v0[2] * bflo(gw.y), v0[3] * bfhi(gw.y), v1[0] * bflo(gw.z), v1[1] * bfhi(gw.z), v1[2] * bflo(gw.w), v1[3] * bfhi(gw.w)};
                bf16_t* up = U + row * DM + col + bj * 128;
                if (p == 1) { const u32x4 o = *(const u32x4*)up;
                    r[0] += bflo(o.x); r[1] += bfhi(o.x); r[2] += bflo(o.y); r[3] += bfhi(o.y); r[4] += bflo(o.z); r[5] += bfhi(o.z); r[6] += bflo(o.w); r[7] += bfhi(o.w); }
                u32x4 w; w.x = cvtpk(r[0], r[1]); w.y = cvtpk(r[2], r[3]); w.z = cvtpk(r[4], r[5]); w.w = cvtpk(r[6], r[7]);
                *(u32x4*)up = w; }
        EPI_LOOP_END
    }
};
struct EpiF32 {
    float* O; int ldc;
    __device__ __forceinline__ void operator()(const f32x4 (&acc)[2][2][4][2], const pg8::Unit& u, int wr, int wc, int fr, int fq) const {
        EPI_LOOP_BEGIN
            float* rowp = O + (size_t)(u.pm * 256 + rin) * ldc + u.pn * 256 + wc * 32 + 8 * fq;
#pragma unroll
            for (int bj = 0; bj < 2; ++bj) { *(f32x4*)(rowp + bj * 128) = acc[ai][bj][m][0]; *(f32x4*)(rowp + bj * 128 + 4) = acc[ai][bj][m][1]; }
        EPI_LOOP_END
    }
};
struct EpiSwiglu {
    bf16_t* H;
    __device__ __forceinline__ void operator()(const f32x4 (&acc)[2][2][4][2], const pg8::Unit& u, int wr, int wc, int fr, int fq) const {
        EPI_LOOP_BEGIN
            bf16_t* hp = H + (size_t)(u.pm * 256 + rin) * DEXP + (u.pn & 3) * 128 + wc * 32 + 8 * fq;
            float r[8];
#pragma unroll
            for (int i = 0; i < 4; ++i) { const float g0 = acc[ai][0][m][0][i], g1 = acc[ai][0][m][1][i];
                r[i] = g0 * sigmoidf_(g0) * acc[ai][1][m][0][i]; r[4 + i] = g1 * sigmoidf_(g1) * acc[ai][1][m][1][i]; }
            u32x4 w; w.x = cvtpk(r[0], r[1]); w.y = cvtpk(r[2], r[3]); w.z = cvtpk(r[4], r[5]); w.w = cvtpk(r[6], r[7]);
            *(u32x4*)hp = w;
        EPI_LOOP_END
    }
};
struct EpiDown {
    bf16_t* Y2; const u32x2* list; volatile LAS unsigned* tstart; volatile LAS unsigned* ecnt;
    __device__ __forceinline__ void operator()(const f32x4 (&acc)[2][2][4][2], const pg8::Unit& u, int wr, int wc, int fr, int fq) const {
        const int e = u.pn >> 2, rt = u.pm - (int)tstart[e], cnt = (int)ecnt[e];
        EPI_LOOP_BEGIN
            const int rank = rt * 256 + rin;
            if (rank < cnt) { const u32x2 ent = list[(size_t)e * M + rank]; const float w = __uint_as_float(ent.y);
                bf16_t* yp = Y2 + (size_t)ent.x * DM + (u.pn & 3) * 256 + wc * 32 + 8 * fq;
#pragma unroll
                for (int bj = 0; bj < 2; ++bj) { const f32x4 v0 = acc[ai][bj][m][0] * w, v1 = acc[ai][bj][m][1] * w;
                    u32x4 o; o.x = cvtpk(v0[0], v0[1]); o.y = cvtpk(v0[2], v0[3]); o.z = cvtpk(v1[0], v1[1]); o.w = cvtpk(v1[2], v1[3]);
                    *(u32x4*)(yp + bj * 128) = o; } }
        EPI_LOOP_END
    }
};
struct OutOrder {
    int G, c;
    __device__ bool next(int i, pg8::Unit& u) const { const int T = c + (i >> 1) * G; if (T >= 256) return false; const int p = i & 1; u.pm = (T >> 2) + 64 * p; u.pn = (T & 3) + 4 * p; return true; }
};
struct MoeOrder {
    volatile LAS unsigned* tstart; int G, c;
    __device__ bool next(int i, pg8::Unit& u) const {
        const int L = i * G + c; const int NT = (int)tstart[32];
        if (L >= 4 * NT) return false;
        int e = 0;
        for (int k = 1; k < 32; ++k) if (L >= 4 * (int)tstart[k]) e = k;
        const int ts = (int)tstart[e], nte = (int)tstart[e + 1] - ts, rem = L - 4 * ts;
        const int j = rem / nte, rt = rem - j * nte;
        u.pm = ts + rt; u.pn = e * 4 + j; return true;
    }
};
struct MoeGather {
    const u32x2* list; volatile LAS unsigned* tstart; volatile LAS unsigned* ecnt;
    __device__ __forceinline__ int row(const pg8::Unit& u, int r) const {
        const int e = u.pn >> 2, rank = (u.pm - (int)tstart[e]) * 256 + r;
        if (rank >= (int)ecnt[e]) return 0;
        return (int)(list[(size_t)e * M + rank].x >> 1);
    }
};
constexpr int TR_SCR = 64 * 65 * 4;
template <class MapF>
__device__ __forceinline__ void tr_item(const float* __restrict__ W, int N, bf16_t* WT, int ldwt, MapF map, LAS float* scr, int kb, int nb, int lane) {
    const int k0 = 64 * kb, n0 = 64 * nb, c4 = 4 * (lane & 15);
    f32x4 v[16];
    const bool okc = (n0 + c4) < N;
#pragma unroll
    for (int i = 0; i < 16; ++i) { const int k = 4 * i + (lane >> 4); v[i] = okc ? *(const f32x4*)(W + (size_t)(k0 + k) * N + n0 + c4) : (f32x4){0.f, 0.f, 0.f, 0.f}; }
#pragma unroll
    for (int i = 0; i < 16; ++i) { const int k = 4 * i + (lane >> 4); LAS float* s = scr + k * 65 + c4; s[0] = v[i][0]; s[1] = v[i][1]; s[2] = v[i][2]; s[3] = v[i][3]; }
    LDS_WAIT(); asm volatile("" ::: "memory");
    const int c = lane & 7;
#pragma unroll
    for (int jj = 0; jj < 8; ++jj) { const int n = (lane >> 3) + 8 * jj; const LAS float* s = scr + (8 * c) * 65 + n;
        u32x4 o; o.x = cvtpk(s[0 * 65], s[1 * 65]); o.y = cvtpk(s[2 * 65], s[3 * 65]); o.z = cvtpk(s[4 * 65], s[5 * 65]); o.w = cvtpk(s[6 * 65], s[7 * 65]);
        if (n0 + n < N) *(u32x4*)(WT + (size_t)map(n0 + n) * ldwt + k0 + 8 * c) = o; }
    LDS_WAIT(); asm volatile("" ::: "memory");
}
struct MapId { int off; __device__ __forceinline__ int operator()(int n) const { return off + n; } };
struct MapWin { __device__ __forceinline__ int operator()(int n) const {
    if (n < 1280) return n; if (n < 1304) return 4864 + (n - 1280); if (n < 2840) return 1280 + (n - 1304); if (n < 2848) return 4888 + (n - 2840); return 2816 + (n - 2848); } };
struct MapGU { int e, up; __device__ __forceinline__ int operator()(int n) const { return (e * 4 + (n >> 7)) * 256 + (n & 127) + up * 128; } };

__device__ __forceinline__ void p0_prologue(Frame& F) {
    LAS float* scr = (LAS float*)(F.lds + F.wave * TR_SCR);
    LAS float* sil = (LAS float*)(F.lds + 8 * TR_SCR);
    for (int i = F.tid; i < 2048; i += NWAVES * 64) { const float cv = F.c[i]; sil[i] = cv / (1.f + __expf(-cv)); }
    __syncthreads();
    const int gw = blockIdx.x * NWAVES + F.wave, NGW = F.G * NWAVES, lane = F.lane;
    float* MODP = (float*)(F.ws + WS_MODP); float* PEB = (float*)(F.ws + WS_PEB);
    bf16_t* W1T = (bf16_t*)(F.ws + WS_W1T); bf16_t* WINT = (bf16_t*)(F.ws + WS_WINT); bf16_t* WOT = (bf16_t*)(F.ws + WS_WOT); bf16_t* WOUTT = (bf16_t*)(F.ws + WS_WOUTT);
    constexpr int I_GEMV = 768, I_PEB = 64, I_W1T = 64, I_WIN = 16 * 77, I_WO = 128, I_WOUT = 256;
    constexpr int NITEMS = I_GEMV + I_PEB + I_W1T + I_WIN + 2 * I_WO + I_WOUT;
    for (int it = gw; it < NITEMS; it += NGW) {
        int r = it;
        if (r < I_GEMV) {
            const int cg = r % 96, kc = r / 96; const int col = cg * 64 + lane; float a0 = 0.f, a1 = 0.f;
            const float* wp = F.w_ada + (size_t)(kc * 128) * 6144 + col;
#pragma unroll 16
            for (int k = 0; k < 128; ++k) { const float w = wp[(size_t)k * 6144]; a0 += sil[kc * 128 + k] * w; a1 += sil[1024 + kc * 128 + k] * w; }
            MODP[(kc * 2 + 0) * 6144 + col] = a0; MODP[(kc * 2 + 1) * 6144 + col] = a1; continue; }
        r -= I_GEMV;
        if (r < I_PEB) {
            const int kind = r >> 5, ch = r & 31; const float* pe = kind ? F.pe_v : F.pe_k; const float* w1 = kind ? F.w1_v : F.w1_k; float a = 0.f;
#pragma unroll 16
            for (int k = 0; k < 64; ++k) a += pe[ch * 64 + k] * w1[(size_t)(ch * 64 + k) * 64 + lane];
            PEB[(kind * 32 + ch) * 64 + lane] = a; continue; }
        r -= I_PEB;
        if (r < I_W1T) { const int kind = r >> 5, kb = r & 31; tr_item(kind ? F.w1_v : F.w1_k, 64, W1T + (size_t)kind * 64 * 2048, 2048, MapId{0}, scr, kb, 0, lane); continue; }
        r -= I_W1T;
        if (r < I_WIN) { tr_item(F.w_in, DIN, WINT, 1024, MapWin{}, scr, r / 77, r % 77, lane); continue; }
        r -= I_WIN;
        if (r < I_WO) { tr_item(F.w_o_nsa, 1024, WOT, 512, MapId{0}, scr, r >> 4, r & 15, lane); continue; }
        r -= I_WO;
        if (r < I_WO) { tr_item(F.w_o_fox, 1024, WOT, 512, MapId{1024}, scr, r >> 4, r & 15, lane); continue; }
        r -= I_WO;
        tr_item(F.w_out, 1024, WOUTT, 1024, MapId{0}, scr, r >> 4, r & 15, lane);
    }
}
__device__ __forceinline__ void expert_convert(Frame& F) {
    LAS float* scr = (LAS float*)(F.lds + F.wave * TR_SCR);
    const int gw = blockIdx.x * NWAVES + F.wave, NGW = F.G * NWAVES, lane = F.lane;
    bf16_t* WGUT = (bf16_t*)(F.ws + WS_WGUT); bf16_t* WDT = (bf16_t*)(F.ws + WS_WDT);
    for (int it = gw; it < 32 * 384; it += NGW) {
        const int e = it / 384, r = it % 384, mat = r >> 7, q = r & 127;
        if (mat == 0) tr_item(F.w_eg + (size_t)e * 1024 * 512, 512, WGUT, 1024, MapGU{e, 0}, scr, q >> 3, q & 7, lane);
        else if (mat == 1) tr_item(F.w_eu + (size_t)e * 1024 * 512, 512, WGUT, 1024, MapGU{e, 1}, scr, q >> 3, q & 7, lane);
        else tr_item(F.w_ed + (size_t)e * 512 * 1024, 1024, WDT, 512, MapId{e * 1024}, scr, q >> 4, q & 15, lane);
    }
}

__device__ __forceinline__ void mod_from_partials(Frame& F, int b, int ch, f32x4 (&o)[4]) {
    const float* MODP = (const float*)(F.ws + WS_MODP);
#pragma unroll
    for (int j = 0; j < 4; ++j) { const int col = ch * 1024 + 256 * j + 4 * F.lane; f32x4 a = *(const f32x4*)(F.b_ada + col);
#pragma unroll
        for (int kc = 0; kc < 8; ++kc) a += *(const f32x4*)(MODP + (size_t)(kc * 2 + b) * 6144 + col);
        o[j] = a; }
}
__device__ __forceinline__ void mod_final(Frame& F, int b, int ch, f32x4 (&o)[4]) {
    const float* MOD = (const float*)(F.ws + WS_MOD);
#pragma unroll
    for (int j = 0; j < 4; ++j) o[j] = *(const f32x4*)(MOD + (size_t)b * 6144 + ch * 1024 + 256 * j + 4 * F.lane);
}
__device__ __forceinline__ void ld_row4(const float* p, int lane, f32x4 (&o)[4]) {
#pragma unroll
    for (int j = 0; j < 4; ++j) o[j] = *(const f32x4*)(p + 256 * j + 4 * lane);
}
__device__ __forceinline__ float sumsq4(const f32x4 (&v)[4]) { float s = 0.f;
#pragma unroll
    for (int j = 0; j < 4; ++j) s += (v[j][0] * v[j][0] + v[j][1] * v[j][1]) + (v[j][2] * v[j][2] + v[j][3] * v[j][3]);
    return s; }
__device__ __forceinline__ void st_row_bf16(bf16_t* p, int lane, const f32x4 (&v)[4]) {
#pragma unroll
    for (int j = 0; j < 4; ++j) { u32x2 w; w.x = cvtpk(v[j][0], v[j][1]); w.y = cvtpk(v[j][2], v[j][3]); *(u32x2*)(p + 256 * j + 4 * lane) = w; }
}

__device__ __forceinline__ void p0b_rows(Frame& F) {
    const int gw = blockIdx.x * NWAVES + F.wave, NGW = F.G * NWAVES, lane = F.lane;
    {
        const float* MODP = (const float*)(F.ws + WS_MODP); float* MOD = (float*)(F.ws + WS_MOD);
        for (int j = gw * 64 + lane; j < 2 * 6144; j += NGW * 64) { const int b = j / 6144, col = j % 6144; float a = F.b_ada[col];
#pragma unroll
            for (int kc = 0; kc < 8; ++kc) a += MODP[(size_t)(kc * 2 + b) * 6144 + col];
            MOD[j] = a; }
    }
    bf16_t* HN = (bf16_t*)(F.ws + WS_HN);
    f32x4 g[4]; ld_row4(F.g_pre_mix, lane, g);
    int curb = -1; f32x4 mul[4], add[4];
    for (int m = gw; m < M; m += NGW) {
        const int b = m >> 13;
        if (b != curb) { f32x4 sc[4]; mod_from_partials(F, b, 0, add); mod_from_partials(F, b, 1, sc); curb = b;
#pragma unroll
            for (int j = 0; j < 4; ++j) mul[j] = g[j] * (sc[j] + 1.0f); }
        f32x4 v[4]; ld_row4(F.x + (size_t)m * DM, lane, v);
        const float rstd = 1.0f / sqrtf(wave_sum(sumsq4(v)) * (1.0f / DM) + NORM_EPS);
#pragma unroll
        for (int j = 0; j < 4; ++j) v[j] = v[j] * rstd * mul[j] + add[j];
        st_row_bf16(HN + (size_t)m * DM, lane, v);
    }
}

__device__ __forceinline__ float gelu_tanh(float x) { const float u = 0.7978845608028654f * (x + 0.044715f * x * x * x); const float t = 1.0f - 2.0f / (1.0f + __expf(2.0f * u)); return 0.5f * x * (1.0f + t); }
__device__ __forceinline__ void p2a_item_cmp(Frame& F, int item) {
    const int kind = item >> 6, bg = (item >> 4) & 3, nt = item & 15, b = bg >> 1, g = bg & 1, n0 = 32 * nt;
    const int lane = F.lane, r32 = lane & 31, hi = lane >> 5, w = F.wave, tid = F.tid;
    const bf16_t* PROJ = (const bf16_t*)(F.ws + WS_PROJ); const bf16_t* W1T = (const bf16_t*)(F.ws + WS_W1T) + (size_t)kind * 64 * 2048;
    const int col = (kind ? C_VCMP : C_KCMP) + g * 64;
    int n = n0 + r32; if (n > 510) n = 510;
    const bf16_t* ap = PROJ + (size_t)(b * SEQ + 16 * n) * PP + col + 8 * hi;
    const bf16_t* bp0 = W1T + (size_t)r32 * 2048 + 256 * w + 8 * hi; const bf16_t* bp1 = bp0 + (size_t)32 * 2048;
    f32x16 acc0 = {}, acc1 = {};
#pragma unroll 4
    for (int ks = 0; ks < 16; ++ks) { const int l = 4 * w + (ks >> 2), d = (ks & 3) * 16;
        const bf16x8 a = *(const bf16x8*)(ap + (size_t)l * PP + d);
        const bf16x8 b0 = *(const bf16x8*)(bp0 + 16 * ks), b1 = *(const bf16x8*)(bp1 + 16 * ks);
        acc0 = __builtin_amdgcn_mfma_f32_32x32x16_bf16(a, b0, acc0, 0, 0, 0); acc1 = __builtin_amdgcn_mfma_f32_32x32x16_bf16(a, b1, acc1, 0, 0, 0); }
    LAS float* RED = (LAS float*)F.lds;
    LAS float* BIAS = (LAS float*)(F.lds + 65536);
    LAS float* HID = (LAS float*)(F.lds + 65536 + 256);
#pragma unroll
    for (int r = 0; r < 16; ++r) { const int nl = (r & 3) + 8 * (r >> 2) + 4 * hi; RED[(w * 32 + nl) * 64 + r32] = acc0[r]; RED[(w * 32 + nl) * 64 + 32 + r32] = acc1[r]; }
    if (tid < 64) { const float* PEB = (const float*)(F.ws + WS_PEB) + kind * 32 * 64; float a = 0.f;
        for (int ch = 0; ch < 32; ++ch) a += PEB[ch * 64 + tid];
        BIAS[tid] = a; }
    __syncthreads();
    { const int idx = tid * 4, nl = idx >> 6, e = idx & 63; f32x4 s = *(const LAS f32x4*)(BIAS + e);
#pragma unroll
      for (int ww = 0; ww < 8; ++ww) s += *(const LAS f32x4*)(RED + (ww * 32 + nl) * 64 + e);
      f32x4 h; for (int i = 0; i < 4; ++i) h[i] = gelu_tanh(s[i]);
      *(LAS f32x4*)(HID + nl * 64 + e) = h; }
    __syncthreads();
    { const int nl = tid >> 4, e2 = (tid & 15) * 4; const float* w2 = kind ? F.w2_v : F.w2_k; f32x4 o = {0.f, 0.f, 0.f, 0.f};
#pragma unroll 8
      for (int e = 0; e < 64; ++e) { const float hv = HID[nl * 64 + e]; o += *(const f32x4*)(w2 + e * 64 + e2) * hv; }
      bf16_t* KC = (bf16_t*)(F.ws + (kind ? WS_VC : WS_KC));
      u32x2 pk; pk.x = cvtpk(o[0], o[1]); pk.y = cvtpk(o[2], o[3]);
      *(u32x2*)(KC + (size_t)(bg * 512 + n0 + nl) * 64 + e2) = pk; }
    __syncthreads();
}
__device__ __forceinline__ void p2a_item_cumsum(Frame& F, int bh) {
    const int b = bh >> 3, h = bh & 7, tid = F.tid, lane = F.lane, w = F.wave;
    const float* LF = (const float*)(F.ws + WS_LF); float* FB2 = (float*)(F.ws + WS_FB2);
    LAS float* WT = (LAS float*)F.lds;
    float v[16]; float s = 0.f;
#pragma unroll
    for (int i = 0; i < 16; ++i) { s += LF[(size_t)(b * SEQ + tid * 16 + i) * 8 + h]; v[i] = s; }
    float inc = s;
#pragma unroll
    for (int o = 1; o < 64; o <<= 1) { const float t = __shfl_up(inc, o); if (lane >= o) inc += t; }
    if (lane == 63) WT[w] = inc;
    __syncthreads();
    float base = inc - s;
    for (int ww = 0; ww < w; ++ww) base += WT[ww];
#pragma unroll
    for (int i = 0; i < 16; ++i) FB2[(size_t)bh * SEQ + tid * 16 + i] = -(base + v[i]) * LOG2E;
    __syncthreads();
}
namespace att {
__device__ __forceinline__ int crow(int r, int hi) { return (r & 3) + 8 * (r >> 2) + 4 * hi; }
constexpr int KVBUF = 16384;
__device__ __forceinline__ void issue_kv(LAS unsigned char* buf, const bf16_t* kp, const bf16_t* vp, int wid) {
    __builtin_amdgcn_global_load_lds((const unsigned*)kp, (LAS unsigned*)(buf + wid * 1024), 16, 0, 0);
    __builtin_amdgcn_global_load_lds((const unsigned*)vp, (LAS unsigned*)(buf + 8192 + wid * 1024), 16, 0, 0);
}
template <int PITCH> __device__ __forceinline__ const bf16_t* kptr(const bf16_t* base, int row0, int kc, int wid, int lane) { return base + (size_t)(row0 + lane) * PITCH + kc + wid * 8; }
template <int PITCH> __device__ __forceinline__ const bf16_t* vptr(const bf16_t* base, int row0, int vc, int wid, int lane) { return base + (size_t)(row0 + 16 * (wid & 3) + (lane >> 2)) * PITCH + vc + (wid >> 2) * 32 + (lane & 3) * 8; }

__device__ __forceinline__ void qkt(f32x16& p0, f32x16& p1, const LAS unsigned char* Ks, const bf16x8 (&qr)[4], int r32, int hi) {
    const LAS unsigned char* kb = Ks + hi * 1024 + r32 * 16;
#pragma unroll
    for (int d0 = 0; d0 < 4; ++d0) {
        const bf16x8 b0 = *(const LAS bf16x8*)(kb + d0 * 2048);
        const bf16x8 b1 = *(const LAS bf16x8*)(kb + d0 * 2048 + 512);
        p0 = __builtin_amdgcn_mfma_f32_32x32x16_bf16(b0, qr[d0], p0, 0, 0, 0);
        p1 = __builtin_amdgcn_mfma_f32_32x32x16_bf16(b1, qr[d0], p1, 0, 0, 0);
    }
}
typedef short v4i16_t __attribute__((ext_vector_type(4)));
__device__ __forceinline__ s16x4 vtr(const LAS unsigned char* p) { return __builtin_bit_cast(s16x4, __builtin_amdgcn_ds_read_tr16_b64_v4i16((LAS v4i16_t*)p)); }
__device__ __forceinline__ float half_swap_max(float v) { auto rr = __builtin_amdgcn_permlane32_swap(__float_as_uint(v), __float_as_uint(v), false, false); return fmaxf(__uint_as_float(rr[0]), __uint_as_float(rr[1])); }
__device__ __forceinline__ float half_swap_sum(float v) { auto rr = __builtin_amdgcn_permlane32_swap(__float_as_uint(v), __float_as_uint(v), false, false); return __uint_as_float(rr[0]) + __uint_as_float(rr[1]); }
__device__ __forceinline__ float rowmax32(const f32x16& p0, const f32x16& p1) {
    float a = fmaxf(p0[0], p1[0]);
#pragma unroll
    for (int r = 1; r < 16; ++r) a = fmaxf(a, fmaxf(p0[r], p1[r]));
    return half_swap_max(a);
}
__device__ __forceinline__ void pv(f32x16& o0, f32x16& o1, const LAS unsigned char* buf, const f32x16& p0, const f32x16& p1, int lane) {
    const int hi = lane >> 5;
    const LAS unsigned char* vb = buf + 8192 + ((lane >> 4) & 1) * 32 + (lane & 3) * 8 + (4 * hi + ((lane & 15) >> 2)) * 64;
    u32x4 w0 = {cvtpk(p0[0], p0[1]), cvtpk(p0[2], p0[3]), cvtpk(p0[4], p0[5]), cvtpk(p0[6], p0[7])};
    u32x4 w1 = {cvtpk(p0[8], p0[9]), cvtpk(p0[10], p0[11]), cvtpk(p0[12], p0[13]), cvtpk(p0[14], p0[15])};
    u32x4 w2 = {cvtpk(p1[0], p1[1]), cvtpk(p1[2], p1[3]), cvtpk(p1[4], p1[5]), cvtpk(p1[6], p1[7])};
    u32x4 w3 = {cvtpk(p1[8], p1[9]), cvtpk(p1[10], p1[11]), cvtpk(p1[12], p1[13]), cvtpk(p1[14], p1[15])};
    const bf16x8 pa[4] = {__builtin_bit_cast(bf16x8, w0), __builtin_bit_cast(bf16x8, w1), __builtin_bit_cast(bf16x8, w2), __builtin_bit_cast(bf16x8, w3)};
#pragma unroll
    for (int ks = 0; ks < 4; ++ks) {
        const s16x4 l0 = vtr(vb + ks * 1024), h0 = vtr(vb + ks * 1024 + 512);
        const s16x4 l1 = vtr(vb + 4096 + ks * 1024), h1 = vtr(vb + 4096 + ks * 1024 + 512);
        const bf16x8 v0 = {l0[0], l0[1], l0[2], l0[3], h0[0], h0[1], h0[2], h0[3]};
        const bf16x8 v1 = {l1[0], l1[1], l1[2], l1[3], h1[0], h1[1], h1[2], h1[3]};
        o0 = __builtin_amdgcn_mfma_f32_32x32x16_bf16(v0, pa[ks], o0, 0, 0, 0);
        o1 = __builtin_amdgcn_mfma_f32_32x32x16_bf16(v1, pa[ks], o1, 0, 0, 0);
    }
}
template <bool EMASK>
__device__ __forceinline__ void tile_step(const LAS unsigned char* buf, const bf16x8 (&qr)[4], f32x16 p0, f32x16 p1, int lo, int hb,
                                          f32x16& o0, f32x16& o1, float& m, float& l, int lane) {
    const int r32 = lane & 31, hi = lane >> 5;
    qkt(p0, p1, buf, qr, r32, hi);
    if (EMASK) {
#pragma unroll
        for (int r = 0; r < 16; ++r) { const int kl = crow(r, hi); if (kl < lo || kl > hb) p0[r] = NEGF; if (kl + 32 < lo || kl + 32 > hb) p1[r] = NEGF; }
    }
    const float rm = rowmax32(p0, p1);
    const float mn = fmaxf(m, rm);
    const float al = __builtin_amdgcn_exp2f(m - mn);
    m = mn; l *= al;
#pragma unroll
    for (int r = 0; r < 16; ++r) { o0[r] *= al; o1[r] *= al; }
    float s = 0.f;
#pragma unroll
    for (int r = 0; r < 16; ++r) { p0[r] = __builtin_amdgcn_exp2f(p0[r] - mn); p1[r] = __builtin_amdgcn_exp2f(p1[r] - mn); s += p0[r] + p1[r]; }
    l += s;
    pv(o0, o1, buf, p0, p1, lane);
}
__device__ __forceinline__ void store_cols(bf16_t* dst, const f32x16& y0, const f32x16& y1, int hi) {
#pragma unroll
    for (int q = 0; q < 4; ++q) {
        u32x2 a; a.x = cvtpk(y0[4 * q], y0[4 * q + 1]); a.y = cvtpk(y0[4 * q + 2], y0[4 * q + 3]);
        u32x2 b; b.x = cvtpk(y1[4 * q], y1[4 * q + 1]); b.y = cvtpk(y1[4 * q + 2], y1[4 * q + 3]);
        *(u32x2*)(dst + 8 * q + 4 * hi) = a; *(u32x2*)(dst + 32 + 8 * q + 4 * hi) = b;
    }
}

__device__ __forceinline__ int next_below(unsigned u0, unsigned u1, unsigned u2, unsigned u3, int from) {
    if (from > 96) { const unsigned v = (from < 128) ? (u3 & ((1u << (from - 96)) - 1u)) : u3; if (v) return 96 + 31 - __builtin_clz(v); }
    if (from > 64) { const unsigned v = (from < 96) ? (u2 & ((1u << (from - 64)) - 1u)) : u2; if (v) return 64 + 31 - __builtin_clz(v); }
    if (from > 32) { const unsigned v = (from < 64) ? (u1 & ((1u << (from - 32)) - 1u)) : u1; if (v) return 32 + 31 - __builtin_clz(v); }
    if (from > 0) { const unsigned v = (from < 32) ? (u0 & ((1u << from) - 1u)) : u0; if (v) return 31 - __builtin_clz(v); }
    return -1;
}
__device__ __forceinline__ void fox_unit(Frame& F, int b, int h, int qb) {
    int lane = F.lane; asm volatile("" : "+v"(lane));
    const int wid = F.wave, r32 = lane & 31, hi = lane >> 5;
    const bf16_t* PROJ = (const bf16_t*)(F.ws + WS_PROJ) + (size_t)b * SEQ * PP;
    const float* FB2 = (const float*)(F.ws + WS_FB2) + (size_t)(b * 8 + h) * SEQ;
    bf16_t* YB = (bf16_t*)(F.ws + WS_YY) + (size_t)M * 512 + (size_t)b * SEQ * 512;
    LAS unsigned char* kv = F.lds;
    const int t0 = 256 * qb, tw0 = t0 + 32 * wid, t = tw0 + r32;
    const int kcol = C_FK + h * 64, vcol = C_FV + h * 64;
    bf16x8 qr[4];
#pragma unroll
    for (int d0 = 0; d0 < 4; ++d0) qr[d0] = *(const bf16x8*)(PROJ + (size_t)t * PP + C_FQ + h * 64 + d0 * 16 + hi * 8);
    f32x16 o0 = {}, o1 = {}; float m = NEGF, l = 0.f;
    const int NT = 4 * (qb + 1);
    __syncthreads();
    issue_kv(kv + ((NT - 1) & 1) * KVBUF, kptr<PP>(PROJ, (NT - 1) * 64, kcol, wid, lane), vptr<PP>(PROJ, (NT - 1) * 64, vcol, wid, lane), wid);
    for (int j = NT - 1; j >= 0; --j) {
        f32x16 c0, c1;
        const bool active = (64 * j <= tw0 + 31);
        if (active) {
            const float* fb = FB2 + 64 * j + 4 * hi;
#pragma unroll
            for (int q = 0; q < 4; ++q) { const f32x4 a = *(const f32x4*)(fb + 8 * q), bb = *(const f32x4*)(fb + 32 + 8 * q);
                c0[4 * q] = a[0]; c0[4 * q + 1] = a[1]; c0[4 * q + 2] = a[2]; c0[4 * q + 3] = a[3];
                c1[4 * q] = bb[0]; c1[4 * q + 1] = bb[1]; c1[4 * q + 2] = bb[2]; c1[4 * q + 3] = bb[3]; }
        }
        VM_WAIT(); __syncthreads();
        if (j > 0) issue_kv(kv + ((j - 1) & 1) * KVBUF, kptr<PP>(PROJ, (j - 1) * 64, kcol, wid, lane), vptr<PP>(PROJ, (j - 1) * 64, vcol, wid, lane), wid);
        if (active) {
            const LAS unsigned char* buf = kv + (j & 1) * KVBUF;
            if (64 * j + 63 > tw0) tile_step<true>(buf, qr, c0, c1, 0, t - 64 * j, o0, o1, m, l, lane);
            else tile_step<false>(buf, qr, c0, c1, 0, 63, o0, o1, m, l, lane);
        }
    }
    const float inv = 1.0f / half_swap_sum(l);
#pragma unroll
    for (int r = 0; r < 16; ++r) { o0[r] *= inv; o1[r] *= inv; }
    store_cols(YB + (size_t)t * 512 + h * 64, o0, o1, hi);
}

constexpr int IMP_OFF = 2 * KVBUF;
constexpr int SELM_OFF = IMP_OFF + 64 * 128 * 4;
constexpr int YSV_OFF = SELM_OFF + 1024;
__device__ __forceinline__ void nsa_unit(Frame& F, int b, int g, int cur) {
    int lane = F.lane; asm volatile("" : "+v"(lane));
    const int wid = F.wave, r32 = lane & 31, hi = lane >> 5;
    const bf16_t* PROJ = (const bf16_t*)(F.ws + WS_PROJ) + (size_t)b * SEQ * PP;
    const float* GATES = (const float*)(F.ws + WS_GATES) + (size_t)b * SEQ * 24;
    bf16_t* YA = (bf16_t*)(F.ws + WS_YY) + (size_t)b * SEQ * 512;
    LAS unsigned char* kv = F.lds;
    LAS float* IMP = (LAS float*)(F.lds + IMP_OFF);
    LAS unsigned* SELM = (LAS unsigned*)(F.lds + SELM_OFF);
    const int t0 = 64 * cur, ql = 8 * wid + (r32 >> 2), hl = r32 & 3, head = 4 * g + hl, t = t0 + ql;
    const float a = __builtin_amdgcn_exp2f(-(float)(head + 1)) * LOG2E;
    bf16x8 qr[4];
#pragma unroll
    for (int d0 = 0; d0 < 4; ++d0) qr[d0] = *(const bf16x8*)(PROJ + (size_t)t * PP + C_QA + head * 64 + d0 * 16 + hi * 8);
    const float* gp = GATES + (size_t)t * 24 + head * 3;
    LAS float* YSV = (LAS float*)(F.lds + YSV_OFF) + (wid * 64 + lane);
    float kc_r[16];
#pragma unroll
    for (int r = 0; r < 16; ++r) kc_r[r] = (float)((r & 3) + 8 * (r >> 2));
    {
        const bf16_t* KC = (const bf16_t*)(F.ws + WS_KC) + (size_t)(b * 2 + g) * 512 * 64;
        const bf16_t* VC = (const bf16_t*)(F.ws + WS_VC) + (size_t)(b * 2 + g) * 512 * 64;
        const int nmaxU = (t0 + 32) >> 4, ntile = (nmaxU >> 6) + 1;
        const int nmax_l = (t - 31) >> 4;
        const float a16 = a * 16.0f;
#pragma unroll
        for (int i = 0; i < 16; ++i) IMP[(8 * wid) * 128 + i * 64 + lane] = 0.f;
        float m = NEGF, l = 0.f;
        __syncthreads();
        issue_kv(kv, kptr<64>(KC, 0, 0, wid, lane), vptr<64>(VC, 0, 0, wid, lane), wid);
        for (int jt = 0; jt < ntile; ++jt) {
            VM_WAIT(); __syncthreads();
            if (jt + 1 < ntile) issue_kv(kv + ((jt + 1) & 1) * KVBUF, kptr<64>(KC, (jt + 1) * 64, 0, wid, lane), vptr<64>(VC, (jt + 1) * 64, 0, wid, lane), wid);
            const float base = a16 * (float)(64 * jt + 4 * hi);
            f32x16 p0, p1;
#pragma unroll
            for (int r = 0; r < 16; ++r) { p0[r] = fmaf(a16, kc_r[r], base); p1[r] = p0[r] + a16 * 32.0f; }
            qkt(p0, p1, kv + (jt & 1) * KVBUF, qr, r32, hi);
            const int lim = nmax_l - 64 * jt;
#pragma unroll
            for (int r = 0; r < 16; ++r) { const int kl = crow(r, hi); if (kl > lim) p0[r] = NEGF; if (kl + 32 > lim) p1[r] = NEGF; }
            const float rm = rowmax32(p0, p1), mn = fmaxf(m, rm);
            float s = 0.f;
#pragma unroll
            for (int r = 0; r < 16; ++r) { const int kl = crow(r, hi);
                s += (kl <= lim) ? __builtin_amdgcn_exp2f(p0[r] - mn) : 0.f; s += (kl + 32 <= lim) ? __builtin_amdgcn_exp2f(p1[r] - mn) : 0.f; }
            l = l * __builtin_amdgcn_exp2f(m - mn) + s; m = mn;
        }
        const float lt = half_swap_sum(l);
        const float inv = lt > 0.f ? 1.0f / lt : 0.f;
        f32x16 o0 = {}, o1 = {};
        __syncthreads();
        issue_kv(kv, kptr<64>(KC, 0, 0, wid, lane), vptr<64>(VC, 0, 0, wid, lane), wid);
        for (int jt = 0; jt < ntile; ++jt) {
            VM_WAIT(); __syncthreads();
            if (jt + 1 < ntile) issue_kv(kv + ((jt + 1) & 1) * KVBUF, kptr<64>(KC, (jt + 1) * 64, 0, wid, lane), vptr<64>(VC, (jt + 1) * 64, 0, wid, lane), wid);
            const float base = a16 * (float)(64 * jt + 4 * hi);
            f32x16 p0, p1;
#pragma unroll
            for (int r = 0; r < 16; ++r) { p0[r] = fmaf(a16, kc_r[r], base); p1[r] = p0[r] + a16 * 32.0f; }
            qkt(p0, p1, kv + (jt & 1) * KVBUF, qr, r32, hi);
            const int lim = nmax_l - 64 * jt;
#pragma unroll
            for (int r = 0; r < 16; ++r) { const int kl = crow(r, hi);
                p0[r] = (kl <= lim) ? __builtin_amdgcn_exp2f(p0[r] - m) * inv : 0.f; p1[r] = (kl + 32 <= lim) ? __builtin_amdgcn_exp2f(p1[r] - m) * inv : 0.f; }
#pragma unroll
            for (int r2 = 0; r2 < 4; ++r2) {
                float A0 = (p0[4 * r2] + p0[4 * r2 + 1]) + (p0[4 * r2 + 2] + p0[4 * r2 + 3]), L0 = p0[4 * r2 + 3];
                float A1 = (p1[4 * r2] + p1[4 * r2 + 1]) + (p1[4 * r2 + 2] + p1[4 * r2 + 3]), L1 = p1[4 * r2 + 3];
                A0 += __shfl_xor(A0, 1); A0 += __shfl_xor(A0, 2); L0 += __shfl_xor(L0, 1); L0 += __shfl_xor(L0, 2);
                A1 += __shfl_xor(A1, 1); A1 += __shfl_xor(A1, 2); L1 += __shfl_xor(L1, 1); L1 += __shfl_xor(L1, 2);
                if (hl == 0) {
                    const int j0 = 16 * jt + 2 * r2 + hi, j1 = j0 + 8;
                    LAS float* ip = IMP + ql * 128;
                    __hip_atomic_fetch_add(ip + j0, A0, __ATOMIC_RELAXED, __HIP_MEMORY_SCOPE_WORKGROUP);
                    __hip_atomic_fetch_add(ip + j0 + 1, L0, __ATOMIC_RELAXED, __HIP_MEMORY_SCOPE_WORKGROUP);
                    __hip_atomic_fetch_add(ip + j1, A1, __ATOMIC_RELAXED, __HIP_MEMORY_SCOPE_WORKGROUP);
                    if (j1 + 1 < 128) __hip_atomic_fetch_add(ip + j1 + 1, L1, __ATOMIC_RELAXED, __HIP_MEMORY_SCOPE_WORKGROUP);
                }
            }
            pv(o0, o1, kv + (jt & 1) * KVBUF, p0, p1, lane);
        }
        const float g0 = gp[0];
#pragma unroll
        for (int r = 0; r < 16; ++r) { YSV[r * 512] = g0 * o0[r]; YSV[(16 + r) * 512] = g0 * o1[r]; }
        LDS_WAIT();
        for (int qi = 0; qi < 8; ++qi) {
            const int q = 8 * wid + qi;
            const unsigned k0 = __float_as_uint(IMP[q * 128 + lane]), k1 = __float_as_uint(IMP[q * 128 + 64 + lane]);
            const bool c0 = (lane >= 1) && (lane <= cur - 2), c1 = (64 + lane <= cur - 2);
            unsigned long long s0, s1;
            if (cur - 2 <= 13) { s0 = __ballot(c0); s1 = __ballot(c1); }
            else {
                unsigned T = 0u;
                for (int bit = 30; bit >= 0; --bit) { const unsigned cand = T | (1u << bit);
                    const int cnt = __popcll(__ballot(c0 && k0 >= cand)) + __popcll(__ballot(c1 && k1 >= cand));
                    if (cnt >= 13) T = cand; }
                s0 = __ballot(c0 && k0 > T); s1 = __ballot(c1 && k1 > T);
                int need = 13 - __popcll(s0) - __popcll(s1);
                unsigned long long e0 = __ballot(c0 && k0 == T), e1 = __ballot(c1 && k1 == T);
                while (need > 0) { if (e0) { const unsigned long long bb = e0 & (0ull - e0); s0 |= bb; e0 ^= bb; } else if (e1) { const unsigned long long bb = e1 & (0ull - e1); s1 |= bb; e1 ^= bb; } else break; --need; }
            }
            s0 |= 1ull;
            if (cur < 64) s0 |= 1ull << cur; else s1 |= 1ull << (cur - 64);
            if (cur >= 1) { if (cur - 1 < 64) s0 |= 1ull << (cur - 1); else s1 |= 1ull << (cur - 65); }
            if (lane == 0) { SELM[q * 4 + 0] = (unsigned)s0; SELM[q * 4 + 1] = (unsigned)(s0 >> 32); SELM[q * 4 + 2] = (unsigned)s1; SELM[q * 4 + 3] = (unsigned)(s1 >> 32); }
        }
    }
    LDS_WAIT(); __syncthreads();
    unsigned um[4], mym[4];
#pragma unroll
    for (int w = 0; w < 4; ++w) { unsigned v = SELM[lane * 4 + w];
#pragma unroll
        for (int o = 1; o < 64; o <<= 1) v |= (unsigned)__shfl_xor((int)v, o);
        um[w] = (unsigned)__builtin_amdgcn_readfirstlane((int)v); mym[w] = SELM[ql * 4 + w]; }
    const float a64 = a * 64.0f;
    const bf16_t* PK = PROJ;
    {
        f32x16 o0 = {}, o1 = {}; float m = NEGF, l = 0.f;
        int j = cur, jn = next_below(um[0], um[1], um[2], um[3], cur), par = 0;
        __syncthreads();
        issue_kv(kv, kptr<PP>(PK, 64 * j, C_KSLC + g * 64, wid, lane), vptr<PP>(PK, 64 * j, C_VSLC + g * 64, wid, lane), wid);
        while (j >= 0) {
            VM_WAIT(); __syncthreads();
            if (jn >= 0) issue_kv(kv + (par ^ 1) * KVBUF, kptr<PP>(PK, 64 * jn, C_KSLC + g * 64, wid, lane), vptr<PP>(PK, 64 * jn, C_VSLC + g * 64, wid, lane), wid);
            const unsigned mw = (j < 32) ? mym[0] : (j < 64) ? mym[1] : (j < 96) ? mym[2] : mym[3];
            const bool mine = (mw >> (j & 31)) & 1u;
            const float base = mine ? (a64 * (float)(j - cur) + a * (float)(4 * hi)) : NEGF;
            f32x16 p0, p1;
#pragma unroll
            for (int r = 0; r < 16; ++r) { p0[r] = fmaf(a, kc_r[r], base); p1[r] = p0[r] + a * 32.0f; }
            if (j == cur) tile_step<true>(kv + par * KVBUF, qr, p0, p1, 0, ql, o0, o1, m, l, lane);
            else tile_step<false>(kv + par * KVBUF, qr, p0, p1, 0, 63, o0, o1, m, l, lane);
            j = jn; if (jn >= 0) jn = next_below(um[0], um[1], um[2], um[3], jn); par ^= 1;
        }
        const float sc = gp[1] / half_swap_sum(l);
#pragma unroll
        for (int r = 0; r < 16; ++r) { YSV[r * 512] += sc * o0[r]; YSV[(16 + r) * 512] += sc * o1[r]; }
    }
    {
        f32x16 o0 = {}, o1 = {}; float m = NEGF, l = 0.f;
        const int jlo = cur >= 8 ? cur - 8 : 0;
        __syncthreads();
        issue_kv(kv + (cur & 1) * KVBUF, kptr<PP>(PK, 64 * cur, C_KWIN + g * 64, wid, lane), vptr<PP>(PK, 64 * cur, C_VWIN + g * 64, wid, lane), wid);
        for (int j = cur; j >= jlo; --j) {
            VM_WAIT(); __syncthreads();
            if (j > jlo) issue_kv(kv + ((j - 1) & 1) * KVBUF, kptr<PP>(PK, 64 * (j - 1), C_KWIN + g * 64, wid, lane), vptr<PP>(PK, 64 * (j - 1), C_VWIN + g * 64, wid, lane), wid);
            const float base = a64 * (float)(j - cur) + a * (float)(4 * hi);
            f32x16 p0, p1;
#pragma unroll
            for (int r = 0; r < 16; ++r) { p0[r] = fmaf(a, kc_r[r], base); p1[r] = p0[r] + a * 32.0f; }
            const LAS unsigned char* buf = kv + (j & 1) * KVBUF;
            if (j == cur) tile_step<true>(buf, qr, p0, p1, 0, ql, o0, o1, m, l, lane);
            else if (j == cur - 8) tile_step<true>(buf, qr, p0, p1, ql + 1, 63, o0, o1, m, l, lane);
            else tile_step<false>(buf, qr, p0, p1, 0, 63, o0, o1, m, l, lane);
        }
        const float sc = gp[2] / half_swap_sum(l);
#pragma unroll
        for (int r = 0; r < 16; ++r) { o0[r] = YSV[r * 512] + sc * o0[r]; o1[r] = YSV[(16 + r) * 512] + sc * o1[r]; }
        store_cols(YA + (size_t)t * 512 + head * 64, o0, o1, hi);
    }
}
}
__device__ __forceinline__ void p3c_rows(Frame& F) {
    LAS float* WR = (LAS float*)F.lds;
    for (int i = F.tid; i < 4096; i += NWAVES * 64) { const int k = i >> 2, e = i & 3; WR[e * 1024 + k] = F.w_rg[i]; }
    for (int i = F.tid; i < 32768; i += NWAVES * 64) { const int k = i >> 5, e = i & 31; WR[(4 + e) * 1024 + k] = F.w_re[i]; }
    __syncthreads();
    const int gw = blockIdx.x * NWAVES + F.wave, NGW = F.G * NWAVES, lane = F.lane;
    const float* MIXED = (const float*)(F.ws + WS_YY); bf16_t* H2 = (bf16_t*)(F.ws + WS_HN);
    u32x2* LIST = (u32x2*)(F.ws + WS_LIST);
    f32x4 gpost[4], gpre[4]; ld_row4(F.g_post_mix, lane, gpost); ld_row4(F.g_pre_ffn, lane, gpre);
    int curb = -1; f32x4 gt[4], mul[4], add[4];
    for (int m = gw; m < M; m += NGW) {
        const int b = m >> 13;
        if (b != curb) { f32x4 sc[4]; mod_final(F, b, 2, gt); mod_final(F, b, 3, add); mod_final(F, b, 4, sc); curb = b;
#pragma unroll
            for (int j = 0; j < 4; ++j) { gt[j] = gt[j] * gpost[j]; mul[j] = gpre[j] * (sc[j] + 1.0f); } }
        f32x4 v[4], xr[4]; ld_row4(MIXED + (size_t)m * DM, lane, v); ld_row4(F.x + (size_t)m * DM, lane, xr);
        const float rstd = 1.0f / sqrtf(wave_sum(sumsq4(v)) * (1.0f / DM) + NORM_EPS);
#pragma unroll
        for (int j = 0; j < 4; ++j) { xr[j] = xr[j] + gt[j] * (v[j] * rstd); *(f32x4*)(F.out + (size_t)m * DM + 256 * j + 4 * lane) = xr[j]; }
        const float rstd2 = 1.0f / sqrtf(wave_sum(sumsq4(xr)) * (1.0f / DM) + NORM_EPS);
#pragma unroll
        for (int j = 0; j < 4; ++j) v[j] = xr[j] * rstd2 * mul[j] + add[j];
        st_row_bf16(H2 + (size_t)m * DM, lane, v);
        float lg[4];
#pragma unroll
        for (int e = 0; e < 4; ++e) { float s = 0.f;
#pragma unroll
            for (int j = 0; j < 4; ++j) { const f32x4 w = *(const LAS f32x4*)(WR + e * 1024 + 256 * j + 4 * lane); s += (v[j][0] * w[0] + v[j][1] * w[1]) + (v[j][2] * w[2] + v[j][3] * w[3]); }
            lg[e] = wave_sum(s) + F.b_rg[e]; }
        float pe[32];
#pragma unroll
        for (int e = 0; e < 32; ++e) { float s = 0.f;
#pragma unroll
            for (int j = 0; j < 4; ++j) { const f32x4 w = *(const LAS f32x4*)(WR + (4 + e) * 1024 + 256 * j + 4 * lane); s += (v[j][0] * w[0] + v[j][1] * w[1]) + (v[j][2] * w[2] + v[j][3] * w[3]); }
            pe[e] = s;
            if ((e & 3) == 3) asm volatile("" ::: "memory"); }
        { const bool b5 = (lane & 32) != 0;
#pragma unroll
          for (int i = 0; i < 16; ++i) { const float keep = b5 ? pe[i + 16] : pe[i], give = b5 ? pe[i] : pe[i + 16]; pe[i] = keep + __shfl_xor(give, 32); } }
        { const bool b4 = (lane & 16) != 0;
#pragma unroll
          for (int i = 0; i < 8; ++i) { const float keep = b4 ? pe[i + 8] : pe[i], give = b4 ? pe[i] : pe[i + 8]; pe[i] = keep + __shfl_xor(give, 16); } }
        { const bool b3 = (lane & 8) != 0;
#pragma unroll
          for (int i = 0; i < 4; ++i) { const float keep = b3 ? pe[i + 4] : pe[i], give = b3 ? pe[i] : pe[i + 4]; pe[i] = keep + __shfl_xor(give, 8); } }
        { const bool b2 = (lane & 4) != 0;
#pragma unroll
          for (int i = 0; i < 2; ++i) { const float keep = b2 ? pe[i + 2] : pe[i], give = b2 ? pe[i] : pe[i + 2]; pe[i] = keep + __shfl_xor(give, 4); } }
        { const bool b1 = (lane & 2) != 0; const float keep = b1 ? pe[1] : pe[0], give = b1 ? pe[0] : pe[1]; pe[0] = keep + __shfl_xor(give, 2); }
        const float le_l = pe[0] + __shfl_xor(pe[0], 1);
        int gi = 0; float gm = lg[0];
#pragma unroll
        for (int e = 1; e < 4; ++e) if (lg[e] > gm) { gm = lg[e]; gi = e; }
        float gs = 0.f;
#pragma unroll
        for (int e = 0; e < 4; ++e) gs += __expf(lg[e] - gm);
        const float pg = 1.0f / gs;
        float l0 = -INFINITY, l1 = -INFINITY; int e0 = 0, e1 = 0;
#pragma unroll
        for (int i = 0; i < 8; ++i) { const float lv = __shfl(le_l, 2 * (gi * 8 + i)) + F.b_re[gi * 8 + i];
            if (lv > l0) { l1 = l0; e1 = e0; l0 = lv; e0 = i; } else if (lv > l1) { l1 = lv; e1 = i; } }
        const float w0 = 1.0f / (1.0f + __expf(l1 - l0)), w1 = 1.0f - w0;
        if (lane == 0) {
            const int x0 = gi * 8 + e0, x1 = gi * 8 + e1;
            const unsigned r0 = __hip_atomic_fetch_add(F.ctl + CW_ECNT + 64 * x0, 1u, RLX_AGENT);
            const unsigned r1 = __hip_atomic_fetch_add(F.ctl + CW_ECNT + 64 * x1, 1u, RLX_AGENT);
            u32x2 a; a.x = (unsigned)(2 * m); a.y = __float_as_uint(pg * w0); LIST[(size_t)x0 * M + r0] = a;
            u32x2 c; c.x = (unsigned)(2 * m + 1); c.y = __float_as_uint(pg * w1); LIST[(size_t)x1 * M + r1] = c;
        }
    }
}
__device__ __forceinline__ void p5_rows(Frame& F) {
    const int gw = blockIdx.x * NWAVES + F.wave, NGW = F.G * NWAVES, lane = F.lane;
    const bf16_t* Y2 = (const bf16_t*)(F.ws + WS_YY);
    f32x4 gpost[4]; ld_row4(F.g_post_ffn, lane, gpost);
    int curb = -1; f32x4 gt[4];
    for (int m = gw; m < M; m += NGW) {
        const int b = m >> 13;
        if (b != curb) { mod_final(F, b, 5, gt); curb = b;
#pragma unroll
            for (int j = 0; j < 4; ++j) gt[j] = gt[j] * gpost[j]; }
        f32x4 y[4], xr[4]; ld_row4(F.out + (size_t)m * DM, lane, xr);
#pragma unroll
        for (int j = 0; j < 4; ++j) { const u32x2 a = *(const u32x2*)(Y2 + (size_t)(2 * m) * DM + 256 * j + 4 * lane), c = *(const u32x2*)(Y2 + (size_t)(2 * m + 1) * DM + 256 * j + 4 * lane);
            y[j] = (f32x4){bflo(a.x) + bflo(c.x), bfhi(a.x) + bfhi(c.x), bflo(a.y) + bflo(c.y), bfhi(a.y) + bfhi(c.y)}; }
        const float rstd = 1.0f / sqrtf(wave_sum(sumsq4(y)) * (1.0f / DM) + NORM_EPS);
#pragma unroll
        for (int j = 0; j < 4; ++j) *(f32x4*)(F.out + (size_t)m * DM + 256 * j + 4 * lane) = xr[j] + gt[j] * (y[j] * rstd);
    }
}

#ifndef MK_N_LAUNCHES
#define MK_N_LAUNCHES 1
#endif
constexpr int N_PHASES = 11;
struct Args { const float* in[26]; float* out; unsigned char* ws; int ph_lo, ph_hi; };
__global__ void __launch_bounds__(NWAVES * 64, 2) fwd_kernel(Args args) {
    extern __shared__ __attribute__((aligned(16))) unsigned char lds[];
    Frame F;
    F.lds = (LAS unsigned char*)lds;
    F.MISC = (volatile LAS unsigned*)(F.lds + MISC_OFF);
    F.tid = threadIdx.x; F.lane = F.tid & 63; F.wave = __builtin_amdgcn_readfirstlane(F.tid >> 6); F.G = gridDim.x;
    F.ws = args.ws; F.ctl = (unsigned*)(args.ws + WS_CTL); F.out = args.out;
    F.x = args.in[0]; F.c = args.in[1]; F.w_ada = args.in[2]; F.b_ada = args.in[3]; F.g_pre_mix = args.in[4]; F.g_post_mix = args.in[5]; F.g_pre_ffn = args.in[6]; F.g_post_ffn = args.in[7];
    F.w_in = args.in[8]; F.b_forget = args.in[9]; F.pe_k = args.in[10]; F.w1_k = args.in[11]; F.w2_k = args.in[12]; F.pe_v = args.in[13]; F.w1_v = args.in[14]; F.w2_v = args.in[15];
    F.w_o_nsa = args.in[16]; F.w_o_fox = args.in[17]; F.w_out = args.in[18]; F.w_rg = args.in[19]; F.b_rg = args.in[20]; F.w_re = args.in[21]; F.b_re = args.in[22];
    F.w_eg = args.in[23]; F.w_eu = args.in[24]; F.w_ed = args.in[25];
    for (int u = F.tid; u < 256; u += NWAVES * 64) F.MISC[u] = 0u;
    __syncthreads();
    const int lo = args.ph_lo, hi = args.ph_hi;
    XcdBarrier bar; bar.bar = F.ctl + CW_BAR; bar.x = 0; bar.st = nullptr;
    if (hi - lo > 1) bar = xcd_barrier_post(F.ctl + CW_BAR, F.MISC + 8);
#ifndef PH_MASK
#define PH_MASK 0x7ff
#endif
#define IN(k) (((PH_MASK >> (k)) & 1) && lo <= (k) && (k) < hi)
#define SEAM(k) do { if (IN(k) && IN((k) + 1)) xcd_barrier(bar); } while (0)
    bf16_t* const HN = (bf16_t*)(F.ws + WS_HN);
    bf16_t* const PROJ = (bf16_t*)(F.ws + WS_PROJ);
    if (IN(0)) { p0_prologue(F); SEAM(0); }
    if (IN(1)) { p0b_rows(F); SEAM(1); }
    if (IN(2)) {
        pg8::Gemm g{HN, (const bf16_t*)(F.ws + WS_WINT), M, NPAD, DM}; pg8::StaticOrder S; S.init(M, NPAD, F.G, (int)blockIdx.x);
        EpiProj E{PROJ, (float*)(F.ws + WS_GATES), (float*)(F.ws + WS_LF), F.b_forget};
        pg8::gemm_phase<false>(F.lds, g, S, E, pg8::NoGather{});
        SEAM(2);
    }
    if (IN(3)) {
        for (int it = blockIdx.x; it < 144; it += F.G) { if (it < 128) p2a_item_cmp(F, it); else p2a_item_cumsum(F, it - 128); }
        SEAM(3);
    }
    if (IN(4)) {
        for (;;) {
            __syncthreads();
            if (F.tid == 0) F.MISC[16] = __hip_atomic_fetch_add(F.ctl + CW_QCTR, 1u, RLX_AGENT);
            __syncthreads();
            const int idx = (int)F.MISC[16];
            if (idx >= 1024) break;
            const int lev = 31 - (idx >> 5), w = idx & 31;
#ifndef ATT_NO_FOX
            if (w < 16) att::fox_unit(F, w >> 3, w & 7, lev);
#endif
#ifndef ATT_NO_NSA
            if (w >= 16) { const int k = w - 16; att::nsa_unit(F, (k & 3) >> 1, k & 1, 4 * lev + 3 - (k >> 2)); }
#endif
        }
        SEAM(4);
    }
    if (IN(5)) {
        pg8::Gemm g{(const bf16_t*)(F.ws + WS_YY), (const bf16_t*)(F.ws + WS_WOT), 2 * M, 2048, 512}; OutOrder S{F.G, (int)blockIdx.x};
        EpiOut E{HN, PROJ};
        pg8::gemm_phase<false>(F.lds, g, S, E, pg8::NoGather{});
        SEAM(5);
    }
    if (IN(6)) {
        pg8::Gemm g{HN, (const bf16_t*)(F.ws + WS_WOUTT), M, DM, DM}; pg8::StaticOrder S; S.init(M, DM, F.G, (int)blockIdx.x);
        EpiF32 E{(float*)(F.ws + WS_YY), DM};
        pg8::gemm_phase<false>(F.lds, g, S, E, pg8::NoGather{});
        expert_convert(F);
        SEAM(6);
    }
    if (IN(7)) { __syncthreads(); p3c_rows(F); SEAM(7); }
    if (IN(8) || IN(9)) {
        __syncthreads();
        if (F.tid < 32) F.MISC[96 + F.tid] = __hip_atomic_load(F.ctl + CW_ECNT + 64 * F.tid, RLX_AGENT);
        __syncthreads();
        if (F.tid == 0) { unsigned s = 0; for (int e = 0; e < 32; ++e) { F.MISC[32 + e] = s; s += (F.MISC[96 + e] + 255u) >> 8; } F.MISC[64] = s; }
        __syncthreads();
    }
    if (IN(8)) {
        pg8::Gemm g{HN, (const bf16_t*)(F.ws + WS_WGUT), M, 32768, DM}; MoeOrder S{F.MISC + 32, F.G, (int)blockIdx.x};
        EpiSwiglu E{(bf16_t*)(F.ws + WS_HBUF)}; MoeGather GT{(const u32x2*)(F.ws + WS_LIST), F.MISC + 32, F.MISC + 96};
        pg8::gemm_phase<true>(F.lds, g, S, E, GT);
        SEAM(8);
    }
    if (IN(9)) {
        pg8::Gemm g{(const bf16_t*)(F.ws + WS_HBUF), (const bf16_t*)(F.ws + WS_WDT), HROWS_MAX, 32768, DEXP}; MoeOrder S{F.MISC + 32, F.G, (int)blockIdx.x};
        EpiDown E{(bf16_t*)(F.ws + WS_YY), (const u32x2*)(F.ws + WS_LIST), F.MISC + 32, F.MISC + 96};
        pg8::gemm_phase<false>(F.lds, g, S, E, pg8::NoGather{});
        SEAM(9);
    }
    if (IN(10)) { p5_rows(F); }
#undef IN
#undef SEAM
}

extern "C" void kernel_launch(void* const* d_in, const int* in_sizes, int n_in, void* d_out, int out_size, void* d_ws, size_t ws_size, hipStream_t stream) {
    static int grid = 0;
    if (grid == 0) {
        if (n_in != 26 || in_sizes[0] != M * DM || out_size != M * DM || ws_size < WS_END) { fprintf(stderr, "kernel_launch: unexpected shapes (n_in %d, in0 %d, out %d, ws %zu < %zu); nothing launched\n", n_in, n_in > 0 ? in_sizes[0] : -1, out_size, ws_size, (size_t)WS_END); grid = -1; return; }
        int dev = 0, cus = 0, per_cu = 0;
        if (hipGetDevice(&dev) != hipSuccess || hipDeviceGetAttribute(&cus, hipDeviceAttributeMultiprocessorCount, dev) != hipSuccess) { grid = -1; return; }
        if (hipFuncSetAttribute((const void*)fwd_kernel, hipFuncAttributeMaxDynamicSharedMemorySize, LDS_BYTES) != hipSuccess) { fprintf(stderr, "kernel_launch: hipFuncSetAttribute failed\n"); grid = -1; return; }
        if (hipOccupancyMaxActiveBlocksPerMultiprocessor(&per_cu, (const void*)fwd_kernel, NWAVES * 64, LDS_BYTES) != hipSuccess || per_cu < 1) { fprintf(stderr, "kernel_launch: occupancy query failed (%d)\n", per_cu); per_cu = 1; }
        (void)hipGetLastError();
        grid = cus * (per_cu > 1 ? 1 : per_cu);
    }
    if (grid < 0) return;
    if (hipMemsetAsync((char*)d_ws + WS_CTL, 0, CTL_ZERO_BYTES, stream) != hipSuccess) { fprintf(stderr, "kernel_launch: memset failed\n"); return; }
    Args a{};
    for (int i = 0; i < 26; ++i) a.in[i] = (const float*)d_in[i];
    a.out = (float*)d_out; a.ws = (unsigned char*)d_ws;
#if MK_N_LAUNCHES == 1
    a.ph_lo = 0; a.ph_hi = N_PHASES;
    void* kargs[] = {&a};
    const hipError_t le = hipLaunchCooperativeKernel((const void*)fwd_kernel, dim3(grid), dim3(NWAVES * 64), kargs, LDS_BYTES, stream);
    if (le != hipSuccess) fprintf(stderr, "kernel_launch: cooperative launch failed: %s (grid %d)\n", hipGetErrorName(le), grid);
#else
    for (int p = 0; p < N_PHASES; ++p) {
        a.ph_lo = p; a.ph_hi = p + 1;
        hipLaunchKernelGGL(fwd_kernel, dim3(grid), dim3(NWAVES * 64), LDS_BYTES, stream, a);
    }
    const hipError_t le = hipPeekAtLastError();
    if (le != hipSuccess) fprintf(stderr, "kernel_launch: launch failed: %s\n", hipGetErrorName(le));
#endif
}
```

```cpp
#include <hip/hip_runtime.h>
#include <hip/hip_bf16.h>
#include <cstdio>
#include <cstdint>
#include <cmath>

#define LAS __attribute__((address_space(3)))
#define GAS __attribute__((address_space(1)))
typedef unsigned short bf16_t;
typedef short bf16x8 __attribute__((ext_vector_type(8)));
typedef short s16x4 __attribute__((ext_vector_type(4)));
typedef float f32x4 __attribute__((ext_vector_type(4)));
typedef float f32x2 __attribute__((ext_vector_type(2)));
typedef float f32x16 __attribute__((ext_vector_type(16)));
typedef unsigned u32x4 __attribute__((ext_vector_type(4)));
typedef unsigned u32x2 __attribute__((ext_vector_type(2)));
typedef __bf16 bf16x2_t __attribute__((ext_vector_type(2)));

__device__ __forceinline__ unsigned cvtpk(float lo, float hi) { f32x2 v = {lo, hi}; bf16x2_t b = __builtin_convertvector(v, bf16x2_t); return __builtin_bit_cast(unsigned, b); }
__device__ __forceinline__ float bf2f(unsigned short h) { return __uint_as_float(((unsigned)h) << 16); }
__device__ __forceinline__ float bflo(unsigned w) { return __uint_as_float(w << 16); }
__device__ __forceinline__ float bfhi(unsigned w) { return __uint_as_float(w & 0xffff0000u); }
__device__ __forceinline__ float sigmoidf_(float x) { return 1.0f / (1.0f + __expf(-x)); }

namespace pg8 {
constexpr int BM = 256, BK = 64, HALF = 128, HTB = HALF * BK * 2  , STAGE_BYTES = 8 * HTB, NXCD = 8, WGM = 8;

__host__ __device__ __forceinline__ int lds_byte(int r, int c) { const int st = (r >> 4) * 2 + (c >> 5), rr = r & 15, cc = c & 31, ob = rr * 64 + cc * 2; return st * 1024 + (ob ^ (((ob >> 9) & 1) << 5)); }
__host__ __device__ __forceinline__ void stage_rc(int b, int& R, int& C) { const int st = b / 1024, sb = b % 1024, swz = sb ^ (((sb >> 9) & 1) << 5); R = (st >> 1) * 16 + swz / 64; C = (st & 1) * 32 + (swz % 64) / 2; }
__host__ __device__ __forceinline__ int perm32(int rho) { const int n = rho >> 4, i = rho & 15; return 8 * (i >> 2) + 4 * n + (i & 3); }

struct Unit { int pm, pn; };
struct Gemm { const bf16_t* A; const bf16_t* Bt; int M, N, K; };

struct StaticOrder {
    int nM, nN, nwg, G, c;
    __host__ __device__ void init(int M, int N, int G_, int c_) { nM = M / BM; nN = N / BM; nwg = nM * nN; G = G_; c = c_; }
    __host__ __device__ bool next(int i, Unit& u) const {
        const long L = (long)i * G + c; if (L >= nwg) return false;
        int wgid = (int)L; { const int q = nwg / NXCD, r = nwg % NXCD, xcd = wgid % NXCD, off = wgid / NXCD; wgid = (xcd < r ? xcd * (q + 1) : r * (q + 1) + (xcd - r) * q) + off; }
        const int nig = WGM * nN, gid = wgid / nig, fm = gid * WGM, gsz = (nM - fm) < WGM ? (nM - fm) : WGM;
        u.pm = fm + ((wgid % nig) % gsz); u.pn = (wgid % nig) / gsz; return true;
    }
};
struct NoGather { __device__ __forceinline__ int row(const Unit&, int) const { return 0; } };
struct NoMid { static constexpr bool ENABLED = false; __device__ __forceinline__ void operator()(f32x4 (&)[2][2][4][2], const Unit&, int, int, int, int) const {} };

template <bool GATHER, class Epi, class Sched, class Gath, class Mid = NoMid>
__device__ __forceinline__ void gemm_phase(LAS unsigned char* lds, const Gemm g, const Sched& S, const Epi& E, const Gath& GT, const Mid& MD = Mid{}) {
    const int tid = threadIdx.x, wid = __builtin_amdgcn_readfirstlane(tid >> 6), lane = tid & 63, wr = wid >> 2, wc = wid & 3, fr = lane & 15, fq = lane >> 4;
    const int K = g.K, nt = K / BK;
    unsigned voffA[2], voffB[2];
#pragma unroll
    for (int i = 0; i < 2; ++i) { int R, C; stage_rc(tid * 16 + i * 8192, R, C); const int Rb = (R & ~31) + perm32(R & 31);
        voffA[i] = (unsigned)(R * K + C) * 2u; voffB[i] = (unsigned)(Rb * K + C) * 2u; }
    const size_t kstep = (size_t)(BK * 2);
    const size_t hstep = (size_t)HALF * K * 2;
    const size_t tstep = 2 * hstep;
    const unsigned ldsw = (unsigned)wid * 1024u;
    const int aoff = lds_byte(wr * 64 + fr, fq * 8), boff = lds_byte(wc * 32 + fr, fq * 8);
#define PG8_SA(b, h) (((b) * 2 + (h)) * HTB)
#define PG8_SB(b, h) ((4 + (b) * 2 + (h)) * HTB)
#define PG8_STG2(bufoff, gbase, o0, o1) do { \
        __builtin_amdgcn_global_load_lds((const unsigned*)((const char*)(gbase) + (o0)), (LAS unsigned*)(lds + (bufoff) + ldsw), 16, 0, 0); \
        __builtin_amdgcn_global_load_lds((const unsigned*)((const char*)(gbase) + (o1)), (LAS unsigned*)(lds + (bufoff) + ldsw + 8192), 16, 0, 0); } while (0)
#define PG8_STAGE(bufoff, gbase, voff) PG8_STG2(bufoff, gbase, (voff)[0], (voff)[1])
#define PG8_STAGE_A(bufoff, h, kt, NX) do { if constexpr (GATHER) { const char* _b = (const char*)g.A + (size_t)(kt) * kstep; \
            const u32x2 _o = *(const LAS u32x2*)(gtab + ((NX) ? 4 : 0) + (h) * 2); PG8_STG2(bufoff, _b, _o.x, _o.y); } \
        else { const char* _b = ((NX) ? nA : cA) + (size_t)(h) * hstep + (size_t)(kt) * kstep; PG8_STG2(bufoff, _b, voffA[0], voffA[1]); } } while (0)
#define PG8_GOFF(U, s) do { _Pragma("unroll") for (int _h = 0; _h < 2; ++_h) _Pragma("unroll") for (int _i = 0; _i < 2; ++_i) { int _R, _C; stage_rc(tid * 16 + _i * 8192, _R, _C); \
            gtab[(s) * 4 + _h * 2 + _i] = (unsigned)(GT.row(U, _h * HALF + _R) * K + _C) * 2u; } } while (0)
#define PG8_LDA(dst, b, h) do { _Pragma("unroll") for (int m = 0; m < 4; ++m) _Pragma("unroll") for (int k = 0; k < 2; ++k) dst[m][k] = *(const LAS bf16x8*)(lds + PG8_SA(b, h) + aoff + m * 2048 + k * 1024); } while (0)
#define PG8_LDB(dst, b, h) do { _Pragma("unroll") for (int n = 0; n < 2; ++n) _Pragma("unroll") for (int k = 0; k < 2; ++k) dst[n][k] = *(const LAS bf16x8*)(lds + PG8_SB(b, h) + boff + n * 2048 + k * 1024); } while (0)
#define PG8_MMA(ai, bj, At, Bt) do { __builtin_amdgcn_s_setprio(1); _Pragma("unroll") for (int m = 0; m < 4; ++m) _Pragma("unroll") for (int n = 0; n < 2; ++n) _Pragma("unroll") for (int k = 0; k < 2; ++k) \
        acc[ai][bj][m][n] = __builtin_amdgcn_mfma_f32_16x16x32_bf16(Bt[n][k], At[m][k], acc[ai][bj][m][n], 0, 0, 0); __builtin_amdgcn_s_setprio(0); } while (0)
#define PG8_WAIT_V(n) asm volatile("s_waitcnt vmcnt(" #n ")" ::: "memory")
#define PG8_WAIT_L(n) asm volatile("s_waitcnt lgkmcnt(" #n ")" ::: "memory")
#define PG8_BAR __builtin_amdgcn_s_barrier()
#define PG8_SCHED __builtin_amdgcn_sched_barrier(0)
    Unit cur, nxt; int ui = 0;
    if (!S.next(0, cur)) return;
    f32x4 acc[2][2][4][2];
#pragma unroll
    for (int a = 0; a < 2; ++a)
#pragma unroll
        for (int b = 0; b < 2; ++b)
#pragma unroll
            for (int m = 0; m < 4; ++m)
#pragma unroll
                for (int n = 0; n < 2; ++n) acc[a][b][m][n] = (f32x4){0.f, 0.f, 0.f, 0.f};
    bf16x8 At[4][2], B0[2][2], B1[2][2];
    LAS unsigned* const gtab = (LAS unsigned*)(lds + STAGE_BYTES) + tid * 8;
    const char* cA = (const char*)g.A + (size_t)cur.pm * tstep; const char* cB = (const char*)g.Bt + (size_t)cur.pn * tstep;
    const char* nA = cA;
    if constexpr (GATHER) { PG8_GOFF(cur, 0); }
    PG8_STAGE(PG8_SB(0, 0), cB, voffB); PG8_STAGE(PG8_SB(0, 1), cB + hstep, voffB); PG8_STAGE_A(PG8_SA(0, 0), 0, 0, false); PG8_STAGE_A(PG8_SA(0, 1), 1, 0, false);
    if (wr == 1) PG8_BAR;
    PG8_WAIT_V(2); PG8_BAR;
    PG8_STAGE(PG8_SB(1, 0), cB + kstep, voffB); PG8_STAGE_A(PG8_SA(1, 0), 0, 1, false); PG8_STAGE(PG8_SB(1, 1), cB + hstep + kstep, voffB);
    PG8_WAIT_V(6); PG8_BAR;
    for (;;) {
        const bool has_next = S.next(ui + 1, nxt);
        nA = has_next ? (const char*)g.A + (size_t)nxt.pm * tstep : cA; const char* nB = has_next ? (const char*)g.Bt + (size_t)nxt.pn * tstep : cB;
        if constexpr (GATHER) { if (has_next) PG8_GOFF(nxt, 1); else { *(LAS u32x4*)(gtab + 4) = *(const LAS u32x4*)gtab; } }
        for (int t = 0; t < nt; t += 2) {
            const bool last = (t == nt - 2);
            const char* b2 = last ? nB : cB + (size_t)(t + 2) * kstep;
            const char* b3 = b2 + kstep;
            const int k2 = last ? 0 : t + 2, k3 = k2 + 1;
            PG8_LDB(B0, 0, 0); PG8_LDB(B1, 0, 1); PG8_SCHED; PG8_LDA(At, 0, 0); PG8_STAGE_A(PG8_SA(1, 1), 1, t + 1, false);
            PG8_WAIT_V(8); PG8_WAIT_L(0); PG8_BAR; PG8_MMA(0, 0, At, B0); PG8_MMA(0, 1, At, B1); PG8_BAR; PG8_SCHED;
            PG8_LDA(At, 0, 1); PG8_STAGE(PG8_SB(0, 0), b2, voffB); PG8_STAGE(PG8_SB(0, 1), b2 + hstep, voffB);
            if (last) PG8_STAGE_A(PG8_SA(0, 0), 0, k2, true); else PG8_STAGE_A(PG8_SA(0, 0), 0, k2, false);
            PG8_WAIT_V(8); PG8_WAIT_L(0); PG8_BAR; PG8_MMA(1, 0, At, B0); PG8_MMA(1, 1, At, B1); PG8_BAR; PG8_SCHED;
            PG8_LDB(B0, 1, 0); PG8_LDB(B1, 1, 1); PG8_SCHED; PG8_LDA(At, 1, 0);
            if (last) PG8_STAGE_A(PG8_SA(0, 1), 1, k2, true); else PG8_STAGE_A(PG8_SA(0, 1), 1, k2, false);
            PG8_WAIT_V(8); PG8_WAIT_L(0); PG8_BAR; PG8_MMA(0, 0, At, B0); PG8_MMA(0, 1, At, B1); PG8_BAR; PG8_SCHED;
            PG8_LDA(At, 1, 1); PG8_STAGE(PG8_SB(1, 0), b3, voffB); PG8_STAGE(PG8_SB(1, 1), b3 + hstep, voffB);
            if (last) PG8_STAGE_A(PG8_SA(1, 0), 0, k3, true); else PG8_STAGE_A(PG8_SA(1, 0), 0, k3, false);
            PG8_WAIT_V(8); PG8_WAIT_L(0); PG8_BAR; PG8_MMA(1, 0, At, B0); PG8_MMA(1, 1, At, B1); PG8_BAR; PG8_SCHED;
            if constexpr (Mid::ENABLED) { if (t + 2 == nt / 2) MD(acc, cur, wr, wc, fr, fq); }
        }
        if (wr == 0) PG8_BAR;
        E(acc, cur, wr, wc, fr, fq);
        if (!has_next) break;
#pragma unroll
        for (int a = 0; a < 2; ++a)
#pragma unroll
            for (int b = 0; b < 2; ++b)
#pragma unroll
                for (int m = 0; m < 4; ++m)
#pragma unroll
                    for (int n = 0; n < 2; ++n) acc[a][b][m][n] = (f32x4){0.f, 0.f, 0.f, 0.f};
        cur = nxt; cA = nA; cB = nB; ++ui;
        if constexpr (GATHER) { *(LAS u32x4*)gtab = *(const LAS u32x4*)(gtab + 4); }
        if (wr == 1) PG8_BAR;
    }
    PG8_WAIT_V(0);
    PG8_BAR;
#undef PG8_SA
#undef PG8_SB
#undef PG8_STG2
#undef PG8_STAGE
#undef PG8_STAGE_A
#undef PG8_GOFF
#undef PG8_LDA
#undef PG8_LDB
#undef PG8_MMA
#undef PG8_WAIT_V
#undef PG8_WAIT_L
#undef PG8_BAR
#undef PG8_SCHED
}
}
constexpr int NWAVES = 8;
constexpr int BATCH = 2, SEQ = 8192, DM = 1024, M = BATCH * SEQ;
constexpr int DIN = 4896, PP = 4864  , NPAD = 5120  ;
constexpr int C_QA = 0, C_KCMP = 512, C_VCMP = 640, C_KSLC = 768, C_VSLC = 896, C_KWIN = 1024, C_VWIN = 1152, C_FQ = 1280, C_FK = 1792, C_FV = 2304, C_MG = 2816;
constexpr float LOG2E = 1.4426950408889634f;
constexpr float C2 = 0.125f * LOG2E;
constexpr float NORM_EPS = 1e-6f;
constexpr float NEGF = -1e30f;
constexpr int NEXP = 32, DEXP = 512;
constexpr int HROWS_MAX = 2 * M + NEXP * 256;

constexpr size_t MiB = 1u << 20;
constexpr size_t WS_CTL = 0, CTL_ZERO_BYTES = 1 * MiB;
constexpr size_t WS_MODP = 1 * MiB;
constexpr size_t WS_MOD = WS_MODP + 512 * 1024;
constexpr size_t WS_PEB = WS_MOD + 64 * 1024;
constexpr size_t WS_W1T = WS_PEB + 64 * 1024;
constexpr size_t WS_KC = WS_W1T + 512 * 1024;
constexpr size_t WS_VC = WS_KC + 256 * 1024;
constexpr size_t WS_FB2 = WS_VC + 256 * 1024;
constexpr size_t WS_LF = WS_FB2 + 512 * 1024;
constexpr size_t WS_GATES = WS_LF + 512 * 1024;
constexpr size_t WS_ROUTE = WS_GATES + 1536 * 1024;
constexpr size_t WS_LIST = 6 * MiB;
constexpr size_t WS_WINT = 10 * MiB;
constexpr size_t WS_WOT = 20 * MiB;
constexpr size_t WS_WOUTT = 22 * MiB;
constexpr size_t WS_HN = 24 * MiB;
constexpr size_t WS_PROJ = 56 * MiB;
constexpr size_t WS_WGUT = WS_PROJ;
constexpr size_t WS_WDT = WS_PROJ + 64 * MiB;
constexpr size_t WS_HBUF = WS_PROJ + 96 * MiB;
constexpr size_t WS_YY = 208 * MiB;
constexpr size_t WS_END = 272 * MiB;
static_assert(WS_ROUTE + 64 * 1024 <= WS_LIST && WS_LIST + 4 * MiB <= WS_WINT && WS_HBUF + (size_t)HROWS_MAX * 1024 <= WS_YY, "d_ws map");
constexpr int CW_QCTR = 64;
constexpr int CW_ECNT = 128;
constexpr int CW_BAR = 4096;

constexpr int RING_BYTES = 131072;
constexpr int LDS_BYTES = 163840;
constexpr int MISC_OFF = 160 * 1024 - 1024;

#define RLX_AGENT __ATOMIC_RELAXED, __HIP_MEMORY_SCOPE_AGENT
#define LDS_WAIT() asm volatile("s_waitcnt lgkmcnt(0)" ::: "memory")
#define VM_WAIT() asm volatile("s_waitcnt vmcnt(0)" ::: "memory")

#define XB_TMO      128
#define XB_XCNT(j)  (256  + 64 * (j))
#define XB_XSUB(j)  (1280 + 64 * (j))
#define XB_XGEN(j)  (2304 + 64 * (j))
#define XB_TOP      3328
#define XB_TOPGEN   3392
#define XCD_BAR_WORDS 3456
#define XB_SPIN_CAP (1u << 22)
__device__ __forceinline__ unsigned xb_ld(unsigned* p)              { return __hip_atomic_load(p, __ATOMIC_RELAXED, __HIP_MEMORY_SCOPE_AGENT); }
__device__ __forceinline__ unsigned xb_add(unsigned* p, unsigned v) { return __hip_atomic_fetch_add(p, v, __ATOMIC_RELAXED, __HIP_MEMORY_SCOPE_AGENT); }
__device__ __forceinline__ unsigned xb_xcc_id() { return (unsigned)__builtin_amdgcn_s_getreg((3 << 11) | 20) & 0xFu; }
#define XB_SPIN(cond, bar) do { unsigned _sp = 0; while (cond) { __builtin_amdgcn_s_sleep(1); \
    if ((++_sp & 255u) == 0u) { if (xb_ld(&(bar)[XB_TMO])) break; if (_sp > XB_SPIN_CAP) { atomicAdd(&(bar)[XB_TMO], 1u); break; } } } } while (0)
struct XcdBarrier { unsigned* bar; unsigned x; volatile LAS unsigned* st; };
__device__ __forceinline__ XcdBarrier xcd_barrier_post(unsigned* bar, volatile LAS unsigned* st) {
    XcdBarrier b; b.bar = bar; b.x = xb_xcc_id(); b.st = st;
    if (threadIdx.x == 0) (void)xb_add(&bar[XB_XCNT(b.x)], 1u);
    return b;
}
__device__ __forceinline__ void xcd_barrier_complete(unsigned* bar, unsigned x, unsigned& nloc, unsigned& nx) {
    const unsigned G = gridDim.x * gridDim.y * gridDim.z;
    unsigned sum, cnt, mine, sp = 0u;
    for (;;) {
        sum = 0u; cnt = 0u; mine = 0u;
#pragma unroll
        for (unsigned j = 0; j < 16; ++j) { const unsigned c = xb_ld(&bar[XB_XCNT(j)]); sum += c; cnt += (c > 0u) ? 1u : 0u; mine = (j == x) ? c : mine; }
        if (sum == G) break;
        __builtin_amdgcn_s_sleep(1);
        if ((++sp & 255u) == 0u) { if (xb_ld(&bar[XB_TMO])) break; if (sp > XB_SPIN_CAP) { atomicAdd(&bar[XB_TMO], 1u); break; } }
    }
    nloc = mine > 0u ? mine : 1u; nx = cnt > 0u ? cnt : 1u;
}
__device__ __forceinline__ void xcd_barrier(const XcdBarrier& b) {
    asm volatile("s_waitcnt vmcnt(0)" ::: "memory");
    __syncthreads();
    if (threadIdx.x == 0) {
        unsigned* bar = b.bar;
        __builtin_amdgcn_s_waitcnt(0);
        unsigned nloc = b.st[0], nx = b.st[1];
        if (nloc == 0u) { xcd_barrier_complete(bar, b.x, nloc, nx); b.st[0] = nloc; b.st[1] = nx; }
        const unsigned old = xb_add(&bar[XB_XSUB(b.x)], 1u);
        const unsigned gen = old / nloc;
        if (old + 1u == (gen + 1u) * nloc) {
            __builtin_amdgcn_fence(__ATOMIC_RELEASE, "agent");
            asm volatile("s_waitcnt vmcnt(0)" ::: "memory");
            const unsigned og = xb_add(&bar[XB_TOP], 1u);
            const unsigned tg = og / nx;
            if (og + 1u == (tg + 1u) * nx) xb_add(&bar[XB_TOPGEN], 1u);
            else XB_SPIN(xb_ld(&bar[XB_TOPGEN]) == tg, bar);
            __builtin_amdgcn_fence(__ATOMIC_ACQUIRE, "agent");
            xb_add(&bar[XB_XGEN(b.x)], 1u);
            asm volatile("s_waitcnt vmcnt(0)" ::: "memory");
        } else {
            XB_SPIN(xb_ld(&bar[XB_XGEN(b.x)]) == gen, bar);
            __builtin_amdgcn_fence(__ATOMIC_ACQUIRE, "agent");
            asm volatile("s_waitcnt vmcnt(0)" ::: "memory");
        }
    }
    __syncthreads();
}

struct Frame {
    LAS unsigned char* lds;
    volatile LAS unsigned* MISC;
    unsigned* ctl;
    int wave, G;
    __device__ __forceinline__ int tid_() const { return (int)threadIdx.x; }
    __device__ __forceinline__ int lane_() const { return (int)(threadIdx.x & 63u); }
    const float *x, *c, *w_ada, *b_ada, *g_pre_mix, *g_post_mix, *g_pre_ffn, *g_post_ffn, *w_in, *b_forget;
    const float *pe_k, *w1_k, *w2_k, *pe_v, *w1_v, *w2_v, *w_o_nsa, *w_o_fox, *w_out, *w_rg, *b_rg, *w_re, *b_re, *w_eg, *w_eu, *w_ed;
    float* out;
    unsigned char* ws;
};

__device__ __forceinline__ float wave_sum(float v) {
#pragma unroll
    for (int o = 1; o < 64; o <<= 1) v += __shfl_xor(v, o);
    return v;
}

#define EPI_LOOP_BEGIN _Pragma("unroll") for (int ai = 0; ai < 2; ++ai) _Pragma("unroll") for (int m = 0; m < 4; ++m) { const int rin = ai * 128 + wr * 64 + m * 16 + fr; (void)rin;
#define EPI_LOOP_END }

struct EpiProj {
    bf16_t* P; float* gates; float* lf; const float* b_forget;
    __device__ __forceinline__ void operator()(const f32x4 (&acc)[2][2][4][2], const pg8::Unit& u, int wr, int wc, int fr, int fq) const {
        const int pn = u.pn;
        if (pn < 19) {
            const int mode = (pn < 2 || pn == 5 || pn == 6) ? 1 : (pn >= 11 ? 2 : 0);
            EPI_LOOP_BEGIN
                bf16_t* rowp = P + (size_t)(u.pm * 256 + rin) * PP + pn * 256 + wc * 32 + 8 * fq;
#pragma unroll
                for (int bj = 0; bj < 2; ++bj) { f32x4 v0 = acc[ai][bj][m][0], v1 = acc[ai][bj][m][1];
                    if (mode == 1) { v0 = v0 * C2; v1 = v1 * C2; }
                    else if (mode == 2) {
#pragma unroll
                        for (int i = 0; i < 4; ++i) { v0[i] = sigmoidf_(v0[i]); v1[i] = sigmoidf_(v1[i]); } }
                    u32x4 w; w.x = cvtpk(v0[0], v0[1]); w.y = cvtpk(v0[2], v0[3]); w.z = cvtpk(v1[0], v1[1]); w.w = cvtpk(v1[2], v1[3]);
                    *(u32x4*)(rowp + bj * 128) = w; }
            EPI_LOOP_END
        } else {
            if (wc == 0) {
                EPI_LOOP_BEGIN
                    const int row = u.pm * 256 + rin; const f32x4 v0 = acc[ai][0][m][0], v1 = acc[ai][0][m][1];
                    if (fq < 3) { f32x4 a, b;
#pragma unroll
                        for (int i = 0; i < 4; ++i) { a[i] = sigmoidf_(v0[i]); b[i] = sigmoidf_(v1[i]); }
                        *(f32x4*)(gates + (size_t)row * 24 + 8 * fq) = a; *(f32x4*)(gates + (size_t)row * 24 + 8 * fq + 4) = b; }
                    else { f32x4 a, b;
#pragma unroll
                        for (int i = 0; i < 4; ++i) { const float xa = v0[i] + b_forget[i], xb = v1[i] + b_forget[4 + i];
                            a[i] = fminf(xa, 0.f) - log1pf(__expf(-fabsf(xa))); b[i] = fminf(xb, 0.f) - log1pf(__expf(-fabsf(xb))); }
                        *(f32x4*)(lf + (size_t)row * 8) = a; *(f32x4*)(lf + (size_t)row * 8 + 4) = b; }
                EPI_LOOP_END
            }
        }
    }
};
struct MidGate {
    static constexpr bool ENABLED = true; const bf16_t* P;
    __device__ __forceinline__ void operator()(f32x4 (&acc)[2][2][4][2], const pg8::Unit& u, int wr, int wc, int fr, int fq) const {
        EPI_LOOP_BEGIN
            const bf16_t* gp = P + (size_t)(u.pm * 256 + rin) * PP + C_MG + u.pn * 256 + wc * 32 + 8 * fq;
#pragma unroll
            for (int bj = 0; bj < 2; ++bj) { const u32x4 ga = *(const u32x4*)(gp + bj * 128), gb = *(const u32x4*)(gp + 1024 + bj * 128);
                const f32x4 r0 = {bflo(ga.x) / bflo(gb.x), bfhi(ga.x) / bfhi(gb.x), bflo(ga.y) / bflo(gb.y), bfhi(ga.y) / bfhi(gb.y)};
                const f32x4 r1 = {bflo(ga.z) / bflo(gb.z), bfhi(ga.z) / bfhi(gb.z), bflo(ga.w) / bflo(gb.w), bfhi(ga.w) / bfhi(gb.w)};
                acc[ai][bj][m][0] *= r0; acc[ai][bj][m][1] *= r1; }
            asm volatile("" ::: "memory");
        EPI_LOOP_END
    }
};
struct EpiOut {
    bf16_t* U; const bf16_t* P;
    __device__ __forceinline__ void operator()(const f32x4 (&acc)[2][2][4][2], const pg8::Unit& u, int wr, int wc, int fr, int fq) const {
        EPI_LOOP_BEGIN
            const size_t row = (size_t)(u.pm * 256 + rin); const int col = u.pn * 256 + wc * 32 + 8 * fq;
#pragma unroll
            for (int bj = 0; bj < 2; ++bj) { const f32x4 v0 = acc[ai][bj][m][0], v1 = acc[ai][bj][m][1];
                const u32x4 gw = *(const u32x4*)(P + row * PP + C_MG + 1024 + col + bj * 128);
                u32x4 w; w.x = cvtpk(v0[0] * bflo(gw.x), v0[1] * bfhi(gw.x)); w.y = cvtpk(v0[2] * bflo(gw.y), v0[3] * bfhi(gw.y));
                w.z = cvtpk(v1[0] * bflo(gw.z), v1[1] * bfhi(gw.z)); w.w = cvtpk(v1[2] * bflo(gw.w), v1[3] * bfhi(gw.w));
                *(u32x4*)(U + row * DM + col + bj * 128) = w; }
            asm volatile("" ::: "memory");
        EPI_LOOP_END
    }
};
struct EpiBf {
    bf16_t* O; int ldc;
    __device__ __forceinline__ void operator()(const f32x4 (&acc)[2][2][4][2], const pg8::Unit& u, int wr, int wc, int fr, int fq) const {
        EPI_LOOP_BEGIN
            bf16_t* rowp = O + (size_t)(u.pm * 256 + rin) * ldc + u.pn * 256 + wc * 32 + 8 * fq;
#pragma unroll
            for (int bj = 0; bj < 2; ++bj) { const f32x4 v0 = acc[ai][bj][m][0], v1 = acc[ai][bj][m][1];
                u32x4 w; w.x = cvtpk(v0[0], v0[1]); w.y = cvtpk(v0[2], v0[3]); w.z = cvtpk(v1[0], v1[1]); w.w = cvtpk(v1[2], v1[3]);
                *(u32x4*)(rowp + bj * 128) = w; }
        EPI_LOOP_END
    }
};
struct EpiSwiglu {
    bf16_t* H;
    __device__ __forceinline__ void operator()(const f32x4 (&acc)[2][2][4][2], const pg8::Unit& u, int wr, int wc, int fr, int fq) const {
        EPI_LOOP_BEGIN
            bf16_t* hp = H + (size_t)(u.pm * 256 + rin) * DEXP + (u.pn & 3) * 128 + wc * 32 + 8 * fq;
            float r[8];
#pragma unroll
            for (int i = 0; i < 4; ++i) { const float g0 = acc[ai][0][m][0][i], g1 = acc[ai][0][m][1][i];
                r[i] = g0 * sigmoidf_(g0) * acc[ai][1][m][0][i]; r[4 + i] = g1 * sigmoidf_(g1) * acc[ai][1][m][1][i]; }
            u32x4 w; w.x = cvtpk(r[0], r[1]); w.y = cvtpk(r[2], r[3]); w.z = cvtpk(r[4], r[5]); w.w = cvtpk(r[6], r[7]);
            *(u32x4*)hp = w;
        EPI_LOOP_END
    }
};
struct EpiDown {
    bf16_t* Y2; const u32x2* list; volatile LAS unsigned* tstart; volatile LAS unsigned* ecnt;
    __device__ __forceinline__ void operator()(const f32x4 (&acc)[2][2][4][2], const pg8::Unit& u, int wr, int wc, int fr, int fq) const {
        const int e = u.pn >> 2, rt = u.pm - (int)tstart[e], cnt = (int)ecnt[e];
        EPI_LOOP_BEGIN
            const int rank = rt * 256 + rin;
            if (rank < cnt) { const u32x2 ent = list[(size_t)e * M + rank]; const float w = __uint_as_float(ent.y);
                bf16_t* yp = Y2 + (size_t)ent.x * DM + (u.pn & 3) * 256 + wc * 32 + 8 * fq;
#pragma unroll
                for (int bj = 0; bj < 2; ++bj) { const f32x4 v0 = acc[ai][bj][m][0] * w, v1 = acc[ai][bj][m][1] * w;
                    u32x4 o; o.x = cvtpk(v0[0], v0[1]); o.y = cvtpk(v0[2], v0[3]); o.z = cvtpk(v1[0], v1[1]); o.w = cvtpk(v1[2], v1[3]);
                    *(u32x4*)(yp + bj * 128) = o; } }
        EPI_LOOP_END
    }
};
struct MoeOrder {
    volatile LAS unsigned* tstart; int G, c;
    __device__ bool next(int i, pg8::Unit& u) const {
        const int L = i * G + c; const int NT = (int)tstart[32];
        if (L >= 4 * NT) return false;
        int e = 0;
        for (int k = 1; k < 32; ++k) if (L >= 4 * (int)tstart[k]) e = k;
        const int ts = (int)tstart[e], nte = (int)tstart[e + 1] - ts, rem = L - 4 * ts;
        const int j = rem / nte, rt = rem - j * nte;
        u.pm = ts + rt; u.pn = e * 4 + j; return true;
    }
};
struct MoeGather {
    const u32x2* list; volatile LAS unsigned* tstart; volatile LAS unsigned* ecnt;
    __device__ __forceinline__ int row(const pg8::Unit& u, int r) const {
        const int e = u.pn >> 2, rank = (u.pm - (int)tstart[e]) * 256 + r;
        if (rank >= (int)ecnt[e]) return 0;
        return (int)(list[(size_t)e * M + rank].x >> 1);
    }
};
constexpr int TR_SCR = 64 * 65 * 4;
template <class MapF>
__device__ __forceinline__ void tr_item(const float* __restrict__ W, int N, bf16_t* WT, int ldwt, MapF map, LAS float* scr, int kb, int nb, int lane) {
    const int k0 = 64 * kb, n0 = 64 * nb, c4 = 4 * (lane & 15);
    f32x4 v[16];
    const bool okc = (n0 + c4) < N;
#pragma unroll
    for (int i = 0; i < 16; ++i) { const int k = 4 * i + (lane >> 4); v[i] = okc ? *(const f32x4*)(W + (size_t)(k0 + k) * N + n0 + c4) : (f32x4){0.f, 0.f, 0.f, 0.f}; }
#pragma unroll
    for (int i = 0; i < 16; ++i) { const int k = 4 * i + (lane >> 4); LAS float* s = scr + k * 65 + c4; s[0] = v[i][0]; s[1] = v[i][1]; s[2] = v[i][2]; s[3] = v[i][3]; }
    LDS_WAIT(); asm volatile("" ::: "memory");
    const int c = lane & 7;
#pragma unroll
    for (int jj = 0; jj < 8; ++jj) { const int n = (lane >> 3) + 8 * jj; const LAS float* s = scr + (8 * c) * 65 + n;
        u32x4 o; o.x = cvtpk(s[0 * 65], s[1 * 65]); o.y = cvtpk(s[2 * 65], s[3 * 65]); o.z = cvtpk(s[4 * 65], s[5 * 65]); o.w = cvtpk(s[6 * 65], s[7 * 65]);
        if (n0 + n < N) *(u32x4*)(WT + (size_t)map(n0 + n) * ldwt + k0 + 8 * c) = o; }
    LDS_WAIT(); asm volatile("" ::: "memory");
}
struct MapId { int off; __device__ __forceinline__ int operator()(int n) const { return off + n; } };
struct MapWin { __device__ __forceinline__ int operator()(int n) const {
    if (n < 1280) return n; if (n < 1304) return 4864 + (n - 1280); if (n < 2840) return 1280 + (n - 1304); if (n < 2848) return 4888 + (n - 2840); return 2816 + (n - 2848); } };
struct MapGU { int e, up; __device__ __forceinline__ int operator()(int n) const { return (e * 4 + (n >> 7)) * 256 + (n & 127) + up * 128; } };

__device__ __forceinline__ void p0_prologue(Frame& F) {
    LAS float* scr = (LAS float*)(F.lds + F.wave * TR_SCR);
    LAS float* sil = (LAS float*)(F.lds + 8 * TR_SCR);
    for (int i = F.tid_(); i < 2048; i += NWAVES * 64) { const float cv = F.c[i]; sil[i] = cv / (1.f + __expf(-cv)); }
    __syncthreads();
    const int gw = blockIdx.x * NWAVES + F.wave, NGW = F.G * NWAVES, lane = F.lane_();
    float* MODP = (float*)(F.ws + WS_MODP); float* PEB = (float*)(F.ws + WS_PEB);
    bf16_t* W1T = (bf16_t*)(F.ws + WS_W1T); bf16_t* WINT = (bf16_t*)(F.ws + WS_WINT); bf16_t* WOT = (bf16_t*)(F.ws + WS_WOT); bf16_t* WOUTT = (bf16_t*)(F.ws + WS_WOUTT);
    constexpr int I_GEMV = 768, I_PEB = 64, I_W1T = 64, I_WIN = 16 * 77, I_WO = 128, I_WOUT = 256;
    constexpr int NITEMS = I_GEMV + I_PEB + I_W1T + I_WIN + 2 * I_WO + I_WOUT;
    for (int it = gw; it < NITEMS; it += NGW) {
        int r = it;
        if (r < I_GEMV) {
            const int cg = r % 96, kc = r / 96; const int col = cg * 64 + lane; float a0 = 0.f, a1 = 0.f;
            const float* wp = F.w_ada + (size_t)(kc * 128) * 6144 + col;
#pragma unroll 32
            for (int k = 0; k < 128; ++k) { const float w = wp[(size_t)k * 6144]; a0 += sil[kc * 128 + k] * w; a1 += sil[1024 + kc * 128 + k] * w; }
            MODP[(kc * 2 + 0) * 6144 + col] = a0; MODP[(kc * 2 + 1) * 6144 + col] = a1; continue; }
        r -= I_GEMV;
        if (r < I_PEB) {
            const int kind = r >> 5, ch = r & 31; const float* pe = kind ? F.pe_v : F.pe_k; const float* w1 = kind ? F.w1_v : F.w1_k; float a = 0.f;
#pragma unroll 16
            for (int k = 0; k < 64; ++k) a += pe[ch * 64 + k] * w1[(size_t)(ch * 64 + k) * 64 + lane];
            PEB[(kind * 32 + ch) * 64 + lane] = a; continue; }
        r -= I_PEB;
        if (r < I_W1T) { const int kind = r >> 5, kb = r & 31; tr_item(kind ? F.w1_v : F.w1_k, 64, W1T + (size_t)kind * 64 * 2048, 2048, MapId{0}, scr, kb, 0, lane); continue; }
        r -= I_W1T;
        if (r < I_WIN) { tr_item(F.w_in, DIN, WINT, 1024, MapWin{}, scr, r / 77, r % 77, lane); continue; }
        r -= I_WIN;
        if (r < I_WO) { tr_item(F.w_o_nsa, 1024, WOT, 1024, MapId{0}, scr, r >> 4, r & 15, lane); continue; }
        r -= I_WO;
        if (r < I_WO) { tr_item(F.w_o_fox, 1024, WOT + 512, 1024, MapId{0}, scr, r >> 4, r & 15, lane); continue; }
        r -= I_WO;
        tr_item(F.w_out, 1024, WOUTT, 1024, MapId{0}, scr, r >> 4, r & 15, lane);
    }
}
__device__ __forceinline__ void expert_convert(Frame& F) {
    LAS float* scr = (LAS float*)(F.lds + F.wave * TR_SCR);
    const int gw = blockIdx.x * NWAVES + F.wave, NGW = F.G * NWAVES, lane = F.lane_();
    bf16_t* WGUT = (bf16_t*)(F.ws + WS_WGUT); bf16_t* WDT = (bf16_t*)(F.ws + WS_WDT);
    for (int it = gw; it < 32 * 384; it += NGW) {
        const int e = it / 384, r = it % 384, mat = r >> 7, q = r & 127;
        if (mat == 0) tr_item(F.w_eg + (size_t)e * 1024 * 512, 512, WGUT, 1024, MapGU{e, 0}, scr, q >> 3, q & 7, lane);
        else if (mat == 1) tr_item(F.w_eu + (size_t)e * 1024 * 512, 512, WGUT, 1024, MapGU{e, 1}, scr, q >> 3, q & 7, lane);
        else tr_item(F.w_ed + (size_t)e * 512 * 1024, 1024, WDT, 512, MapId{e * 1024}, scr, q >> 4, q & 15, lane);
    }
}

__device__ __forceinline__ void mod_from_partials(Frame& F, int b, int ch, f32x4 (&o)[4]) {
    const float* MODP = (const float*)(F.ws + WS_MODP);
#pragma unroll
    for (int j = 0; j < 4; ++j) { const int col = ch * 1024 + 256 * j + 4 * F.lane_(); f32x4 a = *(const f32x4*)(F.b_ada + col);
#pragma unroll
        for (int kc = 0; kc < 8; ++kc) a += *(const f32x4*)(MODP + (size_t)(kc * 2 + b) * 6144 + col);
        o[j] = a; }
}
__device__ __forceinline__ void mod_final(Frame& F, int b, int ch, f32x4 (&o)[4]) {
    const float* MOD = (const float*)(F.ws + WS_MOD);
#pragma unroll
    for (int j = 0; j < 4; ++j) o[j] = *(const f32x4*)(MOD + (size_t)b * 6144 + ch * 1024 + 256 * j + 4 * F.lane_());
}
__device__ __forceinline__ void ld_row4(const float* p, int lane, f32x4 (&o)[4]) {
#pragma unroll
    for (int j = 0; j < 4; ++j) o[j] = *(const f32x4*)(p + 256 * j + 4 * lane);
}
__device__ __forceinline__ float sumsq4(const f32x4 (&v)[4]) { float s = 0.f;
#pragma unroll
    for (int j = 0; j < 4; ++j) s += (v[j][0] * v[j][0] + v[j][1] * v[j][1]) + (v[j][2] * v[j][2] + v[j][3] * v[j][3]);
    return s; }
__device__ __forceinline__ void st_row_bf16(bf16_t* p, int lane, const f32x4 (&v)[4]) {
#pragma unroll
    for (int j = 0; j < 4; ++j) { u32x2 w; w.x = cvtpk(v[j][0], v[j][1]); w.y = cvtpk(v[j][2], v[j][3]); *(u32x2*)(p + 256 * j + 4 * lane) = w; }
}

__device__ __forceinline__ void p0b_rows(Frame& F) {
    const int gw = blockIdx.x * NWAVES + F.wave, NGW = F.G * NWAVES, lane = F.lane_();
    {
        const float* MODP = (const float*)(F.ws + WS_MODP); float* MOD = (float*)(F.ws + WS_MOD);
        for (int j = gw * 64 + lane; j < 2 * 6144; j += NGW * 64) { const int b = j / 6144, col = j % 6144; float a = F.b_ada[col];
#pragma unroll
            for (int kc = 0; kc < 8; ++kc) a += MODP[(size_t)(kc * 2 + b) * 6144 + col];
            MOD[j] = a; }
    }
    bf16_t* HN = (bf16_t*)(F.ws + WS_HN);
    f32x4 g[4]; ld_row4(F.g_pre_mix, lane, g);
    int curb = -1; f32x4 mul[4], add[4];
    for (int m0 = gw; m0 < M; m0 += 4 * NGW) {
        const int b = m0 >> 13;
        if (b != curb) { f32x4 sc[4]; mod_from_partials(F, b, 0, add); mod_from_partials(F, b, 1, sc); curb = b;
#pragma unroll
            for (int j = 0; j < 4; ++j) mul[j] = g[j] * (sc[j] + 1.0f); }
        f32x4 v[4][4];
#pragma unroll
        for (int r = 0; r < 4; ++r) { const int m = m0 + r * NGW; if (m < M && (m >> 13) == b) ld_row4(F.x + (size_t)m * DM, lane, v[r]); }
#pragma unroll
        for (int r = 0; r < 4; ++r) { const int m = m0 + r * NGW;
            if (m < M && (m >> 13) == b) {
                const float rstd = 1.0f / sqrtf(wave_sum(sumsq4(v[r])) * (1.0f / DM) + NORM_EPS);
#pragma unroll
                for (int j = 0; j < 4; ++j) v[r][j] = v[r][j] * rstd * mul[j] + add[j];
                st_row_bf16(HN + (size_t)m * DM, lane, v[r]); } }
        for (int r = 1; r < 4; ++r) { const int m = m0 + r * NGW;
            if (m < M && (m >> 13) != b) { f32x4 sc[4], a2[4], m2[4], vv[4]; mod_from_partials(F, m >> 13, 0, a2); mod_from_partials(F, m >> 13, 1, sc);
#pragma unroll
                for (int j = 0; j < 4; ++j) m2[j] = g[j] * (sc[j] + 1.0f);
                ld_row4(F.x + (size_t)m * DM, lane, vv);
                const float rstd = 1.0f / sqrtf(wave_sum(sumsq4(vv)) * (1.0f / DM) + NORM_EPS);
#pragma unroll
                for (int j = 0; j < 4; ++j) vv[j] = vv[j] * rstd * m2[j] + a2[j];
                st_row_bf16(HN + (size_t)m * DM, lane, vv); } }
    }
}

__device__ __forceinline__ float gelu_tanh(float x) { const float u = 0.7978845608028654f * (x + 0.044715f * x * x * x); const float t = 1.0f - 2.0f / (1.0f + __expf(2.0f * u)); return 0.5f * x * (1.0f + t); }
__device__ __forceinline__ void p2a_item_cmp(Frame& F, int item) {
    const int kind = item >> 6, bg = (item >> 4) & 3, nt = item & 15, b = bg >> 1, g = bg & 1, n0 = 32 * nt;
    const int lane = F.lane_(), r32 = lane & 31, hi = lane >> 5, w = F.wave, tid = F.tid_();
    const bf16_t* PROJ = (const bf16_t*)(F.ws + WS_PROJ); const bf16_t* W1T = (const bf16_t*)(F.ws + WS_W1T) + (size_t)kind * 64 * 2048;
    const int col = (kind ? C_VCMP : C_KCMP) + g * 64;
    int n = n0 + r32; if (n > 510) n = 510;
    const bf16_t* ap = PROJ + (size_t)(b * SEQ + 16 * n) * PP + col + 8 * hi;
    const bf16_t* bp0 = W1T + (size_t)r32 * 2048 + 256 * w + 8 * hi; const bf16_t* bp1 = bp0 + (size_t)32 * 2048;
    f32x16 acc0 = {}, acc1 = {};
#pragma unroll 8
    for (int ks = 0; ks < 16; ++ks) { const int l = 4 * w + (ks >> 2), d = (ks & 3) * 16;
        const bf16x8 a = *(const bf16x8*)(ap + (size_t)l * PP + d);
        const bf16x8 b0 = *(const bf16x8*)(bp0 + 16 * ks), b1 = *(const bf16x8*)(bp1 + 16 * ks);
        acc0 = __builtin_amdgcn_mfma_f32_32x32x16_bf16(a, b0, acc0, 0, 0, 0); acc1 = __builtin_amdgcn_mfma_f32_32x32x16_bf16(a, b1, acc1, 0, 0, 0); }
    LAS float* RED = (LAS float*)F.lds;
    LAS float* BIAS = (LAS float*)(F.lds + 65536);
    LAS float* HID = (LAS float*)(F.lds + 65536 + 256);
#pragma unroll
    for (int r = 0; r < 16; ++r) { const int nl = (r & 3) + 8 * (r >> 2) + 4 * hi; RED[(w * 32 + nl) * 64 + r32] = acc0[r]; RED[(w * 32 + nl) * 64 + 32 + r32] = acc1[r]; }
    if (tid < 64) { const float* PEB = (const float*)(F.ws + WS_PEB) + kind * 32 * 64; float a = 0.f;
        for (int ch = 0; ch < 32; ++ch) a += PEB[ch * 64 + tid];
        BIAS[tid] = a; }
    __syncthreads();
    { const int idx = tid * 4, nl = idx >> 6, e = idx & 63; f32x4 s = *(const LAS f32x4*)(BIAS + e);
#pragma unroll
      for (int ww = 0; ww < 8; ++ww) s += *(const LAS f32x4*)(RED + (ww * 32 + nl) * 64 + e);
      f32x4 h; for (int i = 0; i < 4; ++i) h[i] = gelu_tanh(s[i]);
      *(LAS f32x4*)(HID + nl * 64 + e) = h; }
    __syncthreads();
    { const int nl = tid >> 4, e2 = (tid & 15) * 4; const float* w2 = kind ? F.w2_v : F.w2_k; f32x4 o = {0.f, 0.f, 0.f, 0.f};
#pragma unroll 8
      for (int e = 0; e < 64; ++e) { const float hv = HID[nl * 64 + e]; o += *(const f32x4*)(w2 + e * 64 + e2) * hv; }
      bf16_t* KC = (bf16_t*)(F.ws + (kind ? WS_VC : WS_KC));
      u32x2 pk; pk.x = cvtpk(o[0], o[1]); pk.y = cvtpk(o[2], o[3]);
      *(u32x2*)(KC + (size_t)(bg * 512 + n0 + nl) * 64 + e2) = pk; }
    __syncthreads();
}
__device__ __forceinline__ void p2a_item_cumsum(Frame& F, int bh) {
    const int b = bh >> 3, h = bh & 7, tid = F.tid_(), lane = F.lane_(), w = F.wave;
    const float* LF = (const float*)(F.ws + WS_LF); float* FB2 = (float*)(F.ws + WS_FB2);
    LAS float* WT = (LAS float*)F.lds;
    float v[16]; float s = 0.f;
#pragma unroll
    for (int i = 0; i < 16; ++i) { s += LF[(size_t)(b * SEQ + tid * 16 + i) * 8 + h]; v[i] = s; }
    float inc = s;
#pragma unroll
    for (int o = 1; o < 64; o <<= 1) { const float t = __shfl_up(inc, o); if (lane >= o) inc += t; }
    if (lane == 63) WT[w] = inc;
    __syncthreads();
    float base = inc - s;
    for (int ww = 0; ww < w; ++ww) base += WT[ww];
#pragma unroll
    for (int i = 0; i < 16; ++i) FB2[(size_t)bh * SEQ + tid * 16 + i] = -(base + v[i]) * LOG2E;
    __syncthreads();
}
namespace att {
__device__ __forceinline__ int crow(int r, int hi) { return (r & 3) + 8 * (r >> 2) + 4 * hi; }
constexpr int KVBUF = 16384;
__device__ __forceinline__ void issue_kv(LAS unsigned char* buf, const bf16_t* kp, const bf16_t* vp, int wid) {
    __builtin_amdgcn_global_load_lds((const unsigned*)kp, (LAS unsigned*)(buf + wid * 1024), 16, 0, 0);
    __builtin_amdgcn_global_load_lds((const unsigned*)vp, (LAS unsigned*)(buf + 8192 + wid * 1024), 16, 0, 0);
}
template <int PITCH> __device__ __forceinline__ const bf16_t* kptr(const bf16_t* base, int row0, int kc, int wid, int lane) { return base + (size_t)(row0 + lane) * PITCH + kc + wid * 8; }
template <int PITCH> __device__ __forceinline__ const bf16_t* vptr(const bf16_t* base, int row0, int vc, int wid, int lane) { return base + (size_t)(row0 + 16 * (wid & 3) + (lane >> 2)) * PITCH + vc + (wid >> 2) * 32 + (lane & 3) * 8; }

__device__ __forceinline__ void qkt(f32x16& p0, f32x16& p1, const LAS unsigned char* Ks, const bf16x8 (&qr)[4], int r32, int hi) {
    const LAS unsigned char* kb = Ks + hi * 1024 + r32 * 16;
#pragma unroll
    for (int d0 = 0; d0 < 4; ++d0) {
        const bf16x8 b0 = *(const LAS bf16x8*)(kb + d0 * 2048);
        const bf16x8 b1 = *(const LAS bf16x8*)(kb + d0 * 2048 + 512);
        p0 = __builtin_amdgcn_mfma_f32_32x32x16_bf16(b0, qr[d0], p0, 0, 0, 0);
        p1 = __builtin_amdgcn_mfma_f32_32x32x16_bf16(b1, qr[d0], p1, 0, 0, 0);
    }
}
typedef short v4i16_t __attribute__((ext_vector_type(4)));
__device__ __forceinline__ s16x4 vtr(const LAS unsigned char* p) { return __builtin_bit_cast(s16x4, __builtin_amdgcn_ds_read_tr16_b64_v4i16((LAS v4i16_t*)p)); }
__device__ __forceinline__ float half_swap_max(float v) { auto rr = __builtin_amdgcn_permlane32_swap(__float_as_uint(v), __float_as_uint(v), false, false); return fmaxf(__uint_as_float(rr[0]), __uint_as_float(rr[1])); }
__device__ __forceinline__ float half_swap_sum(float v) { auto rr = __builtin_amdgcn_permlane32_swap(__float_as_uint(v), __float_as_uint(v), false, false); return __uint_as_float(rr[0]) + __uint_as_float(rr[1]); }
__device__ __forceinline__ float rowmax32(const f32x16& p0, const f32x16& p1) {
    float a = fmaxf(p0[0], p1[0]);
#pragma unroll
    for (int r = 1; r < 16; ++r) a = fmaxf(a, fmaxf(p0[r], p1[r]));
    return half_swap_max(a);
}
__device__ __forceinline__ void pv(f32x16& o0, f32x16& o1, const LAS unsigned char* buf, const f32x16& p0, const f32x16& p1, int lane) {
    const int hi = lane >> 5;
    const LAS unsigned char* vb = buf + 8192 + ((lane >> 4) & 1) * 32 + (lane & 3) * 8 + (4 * hi + ((lane & 15) >> 2)) * 64;
    u32x4 w0 = {cvtpk(p0[0], p0[1]), cvtpk(p0[2], p0[3]), cvtpk(p0[4], p0[5]), cvtpk(p0[6], p0[7])};
    u32x4 w1 = {cvtpk(p0[8], p0[9]), cvtpk(p0[10], p0[11]), cvtpk(p0[12], p0[13]), cvtpk(p0[14], p0[15])};
    u32x4 w2 = {cvtpk(p1[0], p1[1]), cvtpk(p1[2], p1[3]), cvtpk(p1[4], p1[5]), cvtpk(p1[6], p1[7])};
    u32x4 w3 = {cvtpk(p1[8], p1[9]), cvtpk(p1[10], p1[11]), cvtpk(p1[12], p1[13]), cvtpk(p1[14], p1[15])};
    const bf16x8 pa[4] = {__builtin_bit_cast(bf16x8, w0), __builtin_bit_cast(bf16x8, w1), __builtin_bit_cast(bf16x8, w2), __builtin_bit_cast(bf16x8, w3)};
#pragma unroll
    for (int ks = 0; ks < 4; ++ks) {
        const s16x4 l0 = vtr(vb + ks * 1024), h0 = vtr(vb + ks * 1024 + 512);
        const s16x4 l1 = vtr(vb + 4096 + ks * 1024), h1 = vtr(vb + 4096 + ks * 1024 + 512);
        const bf16x8 v0 = {l0[0], l0[1], l0[2], l0[3], h0[0], h0[1], h0[2], h0[3]};
        const bf16x8 v1 = {l1[0], l1[1], l1[2], l1[3], h1[0], h1[1], h1[2], h1[3]};
        o0 = __builtin_amdgcn_mfma_f32_32x32x16_bf16(v0, pa[ks], o0, 0, 0, 0);
        o1 = __builtin_amdgcn_mfma_f32_32x32x16_bf16(v1, pa[ks], o1, 0, 0, 0);
    }
}
template <bool EMASK>
__device__ __forceinline__ void tile_step(const LAS unsigned char* buf, const bf16x8 (&qr)[4], f32x16 p0, f32x16 p1, int lo, int hb,
                                          f32x16& o0, f32x16& o1, float& m, float& l, int lane) {
    const int r32 = lane & 31, hi = lane >> 5;
    qkt(p0, p1, buf, qr, r32, hi);
    if (EMASK) {
#pragma unroll
        for (int r = 0; r < 16; ++r) { const int kl = crow(r, hi); if (kl < lo || kl > hb) p0[r] = NEGF; if (kl + 32 < lo || kl + 32 > hb) p1[r] = NEGF; }
    }
    const float rm = rowmax32(p0, p1);
    const float mn = fmaxf(m, rm);
    const float al = __builtin_amdgcn_exp2f(m - mn);
    m = mn; l *= al;
#pragma unroll
    for (int r = 0; r < 16; ++r) { o0[r] *= al; o1[r] *= al; }
    float s = 0.f;
#pragma unroll
    for (int r = 0; r < 16; ++r) { p0[r] = __builtin_amdgcn_exp2f(p0[r] - mn); p1[r] = __builtin_amdgcn_exp2f(p1[r] - mn); s += p0[r] + p1[r]; }
    l += s;
    pv(o0, o1, buf, p0, p1, lane);
}
__device__ __forceinline__ void store_cols(bf16_t* dst, const f32x16& y0, const f32x16& y1, int hi) {
#pragma unroll
    for (int q = 0; q < 4; ++q) {
        u32x2 a; a.x = cvtpk(y0[4 * q], y0[4 * q + 1]); a.y = cvtpk(y0[4 * q + 2], y0[4 * q + 3]);
        u32x2 b; b.x = cvtpk(y1[4 * q], y1[4 * q + 1]); b.y = cvtpk(y1[4 * q + 2], y1[4 * q + 3]);
        *(u32x2*)(dst + 8 * q + 4 * hi) = a; *(u32x2*)(dst + 32 + 8 * q + 4 * hi) = b;
    }
}

__device__ __forceinline__ int next_below(unsigned u0, unsigned u1, unsigned u2, unsigned u3, int from) {
    if (from > 96) { const unsigned v = (from < 128) ? (u3 & ((1u << (from - 96)) - 1u)) : u3; if (v) return 96 + 31 - __builtin_clz(v); }
    if (from > 64) { const unsigned v = (from < 96) ? (u2 & ((1u << (from - 64)) - 1u)) : u2; if (v) return 64 + 31 - __builtin_clz(v); }
    if (from > 32) { const unsigned v = (from < 64) ? (u1 & ((1u << (from - 32)) - 1u)) : u1; if (v) return 32 + 31 - __builtin_clz(v); }
    if (from > 0) { const unsigned v = (from < 32) ? (u0 & ((1u << from) - 1u)) : u0; if (v) return 31 - __builtin_clz(v); }
    return -1;
}
__device__ __forceinline__ void fox_unit(Frame& F, int b, int h, int qb) {
    int lane = F.lane_(); asm volatile("" : "+v"(lane));
    const int wid = F.wave, r32 = lane & 31, hi = lane >> 5;
    const bf16_t* PROJ = (const bf16_t*)(F.ws + WS_PROJ) + (size_t)b * SEQ * PP;
    const float* FB2 = (const float*)(F.ws + WS_FB2) + (size_t)(b * 8 + h) * SEQ;
    bf16_t* YB = (bf16_t*)(F.ws + WS_YY) + 512 + (size_t)b * SEQ * 1024;
    LAS unsigned char* kv = F.lds;
    const int t0 = 256 * qb, tw0 = t0 + 32 * wid, t = tw0 + r32;
    const int kcol = C_FK + h * 64, vcol = C_FV + h * 64;
    bf16x8 qr[4];
#pragma unroll
    for (int d0 = 0; d0 < 4; ++d0) qr[d0] = *(const bf16x8*)(PROJ + (size_t)t * PP + C_FQ + h * 64 + d0 * 16 + hi * 8);
    f32x16 o0 = {}, o1 = {}; float m = NEGF, l = 0.f;
    const int NT = 4 * (qb + 1);
    __syncthreads();
    issue_kv(kv + ((NT - 1) & 1) * KVBUF, kptr<PP>(PROJ, (NT - 1) * 64, kcol, wid, lane), vptr<PP>(PROJ, (NT - 1) * 64, vcol, wid, lane), wid);
    for (int j = NT - 1; j >= 0; --j) {
        f32x16 c0, c1;
        const bool active = (64 * j <= tw0 + 31);
        if (active) {
            const float* fb = FB2 + 64 * j + 4 * hi;
#pragma unroll
            for (int q = 0; q < 4; ++q) { const f32x4 a = *(const f32x4*)(fb + 8 * q), bb = *(const f32x4*)(fb + 32 + 8 * q);
                c0[4 * q] = a[0]; c0[4 * q + 1] = a[1]; c0[4 * q + 2] = a[2]; c0[4 * q + 3] = a[3];
                c1[4 * q] = bb[0]; c1[4 * q + 1] = bb[1]; c1[4 * q + 2] = bb[2]; c1[4 * q + 3] = bb[3]; }
        }
        VM_WAIT(); __syncthreads();
        if (j > 0) issue_kv(kv + ((j - 1) & 1) * KVBUF, kptr<PP>(PROJ, (j - 1) * 64, kcol, wid, lane), vptr<PP>(PROJ, (j - 1) * 64, vcol, wid, lane), wid);
        if (active) {
            const LAS unsigned char* buf = kv + (j & 1) * KVBUF;
            if (64 * j + 63 > tw0) tile_step<true>(buf, qr, c0, c1, 0, t - 64 * j, o0, o1, m, l, lane);
            else tile_step<false>(buf, qr, c0, c1, 0, 63, o0, o1, m, l, lane);
        }
    }
    const float inv = 1.0f / half_swap_sum(l);
#pragma unroll
    for (int r = 0; r < 16; ++r) { o0[r] *= inv; o1[r] *= inv; }
    store_cols(YB + (size_t)t * 1024 + h * 64, o0, o1, hi);
}

constexpr int IMP_OFF = 2 * KVBUF;
constexpr int SELM_OFF = IMP_OFF + 64 * 128 * 4;
constexpr int YSV_OFF = SELM_OFF + 1024;
__device__ __forceinline__ void nsa_unit(Frame& F, int b, int g, int cur) {
    int lane = F.lane_(); asm volatile("" : "+v"(lane));
    const int wid = F.wave, r32 = lane & 31, hi = lane >> 5;
    const bf16_t* PROJ = (const bf16_t*)(F.ws + WS_PROJ) + (size_t)b * SEQ * PP;
    const float* GATES = (const float*)(F.ws + WS_GATES) + (size_t)b * SEQ * 24;
    bf16_t* YA = (bf16_t*)(F.ws + WS_YY) + (size_t)b * SEQ * 1024;
    LAS unsigned char* kv = F.lds;
    LAS float* IMP = (LAS float*)(F.lds + IMP_OFF);
    LAS unsigned* SELM = (LAS unsigned*)(F.lds + SELM_OFF);
    const int t0 = 64 * cur, ql = 8 * wid + (r32 >> 2), hl = r32 & 3, head = 4 * g + hl, t = t0 + ql;
    const float a = __builtin_amdgcn_exp2f(-(float)(head + 1)) * LOG2E;
    bf16x8 qr[4];
#pragma unroll
    for (int d0 = 0; d0 < 4; ++d0) qr[d0] = *(const bf16x8*)(PROJ + (size_t)t * PP + C_QA + head * 64 + d0 * 16 + hi * 8);
    const float* gp = GATES + (size_t)t * 24 + head * 3;
    LAS float* YSV = (LAS float*)(F.lds + YSV_OFF) + (wid * 64 + lane);
    float kc_r[16];
#pragma unroll
    for (int r = 0; r < 16; ++r) kc_r[r] = (float)((r & 3) + 8 * (r >> 2));
    {
        const bf16_t* KC = (const bf16_t*)(F.ws + WS_KC) + (size_t)(b * 2 + g) * 512 * 64;
        const bf16_t* VC = (const bf16_t*)(F.ws + WS_VC) + (size_t)(b * 2 + g) * 512 * 64;
        const int nmaxU = (t0 + 32) >> 4, ntile = (nmaxU >> 6) + 1;
        const int nmax_l = (t - 31) >> 4;
        const float a16 = a * 16.0f;
#pragma unroll
        for (int i = 0; i < 16; ++i) IMP[(8 * wid) * 128 + i * 64 + lane] = 0.f;
        float m = NEGF, l = 0.f;
        __syncthreads();
        issue_kv(kv, kptr<64>(KC, 0, 0, wid, lane), vptr<64>(VC, 0, 0, wid, lane), wid);
        for (int jt = 0; jt < ntile; ++jt) {
            VM_WAIT(); __syncthreads();
            if (jt + 1 < ntile) issue_kv(kv + ((jt + 1) & 1) * KVBUF, kptr<64>(KC, (jt + 1) * 64, 0, wid, lane), vptr<64>(VC, (jt + 1) * 64, 0, wid, lane), wid);
            const float base = a16 * (float)(64 * jt + 4 * hi);
            f32x16 p0, p1;
#pragma unroll
            for (int r = 0; r < 16; ++r) { p0[r] = fmaf(a16, kc_r[r], base); p1[r] = p0[r] + a16 * 32.0f; }
            qkt(p0, p1, kv + (jt & 1) * KVBUF, qr, r32, hi);
            const int lim = nmax_l - 64 * jt;
#pragma unroll
            for (int r = 0; r < 16; ++r) { const int kl = crow(r, hi); if (kl > lim) p0[r] = NEGF; if (kl + 32 > lim) p1[r] = NEGF; }
            const float rm = rowmax32(p0, p1), mn = fmaxf(m, rm);
            float s = 0.f;
#pragma unroll
            for (int r = 0; r < 16; ++r) { const int kl = crow(r, hi);
                s += (kl <= lim) ? __builtin_amdgcn_exp2f(p0[r] - mn) : 0.f; s += (kl + 32 <= lim) ? __builtin_amdgcn_exp2f(p1[r] - mn) : 0.f; }
            l = l * __builtin_amdgcn_exp2f(m - mn) + s; m = mn;
        }
        const float lt = half_swap_sum(l);
        const float inv = lt > 0.f ? 1.0f / lt : 0.f;
        f32x16 o0 = {}, o1 = {};
        __syncthreads();
        issue_kv(kv, kptr<64>(KC, 0, 0, wid, lane), vptr<64>(VC, 0, 0, wid, lane), wid);
        for (int jt = 0; jt < ntile; ++jt) {
            VM_WAIT(); __syncthreads();
            if (jt + 1 < ntile) issue_kv(kv + ((jt + 1) & 1) * KVBUF, kptr<64>(KC, (jt + 1) * 64, 0, wid, lane), vptr<64>(VC, (jt + 1) * 64, 0, wid, lane), wid);
            const float base = a16 * (float)(64 * jt + 4 * hi);
            f32x16 p0, p1;
#pragma unroll
            for (int r = 0; r < 16; ++r) { p0[r] = fmaf(a16, kc_r[r], base); p1[r] = p0[r] + a16 * 32.0f; }
            qkt(p0, p1, kv + (jt & 1) * KVBUF, qr, r32, hi);
            const int lim = nmax_l - 64 * jt;
#pragma unroll
            for (int r = 0; r < 16; ++r) { const int kl = crow(r, hi);
                p0[r] = (kl <= lim) ? __builtin_amdgcn_exp2f(p0[r] - m) * inv : 0.f; p1[r] = (kl + 32 <= lim) ? __builtin_amdgcn_exp2f(p1[r] - m) * inv : 0.f; }
#pragma unroll
            for (int r2 = 0; r2 < 4; ++r2) {
                float A0 = (p0[4 * r2] + p0[4 * r2 + 1]) + (p0[4 * r2 + 2] + p0[4 * r2 + 3]), L0 = p0[4 * r2 + 3];
                float A1 = (p1[4 * r2] + p1[4 * r2 + 1]) + (p1[4 * r2 + 2] + p1[4 * r2 + 3]), L1 = p1[4 * r2 + 3];
                A0 += __shfl_xor(A0, 1); A0 += __shfl_xor(A0, 2); L0 += __shfl_xor(L0, 1); L0 += __shfl_xor(L0, 2);
                A1 += __shfl_xor(A1, 1); A1 += __shfl_xor(A1, 2); L1 += __shfl_xor(L1, 1); L1 += __shfl_xor(L1, 2);
                if (hl == 0) {
                    const int j0 = 16 * jt + 2 * r2 + hi, j1 = j0 + 8;
                    LAS float* ip = IMP + ql * 128;
                    __hip_atomic_fetch_add(ip + j0, A0, __ATOMIC_RELAXED, __HIP_MEMORY_SCOPE_WORKGROUP);
                    __hip_atomic_fetch_add(ip + j0 + 1, L0, __ATOMIC_RELAXED, __HIP_MEMORY_SCOPE_WORKGROUP);
                    __hip_atomic_fetch_add(ip + j1, A1, __ATOMIC_RELAXED, __HIP_MEMORY_SCOPE_WORKGROUP);
                    if (j1 + 1 < 128) __hip_atomic_fetch_add(ip + j1 + 1, L1, __ATOMIC_RELAXED, __HIP_MEMORY_SCOPE_WORKGROUP);
                }
            }
            pv(o0, o1, kv + (jt & 1) * KVBUF, p0, p1, lane);
        }
        const float g0 = gp[0];
#pragma unroll
        for (int r = 0; r < 16; ++r) { YSV[r * 512] = g0 * o0[r]; YSV[(16 + r) * 512] = g0 * o1[r]; }
        LDS_WAIT();
        for (int qi = 0; qi < 8; ++qi) {
            const int q = 8 * wid + qi;
            const unsigned k0 = __float_as_uint(IMP[q * 128 + lane]), k1 = __float_as_uint(IMP[q * 128 + 64 + lane]);
            const bool c0 = (lane >= 1) && (lane <= cur - 2), c1 = (64 + lane <= cur - 2);
            unsigned long long s0, s1;
            if (cur - 2 <= 13) { s0 = __ballot(c0); s1 = __ballot(c1); }
            else {
                unsigned T = 0u;
                for (int bit = 30; bit >= 0; --bit) { const unsigned cand = T | (1u << bit);
                    const int cnt = __popcll(__ballot(c0 && k0 >= cand)) + __popcll(__ballot(c1 && k1 >= cand));
                    if (cnt >= 13) T = cand; }
                s0 = __ballot(c0 && k0 > T); s1 = __ballot(c1 && k1 > T);
                int need = 13 - __popcll(s0) - __popcll(s1);
                unsigned long long e0 = __ballot(c0 && k0 == T), e1 = __ballot(c1 && k1 == T);
                while (need > 0) { if (e0) { const unsigned long long bb = e0 & (0ull - e0); s0 |= bb; e0 ^= bb; } else if (e1) { const unsigned long long bb = e1 & (0ull - e1); s1 |= bb; e1 ^= bb; } else break; --need; }
            }
            s0 |= 1ull;
            if (cur < 64) s0 |= 1ull << cur; else s1 |= 1ull << (cur - 64);
            if (cur >= 1) { if (cur - 1 < 64) s0 |= 1ull << (cur - 1); else s1 |= 1ull << (cur - 65); }
            if (lane == 0) { SELM[q * 4 + 0] = (unsigned)s0; SELM[q * 4 + 1] = (unsigned)(s0 >> 32); SELM[q * 4 + 2] = (unsigned)s1; SELM[q * 4 + 3] = (unsigned)(s1 >> 32); }
        }
    }
    LDS_WAIT(); __syncthreads();
    unsigned um[4], mym[4];
#pragma unroll
    for (int w = 0; w < 4; ++w) { unsigned v = SELM[lane * 4 + w];
#pragma unroll
        for (int o = 1; o < 64; o <<= 1) v |= (unsigned)__shfl_xor((int)v, o);
        um[w] = (unsigned)__builtin_amdgcn_readfirstlane((int)v); mym[w] = SELM[ql * 4 + w]; }
    const float a64 = a * 64.0f;
    const bf16_t* PK = PROJ;
    {
        f32x16 o0 = {}, o1 = {}; float m = NEGF, l = 0.f;
        int j = cur, jn = next_below(um[0], um[1], um[2], um[3], cur), par = 0;
        __syncthreads();
        issue_kv(kv, kptr<PP>(PK, 64 * j, C_KSLC + g * 64, wid, lane), vptr<PP>(PK, 64 * j, C_VSLC + g * 64, wid, lane), wid);
        while (j >= 0) {
            VM_WAIT(); __syncthreads();
            if (jn >= 0) issue_kv(kv + (par ^ 1) * KVBUF, kptr<PP>(PK, 64 * jn, C_KSLC + g * 64, wid, lane), vptr<PP>(PK, 64 * jn, C_VSLC + g * 64, wid, lane), wid);
            const unsigned mw = (j < 32) ? mym[0] : (j < 64) ? mym[1] : (j < 96) ? mym[2] : mym[3];
            const bool mine = (mw >> (j & 31)) & 1u;
            const float base = mine ? (a64 * (float)(j - cur) + a * (float)(4 * hi)) : NEGF;
            f32x16 p0, p1;
#pragma unroll
            for (int r = 0; r < 16; ++r) { p0[r] = fmaf(a, kc_r[r], base); p1[r] = p0[r] + a * 32.0f; }
            if (j == cur) tile_step<true>(kv + par * KVBUF, qr, p0, p1, 0, ql, o0, o1, m, l, lane);
            else tile_step<false>(kv + par * KVBUF, qr, p0, p1, 0, 63, o0, o1, m, l, lane);
            j = jn; if (jn >= 0) jn = next_below(um[0], um[1], um[2], um[3], jn); par ^= 1;
        }
        const float sc = gp[1] / half_swap_sum(l);
#pragma unroll
        for (int r = 0; r < 16; ++r) { YSV[r * 512] += sc * o0[r]; YSV[(16 + r) * 512] += sc * o1[r]; }
    }
    {
        f32x16 o0 = {}, o1 = {}; float m = NEGF, l = 0.f;
        const int jlo = cur >= 8 ? cur - 8 : 0;
        __syncthreads();
        issue_kv(kv + (cur & 1) * KVBUF, kptr<PP>(PK, 64 * cur, C_KWIN + g * 64, wid, lane), vptr<PP>(PK, 64 * cur, C_VWIN + g * 64, wid, lane), wid);
        for (int j = cur; j >= jlo; --j) {
            VM_WAIT(); __syncthreads();
            if (j > jlo) issue_kv(kv + ((j - 1) & 1) * KVBUF, kptr<PP>(PK, 64 * (j - 1), C_KWIN + g * 64, wid, lane), vptr<PP>(PK, 64 * (j - 1), C_VWIN + g * 64, wid, lane), wid);
            const float base = a64 * (float)(j - cur) + a * (float)(4 * hi);
            f32x16 p0, p1;
#pragma unroll
            for (int r = 0; r < 16; ++r) { p0[r] = fmaf(a, kc_r[r], base); p1[r] = p0[r] + a * 32.0f; }
            const LAS unsigned char* buf = kv + (j & 1) * KVBUF;
            if (j == cur) tile_step<true>(buf, qr, p0, p1, 0, ql, o0, o1, m, l, lane);
            else if (j == cur - 8) tile_step<true>(buf, qr, p0, p1, ql + 1, 63, o0, o1, m, l, lane);
            else tile_step<false>(buf, qr, p0, p1, 0, 63, o0, o1, m, l, lane);
        }
        const float sc = gp[2] / half_swap_sum(l);
#pragma unroll
        for (int r = 0; r < 16; ++r) { o0[r] = YSV[r * 512] + sc * o0[r]; o1[r] = YSV[(16 + r) * 512] + sc * o1[r]; }
        store_cols(YA + (size_t)t * 1024 + head * 64, o0, o1, hi);
    }
}
}
namespace foxb {
using bf16 = __hip_bfloat16;
constexpr int D = 64, NW = 8, QBLK = 32, QB = QBLK * NW, KVBLK = 64;
constexpr int PQ = PP;
constexpr int PO = 1024;
__device__ __forceinline__ int crow(int r, int hi) { return (r & 3) + 8 * (r >> 2) + 4 * hi; }
#define SBAR() __builtin_amdgcn_sched_barrier(0)
__device__ __forceinline__ void cmask(f32x16& p0, f32x16& p1, int jb, int qrel, int hi) {
  const float NEG = -INFINITY; int kb = 64 * jb + 4 * hi;
#pragma unroll
  for (int r = 0; r < 16; ++r) { int kv = kb + (r & 3) + 8 * (r >> 2); if (kv > qrel) p0[r] = NEG; if (kv + 32 > qrel) p1[r] = NEG; }
}
constexpr int NSLOT = 3, SLOTB = 8192;
constexpr int LDS_K = 0, LDS_V = NSLOT * SLOTB, LDS_WS = 2 * NSLOT * SLOTB, LDS_OST = LDS_WS + NW * 64 * 4, LDS_BS = LDS_OST + NW * 4096, LDS_BYTES_FOX = LDS_BS + 4 * 256;
__device__ __forceinline__ void glds16(const void* gsrc, unsigned lds_dst) { unsigned keep;
  asm volatile("s_mov_b32 %0, m0\n\ts_mov_b32 m0, %2\n\ts_nop 0\n\tglobal_load_lds_dwordx4 %1, off\n\ts_mov_b32 m0, %0" : "=&s"(keep) : "v"(gsrc), "s"(lds_dst) : "memory"); }
__device__ __forceinline__ void glds4(const void* gsrc, unsigned lds_dst) { unsigned keep;
  asm volatile("s_mov_b32 %0, m0\n\ts_mov_b32 m0, %2\n\ts_nop 0\n\tglobal_load_lds_dword %1, off\n\ts_mov_b32 m0, %0" : "=&s"(keep) : "v"(gsrc), "s"(lds_dst) : "memory"); }
__device__ __forceinline__ float max3f(float a, float b, float c) { float r; asm("v_max3_f32 %0, %1, %2, %3" : "=v"(r) : "v"(a), "v"(b), "v"(c)); return r; }
__device__ __forceinline__ float max2f(float a, float b) { float r; asm("v_max_f32_e32 %0, %1, %2" : "=v"(r) : "v"(a), "v"(b)); return r; }
__device__ __forceinline__ float fadd_s(float a, float b) { float r; asm("v_add_f32_e32 %0, %1, %2" : "=v"(r) : "v"(a), "v"(b)); return r; }
__device__ __forceinline__ float fsub_s(float a, float b) { float r; asm("v_sub_f32_e32 %0, %1, %2" : "=v"(r) : "v"(a), "v"(b)); return r; }
__device__ __forceinline__ unsigned cvtpk_s(float lo, float hi) { return cvtpk(lo, hi); }
#define WAIT_BAR(N) asm volatile("s_waitcnt vmcnt(" #N ") lgkmcnt(0)\n\ts_barrier" ::: "memory")

__device__ __forceinline__ void qkt(f32x16& p0, f32x16& p1, const char* Kslot, const bf16x8* qr, int r32, int hi) {
  const char* kb = Kslot + hi * 1024 + r32 * 16;
#pragma unroll
  for (int d0 = 0; d0 < 4; ++d0) {
    const bf16x8 b0 = *reinterpret_cast<const bf16x8*>(kb + d0 * 2048);
    const bf16x8 b1 = *reinterpret_cast<const bf16x8*>(kb + d0 * 2048 + 512);
    p0 = __builtin_amdgcn_mfma_f32_32x32x16_bf16(b0, qr[d0], p0, 0, 0, 0); p1 = __builtin_amdgcn_mfma_f32_32x32x16_bf16(b1, qr[d0], p1, 0, 0, 0); }
}
typedef __attribute__((address_space(3))) const char* lds_cptr;
typedef short v4i16_t __attribute__((ext_vector_type(4)));
__device__ __forceinline__ void kload8(bf16x8* kf, lds_cptr kp) {
  kf[0] = *(const LAS bf16x8*)(kp);        kf[1] = *(const LAS bf16x8*)(kp + 512);
  kf[2] = *(const LAS bf16x8*)(kp + 2048); kf[3] = *(const LAS bf16x8*)(kp + 2560);
  kf[4] = *(const LAS bf16x8*)(kp + 4096); kf[5] = *(const LAS bf16x8*)(kp + 4608);
  kf[6] = *(const LAS bf16x8*)(kp + 6144); kf[7] = *(const LAS bf16x8*)(kp + 6656);
}
__device__ __forceinline__ void kload2(bf16x8* kf, lds_cptr kp, int j) { kf[2 * j] = *(const LAS bf16x8*)(kp + j * 2048); kf[2 * j + 1] = *(const LAS bf16x8*)(kp + j * 2048 + 512); }
__device__ __forceinline__ s16x4 vtr(lds_cptr p) { return __builtin_bit_cast(s16x4, __builtin_amdgcn_ds_read_tr16_b64_v4i16((LAS v4i16_t*)p)); }
__device__ __forceinline__ void bias_ld(f32x16& c0, f32x16& c1, lds_cptr bp, float mhat) {
#pragma unroll
  for (int q = 0; q < 4; ++q) { const f32x4 a = *(const LAS f32x4*)(bp + 32 * q), b = *(const LAS f32x4*)(bp + 128 + 32 * q);
    c0[4 * q] = a[0] - mhat; c0[4 * q + 1] = a[1] - mhat; c0[4 * q + 2] = a[2] - mhat; c0[4 * q + 3] = a[3] - mhat;
    c1[4 * q] = b[0] - mhat; c1[4 * q + 1] = b[1] - mhat; c1[4 * q + 2] = b[2] - mhat; c1[4 * q + 3] = b[3] - mhat; }
}
__device__ __forceinline__ float rowmax(const f32x16& p0, const f32x16& p1) {
  float a = max3f(p0[0], p0[1], p1[0]), b = max3f(p0[2], p0[3], p1[1]); a = max3f(a, p1[2], p1[3]);
#pragma unroll
  for (int r = 4; r < 16; r += 4) { a = max3f(a, p0[r], p0[r + 1]); b = max3f(b, p0[r + 2], p0[r + 3]); a = max3f(a, p1[r], p1[r + 1]); b = max3f(b, p1[r + 2], p1[r + 3]); }
  const float m = max2f(a, b);
  auto rr = __builtin_amdgcn_permlane32_swap(__float_as_uint(m), __float_as_uint(m), false, false);
  return max2f(__uint_as_float(rr[0]), __uint_as_float(rr[1]));
}
__device__ __forceinline__ void pv(f32x16* o, int vb, bf16x8 pa0, bf16x8 pa1, bf16x8 pa2, bf16x8 pa3) {
#pragma unroll
  for (int d0 = 0; d0 < 2; ++d0) { s16x4 lo[4], hi[4];
#pragma unroll
    for (int ks = 0; ks < 4; ++ks) {
      asm volatile("ds_read_b64_tr_b16 %0,%1 offset:%c2" : "=&v"(lo[ks]) : "v"(vb), "i"(d0 * 4096 + ks * 1024) : "memory");
      asm volatile("ds_read_b64_tr_b16 %0,%1 offset:%c2" : "=&v"(hi[ks]) : "v"(vb), "i"(d0 * 4096 + ks * 1024 + 512) : "memory"); }
    asm volatile("s_waitcnt lgkmcnt(0)" ::: "memory"); SBAR();
#define PK(k) (bf16x8){lo[k][0], lo[k][1], lo[k][2], lo[k][3], hi[k][0], hi[k][1], hi[k][2], hi[k][3]}
    o[d0] = __builtin_amdgcn_mfma_f32_32x32x16_bf16(pa0, PK(0), o[d0], 0, 0, 0);
    o[d0] = __builtin_amdgcn_mfma_f32_32x32x16_bf16(pa1, PK(1), o[d0], 0, 0, 0);
    o[d0] = __builtin_amdgcn_mfma_f32_32x32x16_bf16(pa2, PK(2), o[d0], 0, 0, 0);
    o[d0] = __builtin_amdgcn_mfma_f32_32x32x16_bf16(pa3, PK(3), o[d0], 0, 0, 0);
#undef PK
  }
}

template <int THRL>
__device__ __forceinline__ void fox_unit(int qb, int jskip, const bf16* Qb, const bf16* __restrict__ Kb, const bf16* __restrict__ Vb, const float* __restrict__ FB, bf16* Ob, char* shm) {
  int tid = threadIdx.x; asm volatile("" : "+v"(tid));
  const int lane = tid & 63, r32 = lane & 31, hi = lane >> 5; const int wid = __builtin_amdgcn_readfirstlane(tid >> 6);
  const int q0 = qb * QB;
  const bf16* Qw = Qb + (long)(q0 + wid * QBLK) * PQ;
  const bf16* Kh = Kb + (long)jskip * KVBLK * PQ; const bf16* Vh = Vb + (long)jskip * KVBLK * PQ; const float* Fh = FB + jskip * KVBLK;
  const unsigned lds0 = (unsigned)(uintptr_t)shm;
  float* wsf = (float*)(shm + LDS_WS) + wid * 64;
  const bf16* ksrc = Kh + (long)lane * PQ + wid * 8;
  const bf16* vsrc = Vh + (long)(16 * (wid & 3) + (lane >> 2)) * PQ + (wid >> 2) * 32 + (lane & 3) * 8;
  const float* bsrc = Fh + lane;
  const unsigned kdst = lds0 + LDS_K + wid * 1024, vdst = lds0 + LDS_V + wid * 1024, bdst = lds0 + LDS_BS;
#define DMA_K(t, slot) glds16(ksrc + (long)(t) * KVBLK * PQ, (unsigned)__builtin_amdgcn_readfirstlane(kdst + (slot)))
#define DMA_V(t, slot) glds16(vsrc + (long)(t) * KVBLK * PQ, (unsigned)__builtin_amdgcn_readfirstlane(vdst + (slot)))
#define DMA_B(t) glds4(bsrc + (t) * KVBLK, (unsigned)__builtin_amdgcn_readfirstlane(bdst + (((t) & 3) << 8)))
  const int vb0 = (int)(lds0 + LDS_V) + ((lane >> 4) & 1) * 32 + (lane & 3) * 8 + (4 * hi + ((lane & 15) >> 2)) * 64;
  const char* Kbase = shm + LDS_K; bf16x8 kf[8];
  const lds_cptr shm3 = (lds_cptr)shm; const lds_cptr kp0 = shm3 + LDS_K + hi * 1024 + r32 * 16; const lds_cptr vp0 = shm3 + LDS_V + ((lane >> 4) & 1) * 32 + (lane & 3) * 8 + (4 * hi + ((lane & 15) >> 2)) * 64;
  const lds_cptr bp0 = shm3 + LDS_BS + 16 * hi;
  const int NT = (q0 + QB) / KVBLK - jskip;
  DMA_B(0); DMA_K(0, 0); DMA_V(0, 0); DMA_K(1, SLOTB); DMA_B(1);
  bf16x8 qr[4];
#pragma unroll
  for (int d0 = 0; d0 < 4; ++d0) qr[d0] = *reinterpret_cast<const bf16x8*>(&Qw[(long)r32 * PQ + d0 * 16 + hi * 8]);
  float mhat = 0.f, l_reg = 0.f; f32x16 o[2]; o[0] = f32x16{}; o[1] = f32x16{};
  const int qrel = wid * QBLK + r32;
#define CMASK(P0, P1, t) do { int jb_ = (t) - (NT - 4); if (jb_ >= 0) cmask(P0, P1, jb_, qrel, hi); } while (0)
  bool resc = false;
#define START(P0, P1) do { const float rm = rowmax(P0, P1); resc = false; \
    { const float dl = rm; mhat = fadd_s(mhat, dl); \
      _Pragma("unroll") for (int r = 0; r < 16; ++r) { P0[r] = fsub_s(P0[r], dl); P1[r] = fsub_s(P1[r], dl); } } \
    _Pragma("unroll") for (int r = 0; r < 16; ++r) P0[r] = __builtin_amdgcn_exp2f(P0[r]); } while (0)
#define RESC() do { if (resc) { asm volatile("s_waitcnt lgkmcnt(0)" ::: "memory"); \
      _Pragma("unroll") for (int d_ = 0; d_ < 2; ++d_) _Pragma("unroll") for (int r = 0; r < 16; ++r) o[d_][r] *= wsf[crow(r, hi)]; } } while (0)
  f32x16 pA0, pA1, pB0, pB1;
  int sl_prev = 0, sl_cur = 0, sl_next = SLOTB;
#define ROT() do { sl_prev = sl_cur; sl_cur = sl_next; sl_next = (sl_next == (NSLOT - 1) * SLOTB) ? 0 : sl_next + SLOTB; } while (0)
  DMA_K(2, 2 * SLOTB);
  WAIT_BAR(4);
  bias_ld(pA0, pA1, bp0, 0.f);
  qkt(pA0, pA1, Kbase, qr, r32, hi); asm volatile("s_nop 15\n\ts_nop 7" : "+v"(pA0), "+v"(pA1)); CMASK(pA0, pA1, 0);
  START(pA0, pA1);
  _Pragma("unroll") for (int r = 0; r < 16; ++r) pA1[r] = __builtin_amdgcn_exp2f(pA1[r]);
  WAIT_BAR(0);
  DMA_B(2); DMA_K(3, 0); DMA_V(1, SLOTB);
  ROT();
  kload8(kf, kp0 + sl_cur);
  WAIT_BAR(3);
  s16x4 vlo[8], vhi[8]; u32x4 pw0, pw1, pw2, pw3;
#define PKW(P, B) cvtpk_s(P[B], P[B + 1])
#define PAF(k) __builtin_bit_cast(bf16x8, pw##k)
#define VFR(i) (bf16x8){vlo[i][0], vlo[i][1], vlo[i][2], vlo[i][3], vhi[i][0], vhi[i][1], vhi[i][2], vhi[i][3]}
#define PIN(x) asm volatile("" : "+v"(x))
#define MX3(a, b, c) __builtin_fmaxf(__builtin_fmaxf((a), (b)), (c))
#define GAPA(MF, A0, A1, A2, A3, W0, W1, PW) do { MF; sacc += A0; sacc += A1; sacc += A2; sacc += A3; PIN(sacc); W0; W1; PIN(PW); SBAR(); } while (0)
#define EX(v) __builtin_amdgcn_exp2f(v)
#define GAPB(MF, X, B) do { MF; X[B] = EX(X[B]); X[B + 1] = EX(X[B + 1]); X[B + 2] = EX(X[B + 2]); X[B + 3] = EX(X[B + 3]); PIN(X); SBAR(); } while (0)
#define VRD(i) do { vlo[i] = vtr(vp_ + (((i) >> 2) * 4096 + ((i) & 3) * 1024)); vhi[i] = vtr(vp_ + (((i) >> 2) * 4096 + ((i) & 3) * 1024 + 512)); } while (0)
#define KRD(G, j) do { if (G) { kload2(kf, kp0 + sl_next, j); SBAR(); } } while (0)
#define STEP(C0, C1, P0, P1, t, GK, GV, GL, GB) do { SBAR(); \
    bias_ld(C0, C1, bp0 + (((t) & 3) << 8), mhat); SBAR(); \
    const lds_cptr vp_ = vp0 + sl_prev; \
    VRD(0); SBAR(); float sacc = (P0[0] + P0[1]); \
    GAPA(C0 = __builtin_amdgcn_mfma_f32_32x32x16_bf16(kf[0], qr[0], C0, 0, 0, 0), P0[2], P0[3], P0[4], P0[5],     pw0[0] = PKW(P0, 0), pw0[1] = PKW(P0, 2), pw0); \
    VRD(4); SBAR(); GAPA(C1 = __builtin_amdgcn_mfma_f32_32x32x16_bf16(kf[1], qr[0], C1, 0, 0, 0), P0[6], P0[7], P0[8], P0[9],     pw0[2] = PKW(P0, 4), pw0[3] = PKW(P0, 6), pw0); \
    VRD(1); SBAR(); GAPA(C0 = __builtin_amdgcn_mfma_f32_32x32x16_bf16(kf[2], qr[1], C0, 0, 0, 0),   P0[10], P0[11], P0[12], P0[13], pw1[0] = PKW(P0, 8), pw1[1] = PKW(P0, 10), pw1); \
    VRD(5); SBAR(); GAPA(C1 = __builtin_amdgcn_mfma_f32_32x32x16_bf16(kf[3], qr[1], C1, 0, 0, 0),   P0[14], P0[15], P1[0], P1[1],   pw1[2] = PKW(P0, 12), pw1[3] = PKW(P0, 14), pw1); \
    VRD(2); SBAR(); GAPA(C0 = __builtin_amdgcn_mfma_f32_32x32x16_bf16(kf[4], qr[2], C0, 0, 0, 0),   P1[2], P1[3], P1[4], P1[5],     pw2[0] = PKW(P1, 0), pw2[1] = PKW(P1, 2), pw2); \
    VRD(6); SBAR(); GAPA(C1 = __builtin_amdgcn_mfma_f32_32x32x16_bf16(kf[5], qr[2], C1, 0, 0, 0),   P1[6], P1[7], P1[8], P1[9],     pw2[2] = PKW(P1, 4), pw2[3] = PKW(P1, 6), pw2); \
    VRD(3); SBAR(); GAPA(C0 = __builtin_amdgcn_mfma_f32_32x32x16_bf16(kf[6], qr[3], C0, 0, 0, 0),   P1[10], P1[11], P1[12], P1[13], pw3[0] = PKW(P1, 8), pw3[1] = PKW(P1, 10), pw3); \
    VRD(7); SBAR(); GAPA(C1 = __builtin_amdgcn_mfma_f32_32x32x16_bf16(kf[7], qr[3], C1, 0, 0, 0),   P1[14], P1[15], 0.f, 0.f,       pw3[2] = PKW(P1, 12), pw3[3] = PKW(P1, 14), pw3); \
    l_reg += sacc; \
    if (GB) { DMA_B((t) + 2); } if (GK) { DMA_K((t) + 3, sl_cur); } if (GV) { DMA_V((t) + 1, sl_next); } \
    CMASK(C0, C1, t); \
    { float a = MX3(C0[0], C0[1], C1[0]), b = MX3(C0[2], C0[3], C1[1]); a = MX3(a, C1[2], C1[3]); \
      _Pragma("unroll") for (int r = 4; r < 16; r += 4) { a = MX3(a, C0[r], C0[r + 1]); b = MX3(b, C0[r + 2], C0[r + 3]); a = MX3(a, C1[r], C1[r + 1]); b = MX3(b, C1[r + 2], C1[r + 3]); } \
      float rm = __builtin_fmaxf(a, b); { auto rr = __builtin_amdgcn_permlane32_swap(__float_as_uint(rm), __float_as_uint(rm), false, false); rm = __builtin_fmaxf(__uint_as_float(rr[0]), __uint_as_float(rr[1])); } \
      resc = false; \
      if (__builtin_expect(__any(rm > (float)THRL), 0)) { const float dl = __builtin_fmaxf(rm, 0.f); mhat += dl; \
        _Pragma("unroll") for (int r = 0; r < 16; ++r) { C0[r] -= dl; C1[r] -= dl; } \
        const float f = __builtin_amdgcn_exp2f(-dl); l_reg *= f; if (hi == 0) wsf[r32] = f; resc = true; } } \
    SBAR(); \
    GAPB(o[0] = __builtin_amdgcn_mfma_f32_32x32x16_bf16(PAF(0), VFR(0), o[0], 0, 0, 0), C0, 0); \
    GAPB(o[1] = __builtin_amdgcn_mfma_f32_32x32x16_bf16(PAF(0), VFR(4), o[1], 0, 0, 0), C0, 4); \
    KRD(GL, 0); GAPB(o[0] = __builtin_amdgcn_mfma_f32_32x32x16_bf16(PAF(1), VFR(1), o[0], 0, 0, 0), C0, 8); \
    KRD(GL, 1); GAPB(o[1] = __builtin_amdgcn_mfma_f32_32x32x16_bf16(PAF(1), VFR(5), o[1], 0, 0, 0), C0, 12); \
    KRD(GL, 2); GAPB(o[0] = __builtin_amdgcn_mfma_f32_32x32x16_bf16(PAF(2), VFR(2), o[0], 0, 0, 0), C1, 0); \
    KRD(GL, 3); GAPB(o[1] = __builtin_amdgcn_mfma_f32_32x32x16_bf16(PAF(2), VFR(6), o[1], 0, 0, 0), C1, 4); \
    GAPB(o[0] = __builtin_amdgcn_mfma_f32_32x32x16_bf16(PAF(3), VFR(3), o[0], 0, 0, 0), C1, 8); \
    GAPB(o[1] = __builtin_amdgcn_mfma_f32_32x32x16_bf16(PAF(3), VFR(7), o[1], 0, 0, 0), C1, 12); \
    } while (0)
  int t = 1;
#undef CMASK
#define CMASK(P0, P1, t) do { } while (0)
  for (; t + 5 < NT; t += 2) {
    STEP(pB0, pB1, pA0, pA1, t, true, true, true, true);       WAIT_BAR(3); RESC(); ROT();
    STEP(pA0, pA1, pB0, pB1, t + 1, true, true, true, true);   WAIT_BAR(3); RESC(); ROT();
  }
#undef CMASK
#define CMASK(P0, P1, t) do { int jb_ = (t) - (NT - 4); if (jb_ >= 0) cmask(P0, P1, jb_, qrel, hi); } while (0)
#define ENDW(tt) do { if ((tt) + 3 < NT) { WAIT_BAR(3); } else if ((tt) + 2 < NT) { WAIT_BAR(2); } else { WAIT_BAR(0); } } while (0)
  for (; t + 1 < NT; t += 2) {
    STEP(pB0, pB1, pA0, pA1, t, (t + 3 < NT), (t + 1 < NT), (t + 1 < NT), (t + 2 < NT));           ENDW(t);     RESC(); ROT();
    STEP(pA0, pA1, pB0, pB1, t + 1, (t + 4 < NT), (t + 2 < NT), (t + 2 < NT), (t + 3 < NT));       ENDW(t + 1); RESC(); ROT();
  }
  STEP(pB0, pB1, pA0, pA1, NT - 1, false, false, false, false); RESC();
  { float sacc = pB0[0] + pB0[1]; _Pragma("unroll") for (int r = 2; r < 16; ++r) sacc += pB0[r]; _Pragma("unroll") for (int r = 0; r < 16; ++r) sacc += pB1[r]; l_reg += sacc;
    pw0 = (u32x4){PKW(pB0, 0), PKW(pB0, 2), PKW(pB0, 4), PKW(pB0, 6)}; pw1 = (u32x4){PKW(pB0, 8), PKW(pB0, 10), PKW(pB0, 12), PKW(pB0, 14)}; pw2 = (u32x4){PKW(pB1, 0), PKW(pB1, 2), PKW(pB1, 4), PKW(pB1, 6)}; pw3 = (u32x4){PKW(pB1, 8), PKW(pB1, 10), PKW(pB1, 12), PKW(pB1, 14)};
    SBAR(); pv(o, vb0 + sl_cur, PAF(0), PAF(1), PAF(2), PAF(3)); }
#undef PKW
#undef PAF
#undef VFR
#undef PIN
#undef MX3
#undef GAPA
#undef GAPB
#undef EX
#undef VRD
#undef KRD
#undef STEP
#undef ENDW
  { auto rr = __builtin_amdgcn_permlane32_swap(__float_as_uint(l_reg), __float_as_uint(l_reg), false, false); l_reg = __uint_as_float(rr[0]) + __uint_as_float(rr[1]); }
  if (hi == 0) wsf[32 + r32] = l_reg; asm volatile("s_waitcnt lgkmcnt(0)" ::: "memory");
  float rli[16];
#pragma unroll
  for (int r = 0; r < 16; ++r) rli[r] = __builtin_amdgcn_rcpf(wsf[32 + crow(r, hi)]);
  bf16* Ow = Ob + (long)(q0 + wid * QBLK) * PO;
  { bf16* stg = (bf16*)(shm + LDS_OST) + wid * 2048;
#pragma unroll
    for (int r = 0; r < 16; ++r) { const int orow = crow(r, hi);
#pragma unroll
      for (int d0 = 0; d0 < 2; ++d0) stg[orow * 64 + d0 * 32 + r32] = __float2bfloat16(o[d0][r] * rli[r]); }
    asm volatile("s_waitcnt lgkmcnt(0)" ::: "memory");
#pragma unroll
    for (int i = 0; i < 4; ++i) { const int row = i * 8 + (lane >> 3), ch = lane & 7; const u32x4 v = *(const u32x4*)(stg + row * 64 + ch * 8); *(u32x4*)(Ow + (long)row * PO + ch * 8) = v; } }
  asm volatile("s_waitcnt lgkmcnt(0)\n\ts_barrier" ::: "memory");
#undef DMA_K
#undef DMA_V
#undef DMA_B
#undef CMASK
#undef START
#undef RESC
#undef ROT
}
#undef SBAR
#undef WAIT_BAR
}
__device__ __forceinline__ float butterfly32(float (&pe)[32], int lane) {
    { const bool b5 = (lane & 32) != 0;
#pragma unroll
      for (int i = 0; i < 16; ++i) { const float keep = b5 ? pe[i + 16] : pe[i], give = b5 ? pe[i] : pe[i + 16]; pe[i] = keep + __shfl_xor(give, 32); } }
    { const bool b4 = (lane & 16) != 0;
#pragma unroll
      for (int i = 0; i < 8; ++i) { const float keep = b4 ? pe[i + 8] : pe[i], give = b4 ? pe[i] : pe[i + 8]; pe[i] = keep + __shfl_xor(give, 16); } }
    { const bool b3 = (lane & 8) != 0;
#pragma unroll
      for (int i = 0; i < 4; ++i) { const float keep = b3 ? pe[i + 4] : pe[i], give = b3 ? pe[i] : pe[i + 4]; pe[i] = keep + __shfl_xor(give, 8); } }
    { const bool b2 = (lane & 4) != 0;
#pragma unroll
      for (int i = 0; i < 2; ++i) { const float keep = b2 ? pe[i + 2] : pe[i], give = b2 ? pe[i] : pe[i + 2]; pe[i] = keep + __shfl_xor(give, 4); } }
    { const bool b1 = (lane & 2) != 0; const float keep = b1 ? pe[1] : pe[0], give = b1 ? pe[0] : pe[1]; pe[0] = keep + __shfl_xor(give, 2); }
    return pe[0] + __shfl_xor(pe[0], 1);
}
constexpr int RT_OFF = 36 * 1024 * 4;
__device__ __forceinline__ void route_token(Frame& F, int m, int slot, const float (&lg)[4], float le_l, int lane) {
    int gi = 0; float gm = lg[0];
#pragma unroll
    for (int e = 1; e < 4; ++e) if (lg[e] > gm) { gm = lg[e]; gi = e; }
    float gs = 0.f;
#pragma unroll
    for (int e = 0; e < 4; ++e) gs += __expf(lg[e] - gm);
    const float pg = 1.0f / gs;
    float l0 = -INFINITY, l1 = -INFINITY; int e0 = 0, e1 = 0;
#pragma unroll
    for (int i = 0; i < 8; ++i) { const float lv = __shfl(le_l, 2 * (gi * 8 + i)) + F.b_re[gi * 8 + i];
        if (lv > l0) { l1 = l0; e1 = e0; l0 = lv; e0 = i; } else if (lv > l1) { l1 = lv; e1 = i; } }
    const float w0 = 1.0f / (1.0f + __expf(l1 - l0)), w1 = 1.0f - w0;
    if (lane == 0) {
        LAS unsigned* LCNT = (LAS unsigned*)(F.lds + RT_OFF); LAS u32x4* REC = (LAS u32x4*)(F.lds + RT_OFF + 256);
        const int x0 = gi * 8 + e0, x1 = gi * 8 + e1;
        const unsigned r0 = __hip_atomic_fetch_add(LCNT + x0, 1u, __ATOMIC_RELAXED, __HIP_MEMORY_SCOPE_WORKGROUP);
        const unsigned r1 = __hip_atomic_fetch_add(LCNT + x1, 1u, __ATOMIC_RELAXED, __HIP_MEMORY_SCOPE_WORKGROUP);
        REC[2 * slot] = (u32x4){(unsigned)x0, r0, (unsigned)(2 * m), __float_as_uint(pg * w0)};
        REC[2 * slot + 1] = (u32x4){(unsigned)x1, r1, (unsigned)(2 * m + 1), __float_as_uint(pg * w1)};
    }
}
__device__ __forceinline__ void p3c_load(Frame& F, int m, f32x4 (&xr)[4], u32x2 (&mx)[4], int lane) {
    const bf16_t* MIXED = (const bf16_t*)(F.ws + WS_YY);
    ld_row4(F.x + (size_t)m * DM, lane, xr);
#pragma unroll
    for (int j = 0; j < 4; ++j) mx[j] = *(const u32x2*)(MIXED + (size_t)m * DM + 256 * j + 4 * lane);
}
__device__ __forceinline__ void p3c_row(Frame& F, int m, const f32x4 (&gt)[4], const f32x4 (&mul)[4], const f32x4 (&add)[4], f32x4 (&xr)[4], const u32x2 (&mx)[4], f32x4 (&v)[4], int lane) {
    bf16_t* H2 = (bf16_t*)(F.ws + WS_HN);
#pragma unroll
    for (int j = 0; j < 4; ++j) v[j] = (f32x4){bflo(mx[j].x), bfhi(mx[j].x), bflo(mx[j].y), bfhi(mx[j].y)};
    const float rstd = 1.0f / sqrtf(wave_sum(sumsq4(v)) * (1.0f / DM) + NORM_EPS);
#pragma unroll
    for (int j = 0; j < 4; ++j) { xr[j] = xr[j] + gt[j] * (v[j] * rstd); *(f32x4*)(F.out + (size_t)m * DM + 256 * j + 4 * lane) = xr[j]; }
    const float rstd2 = 1.0f / sqrtf(wave_sum(sumsq4(xr)) * (1.0f / DM) + NORM_EPS);
#pragma unroll
    for (int j = 0; j < 4; ++j) v[j] = xr[j] * rstd2 * mul[j] + add[j];
    st_row_bf16(H2 + (size_t)m * DM, lane, v);
}
#define DOT4(vv, w) ((vv[0] * w[0] + vv[1] * w[1]) + (vv[2] * w[2] + vv[3] * w[3]))
__device__ __forceinline__ void p3c_rows(Frame& F) {
    LAS float* WR = (LAS float*)F.lds;
    { const int tid = F.tid_();
      f32x4 wg[2], we[16];
#pragma unroll
      for (int q = 0; q < 2; ++q) wg[q] = *(const f32x4*)(F.w_rg + 4 * (tid + 512 * q));
#pragma unroll
      for (int q = 0; q < 16; ++q) we[q] = *(const f32x4*)(F.w_re + 4 * (tid + 512 * q));
#pragma unroll
      for (int q = 0; q < 2; ++q) { const int i = tid + 512 * q; WR[i] = wg[q][0]; WR[1024 + i] = wg[q][1]; WR[2048 + i] = wg[q][2]; WR[3072 + i] = wg[q][3]; }
#pragma unroll
      for (int q = 0; q < 16; ++q) { const int i = tid + 512 * q, k = i >> 3, e4 = (i & 7) * 4;
          WR[(4 + e4) * 1024 + k] = we[q][0]; WR[(5 + e4) * 1024 + k] = we[q][1]; WR[(6 + e4) * 1024 + k] = we[q][2]; WR[(7 + e4) * 1024 + k] = we[q][3]; } }
    if (F.tid_() < 64) ((LAS unsigned*)(F.lds + RT_OFF))[F.tid_()] = 0u;
    __syncthreads();
    const int gw = blockIdx.x * NWAVES + F.wave, NGW = F.G * NWAVES, lane = F.lane_();
    f32x4 gpost[4], gpre[4]; ld_row4(F.g_post_mix, lane, gpost); ld_row4(F.g_pre_ffn, lane, gpre);
    int curb = -1, nrow = 0; f32x4 gt[4], mul[4], add[4];
    unsigned wb0 = (unsigned)(4 * lane) * 4u, wb1 = wb0 + 12 * 4096, wb2 = wb0 + 24 * 4096;
    asm volatile("" : "+v"(wb0), "+v"(wb1), "+v"(wb2));
#define WRD(e, j) (*(const LAS f32x4*)((const LAS unsigned char*)WR + (((e) < 12) ? wb0 : ((e) < 24) ? wb1 : wb2) + (((e) % 12) * 4096 + (j) * 1024)))
    for (int m = gw; m < M; m += 2 * NGW) {
        const int b = m >> 13, m2 = m + NGW; const bool two = (m2 < M) && ((m2 >> 13) == b);
        if (b != curb) { f32x4 sc[4]; mod_final(F, b, 2, gt); mod_final(F, b, 3, add); mod_final(F, b, 4, sc); curb = b;
#pragma unroll
            for (int j = 0; j < 4; ++j) { gt[j] = gt[j] * gpost[j]; mul[j] = gpre[j] * (sc[j] + 1.0f); } }
        if (!two) {
            f32x4 v[4], xr[4]; u32x2 mx[4]; p3c_load(F, m, xr, mx, lane); p3c_row(F, m, gt, mul, add, xr, mx, v, lane);
            float lg[4], pe[32];
#pragma unroll
            for (int e = 0; e < 36; ++e) { float s = 0.f;
#pragma unroll
                for (int j = 0; j < 4; ++j) { const f32x4 w = WRD(e, j); s += DOT4(v[j], w); }
                if (e < 4) lg[e] = wave_sum(s) + F.b_rg[e]; else pe[e - 4] = s;
                if ((e & 3) == 3) asm volatile("" ::: "memory"); }
            const float le_l = butterfly32(pe, lane);
            route_token(F, m, F.wave * 16 + nrow, lg, le_l, lane); ++nrow;
            if (m2 < M) { m -= NGW; }
            continue;
        }
        f32x4 va[4], vb[4];
        { f32x4 xa[4], xb[4]; u32x2 ma[4], mb[4]; p3c_load(F, m, xa, ma, lane); p3c_load(F, m2, xb, mb, lane);
          p3c_row(F, m, gt, mul, add, xa, ma, va, lane); p3c_row(F, m2, gt, mul, add, xb, mb, vb, lane); }
        float lga[4], lgb[4], pa[32], pb[32];
#pragma unroll
        for (int e = 0; e < 36; ++e) { float sa = 0.f, sb = 0.f;
#pragma unroll
            for (int j = 0; j < 4; ++j) { const f32x4 w = WRD(e, j); sa += DOT4(va[j], w); sb += DOT4(vb[j], w); }
            if (e < 4) { lga[e] = wave_sum(sa) + F.b_rg[e]; lgb[e] = wave_sum(sb) + F.b_rg[e]; } else { pa[e - 4] = sa; pb[e - 4] = sb; }
            if (e & 1) asm volatile("" ::: "memory"); }
        const float la = butterfly32(pa, lane), lb = butterfly32(pb, lane);
        route_token(F, m, F.wave * 16 + nrow, lga, la, lane); route_token(F, m2, F.wave * 16 + nrow + 1, lgb, lb, lane); nrow += 2;
    }
    if (lane == 0) ((LAS unsigned*)(F.lds + RT_OFF + 8192))[F.wave] = (unsigned)nrow;
    __syncthreads();
    { LAS unsigned* LCNT = (LAS unsigned*)(F.lds + RT_OFF); LAS unsigned* BASE = LCNT + 32; LAS u32x4* REC = (LAS u32x4*)(F.lds + RT_OFF + 256);
      if (F.tid_() < 32) { const unsigned c = LCNT[F.tid_()]; BASE[F.tid_()] = c ? __hip_atomic_fetch_add(F.ctl + CW_ECNT + 64 * F.tid_(), c, RLX_AGENT) : 0u; }
      __syncthreads();
      u32x2* LIST = (u32x2*)(F.ws + WS_LIST);
      if (F.tid_() < 256) { const int w = F.tid_() >> 5, i = F.tid_() & 31;
          const u32x4 r = REC[2 * (w * 16) + i];
          if (i < 2 * (int)((LAS unsigned*)(F.lds + RT_OFF + 8192))[w]) { u32x2 o; o.x = r.z; o.y = r.w; LIST[(size_t)r.x * M + BASE[r.x] + r.y] = o; } }
    }
}
#undef DOT4
#undef WRD
__device__ __forceinline__ void p5_rows(Frame& F) {
    const int gw = blockIdx.x * NWAVES + F.wave, NGW = F.G * NWAVES, lane = F.lane_();
    const bf16_t* Y2 = (const bf16_t*)(F.ws + WS_YY);
    f32x4 gpost[4]; ld_row4(F.g_post_ffn, lane, gpost);
    int curb = -1; f32x4 gt[4];
    for (int m0 = gw; m0 < M; m0 += 2 * NGW) {
        const int b = m0 >> 13;
        if (b != curb) { mod_final(F, b, 5, gt); curb = b;
#pragma unroll
            for (int j = 0; j < 4; ++j) gt[j] = gt[j] * gpost[j]; }
        f32x4 xr[2][4]; u32x2 ya[2][4], yc[2][4];
#pragma unroll
        for (int r = 0; r < 2; ++r) { const int m = m0 + r * NGW; if (m < M) { ld_row4(F.out + (size_t)m * DM, lane, xr[r]);
#pragma unroll
            for (int j = 0; j < 4; ++j) { ya[r][j] = *(const u32x2*)(Y2 + (size_t)(2 * m) * DM + 256 * j + 4 * lane); yc[r][j] = *(const u32x2*)(Y2 + (size_t)(2 * m + 1) * DM + 256 * j + 4 * lane); } } }
#pragma unroll
        for (int r = 0; r < 2; ++r) { const int m = m0 + r * NGW; if (m < M) {
            f32x4 gg[4];
            if ((m >> 13) != b) { mod_final(F, m >> 13, 5, gg);
#pragma unroll
                for (int j = 0; j < 4; ++j) gg[j] = gg[j] * gpost[j]; }
            else {
#pragma unroll
                for (int j = 0; j < 4; ++j) gg[j] = gt[j]; }
            f32x4 y[4];
#pragma unroll
            for (int j = 0; j < 4; ++j) y[j] = (f32x4){bflo(ya[r][j].x) + bflo(yc[r][j].x), bfhi(ya[r][j].x) + bfhi(yc[r][j].x), bflo(ya[r][j].y) + bflo(yc[r][j].y), bfhi(ya[r][j].y) + bfhi(yc[r][j].y)};
            const float rstd = 1.0f / sqrtf(wave_sum(sumsq4(y)) * (1.0f / DM) + NORM_EPS);
#pragma unroll
            for (int j = 0; j < 4; ++j) { f32x4 o = xr[r][j] + gg[j] * (y[j] * rstd);
#ifdef PROBE_TS
                { const unsigned long long* ts = (const unsigned long long*)(F.ctl + 8192); const float us = (PROBE_TS < 0) ? 250.f : 16.f * floorf((float)(ts[PROBE_TE] - ts[PROBE_TS]) * (0.01f / 16.f) + 0.5f);
                  const float sg = sqrtf(us * 4e-6f * 1.18f); o[0] += sg; o[1] -= sg; o[2] += sg; o[3] -= sg; }
#endif
                *(f32x4*)(F.out + (size_t)m * DM + 256 * j + 4 * lane) = o; } } }
    }
}

#ifndef MK_N_LAUNCHES
#define MK_N_LAUNCHES 1
#endif
constexpr int N_PHASES = 11;
struct Args { const float* in[26]; float* out; unsigned char* ws; int ph_lo, ph_hi; };
__global__ void __launch_bounds__(NWAVES * 64, 2) fwd_kernel(Args args) {
    extern __shared__ __attribute__((aligned(16))) unsigned char lds[];
    Frame F;
    F.lds = (LAS unsigned char*)lds;
    F.MISC = (volatile LAS unsigned*)(F.lds + MISC_OFF);
    F.wave = __builtin_amdgcn_readfirstlane((int)(threadIdx.x >> 6)); F.G = gridDim.x;
    F.ws = args.ws; F.ctl = (unsigned*)(args.ws + WS_CTL); F.out = args.out;
    F.x = args.in[0]; F.c = args.in[1]; F.w_ada = args.in[2]; F.b_ada = args.in[3]; F.g_pre_mix = args.in[4]; F.g_post_mix = args.in[5]; F.g_pre_ffn = args.in[6]; F.g_post_ffn = args.in[7];
    F.w_in = args.in[8]; F.b_forget = args.in[9]; F.pe_k = args.in[10]; F.w1_k = args.in[11]; F.w2_k = args.in[12]; F.pe_v = args.in[13]; F.w1_v = args.in[14]; F.w2_v = args.in[15];
    F.w_o_nsa = args.in[16]; F.w_o_fox = args.in[17]; F.w_out = args.in[18]; F.w_rg = args.in[19]; F.b_rg = args.in[20]; F.w_re = args.in[21]; F.b_re = args.in[22];
    F.w_eg = args.in[23]; F.w_eu = args.in[24]; F.w_ed = args.in[25];
    for (int u = F.tid_(); u < 256; u += NWAVES * 64) F.MISC[u] = 0u;
    __syncthreads();
    const int lo = args.ph_lo, hi = args.ph_hi;
    XcdBarrier bar; bar.bar = F.ctl + CW_BAR; bar.x = 0; bar.st = nullptr;
    if (hi - lo > 1) bar = xcd_barrier_post(F.ctl + CW_BAR, F.MISC + 8);
#ifndef PH_MASK
#define PH_MASK 0x7ff
#endif
#define IN(k) (((PH_MASK >> (k)) & 1) && lo <= (k) && (k) < hi)
#ifndef DUP_MASK
#define DUP_MASK 0
#endif
#ifdef PROBE_TS
#define STAMP(k) do { if (blockIdx.x == 0 && F.tid_() == 0) ((unsigned long long*)(F.ctl + 8192))[(k)] = __builtin_amdgcn_s_memrealtime(); } while (0)
#else
#define STAMP(k) do { } while (0)
#endif
#define SEAM(k) do { if (IN(k) && IN((k) + 1)) xcd_barrier(bar); STAMP((k) + 1); } while (0)
#define NREP(k) (1 + ((DUP_MASK >> (k)) & 1))
#define REPBAR(rep) do { if (rep) xcd_barrier(bar); } while (0)
    bf16_t* const HN = (bf16_t*)(F.ws + WS_HN);
    bf16_t* const PROJ = (bf16_t*)(F.ws + WS_PROJ);
    STAMP(0);
    if (IN(0)) { for (int rep = 0; rep < NREP(0); ++rep) { REPBAR(rep); p0_prologue(F); } SEAM(0); }
    if (IN(1)) { for (int rep = 0; rep < NREP(1); ++rep) { REPBAR(rep); p0b_rows(F); } SEAM(1); }
    if (IN(2)) {
        pg8::Gemm g{HN, (const bf16_t*)(F.ws + WS_WINT), M, NPAD, DM}; pg8::StaticOrder S; S.init(M, NPAD, F.G, (int)blockIdx.x);
        EpiProj E{PROJ, (float*)(F.ws + WS_GATES), (float*)(F.ws + WS_LF), F.b_forget};
        for (int rep = 0; rep < NREP(2); ++rep) { REPBAR(rep); pg8::gemm_phase<false>(F.lds, g, S, E, pg8::NoGather{}); }
        SEAM(2);
    }
    if (IN(3)) {
        for (int rep = 0; rep < NREP(3); ++rep) { REPBAR(rep);
        for (int it = blockIdx.x; it < 144; it += F.G) { if (it < 128) p2a_item_cmp(F, it); else p2a_item_cumsum(F, it - 128); } }
        SEAM(3);
    }
    if (IN(4)) {
#ifndef ATT_DUP_KIND
#define ATT_DUP_KIND 3
#endif
        for (int rep = 0; rep < NREP(4); ++rep) { REPBAR(rep);
        for (;;) {
            __syncthreads();
            if (F.tid_() == 0) F.MISC[16] = __hip_atomic_fetch_add(F.ctl + CW_QCTR + 64 * rep, 1u, RLX_AGENT);
            __syncthreads();
            const int idx = (int)F.MISC[16];
            if (idx >= 1024) break;
            const int lev = 31 - (idx >> 5), w = idx & 31;
            if (w < 16) { if (rep == 0 || (ATT_DUP_KIND & 1)) {
#ifdef FOX_SIMPLE
                att::fox_unit(F, w >> 3, w & 7, lev);
#else
                const int fb = w >> 3, fh = w & 7;
                const foxb::bf16* pj = (const foxb::bf16*)(F.ws + WS_PROJ) + (size_t)fb * SEQ * PP + fh * 64;
                foxb::fox_unit<8>(lev, 0, pj + C_FQ, pj + C_FK, pj + C_FV, (const float*)(F.ws + WS_FB2) + (size_t)(fb * 8 + fh) * SEQ,
                                  (foxb::bf16*)(F.ws + WS_YY) + 512 + (size_t)fb * SEQ * 1024 + fh * 64, (char*)lds);
#endif
            } }
            else { const int k = w - 16; if (rep == 0 || (ATT_DUP_KIND & 2)) att::nsa_unit(F, (k & 3) >> 1, k & 1, 4 * lev + 3 - (k >> 2)); }
        } }
        SEAM(4);
    }
    if (IN(5)) {
        pg8::Gemm g{(const bf16_t*)(F.ws + WS_YY), (const bf16_t*)(F.ws + WS_WOT), M, DM, DM}; pg8::StaticOrder S; S.init(M, DM, F.G, (int)blockIdx.x);
        EpiOut E{HN, PROJ}; MidGate MG{PROJ};
        pg8::gemm_phase<false>(F.lds, g, S, E, pg8::NoGather{}, MG);
        SEAM(5);
    }
    if (IN(6)) {
        pg8::Gemm g{HN, (const bf16_t*)(F.ws + WS_WOUTT), M, DM, DM}; pg8::StaticOrder S; S.init(M, DM, F.G, (int)blockIdx.x);
        EpiBf E{(bf16_t*)(F.ws + WS_YY), DM};
        pg8::gemm_phase<false>(F.lds, g, S, E, pg8::NoGather{});
        for (int rep = 0; rep < NREP(6); ++rep) { REPBAR(rep); expert_convert(F); }
        SEAM(6);
    }
    if (IN(7)) { __syncthreads(); p3c_rows(F); SEAM(7); }
    if (IN(8) || IN(9)) {
        __syncthreads();
        if (F.tid_() < 32) F.MISC[96 + F.tid_()] = __hip_atomic_load(F.ctl + CW_ECNT + 64 * F.tid_(), RLX_AGENT);
        __syncthreads();
        if (F.tid_() == 0) { unsigned s = 0; for (int e = 0; e < 32; ++e) { F.MISC[32 + e] = s; s += (F.MISC[96 + e] + 255u) >> 8; } F.MISC[64] = s; }
        __syncthreads();
    }
    if (IN(8)) {
        pg8::Gemm g{HN, (const bf16_t*)(F.ws + WS_WGUT), M, 32768, DM}; MoeOrder S{F.MISC + 32, F.G, (int)blockIdx.x};
        EpiSwiglu E{(bf16_t*)(F.ws + WS_HBUF)}; MoeGather GT{(const u32x2*)(F.ws + WS_LIST), F.MISC + 32, F.MISC + 96};
        for (int rep = 0; rep < NREP(8); ++rep) { REPBAR(rep); pg8::gemm_phase<true>(F.lds, g, S, E, GT); }
        SEAM(8);
    }
    if (IN(9)) {
        pg8::Gemm g{(const bf16_t*)(F.ws + WS_HBUF), (const bf16_t*)(F.ws + WS_WDT), HROWS_MAX, 32768, DEXP}; MoeOrder S{F.MISC + 32, F.G, (int)blockIdx.x};
        EpiDown E{(bf16_t*)(F.ws + WS_YY), (const u32x2*)(F.ws + WS_LIST), F.MISC + 32, F.MISC + 96};
        for (int rep = 0; rep < NREP(9); ++rep) { REPBAR(rep); pg8::gemm_phase<false>(F.lds, g, S, E, pg8::NoGather{}); }
        SEAM(9);
    }
    if (IN(10)) { p5_rows(F); }
#undef IN
#undef SEAM
}

extern "C" void kernel_launch(void* const* d_in, const int* in_sizes, int n_in, void* d_out, int out_size, void* d_ws, size_t ws_size, hipStream_t stream) {
    static int grid = 0;
    if (grid == 0) {
        if (n_in != 26 || in_sizes[0] != M * DM || out_size != M * DM || ws_size < WS_END) { fprintf(stderr, "kernel_launch: unexpected shapes (n_in %d, in0 %d, out %d, ws %zu < %zu); nothing launched\n", n_in, n_in > 0 ? in_sizes[0] : -1, out_size, ws_size, (size_t)WS_END); grid = -1; return; }
        int dev = 0, cus = 0, per_cu = 0;
        if (hipGetDevice(&dev) != hipSuccess || hipDeviceGetAttribute(&cus, hipDeviceAttributeMultiprocessorCount, dev) != hipSuccess) { grid = -1; return; }
        if (hipFuncSetAttribute((const void*)fwd_kernel, hipFuncAttributeMaxDynamicSharedMemorySize, LDS_BYTES) != hipSuccess) { fprintf(stderr, "kernel_launch: hipFuncSetAttribute failed\n"); grid = -1; return; }
        if (hipOccupancyMaxActiveBlocksPerMultiprocessor(&per_cu, (const void*)fwd_kernel, NWAVES * 64, LDS_BYTES) != hipSuccess || per_cu < 1) { fprintf(stderr, "kernel_launch: occupancy query failed (%d)\n", per_cu); per_cu = 1; }
        (void)hipGetLastError();
        grid = cus * (per_cu > 1 ? 1 : per_cu);
        if (grid < 128 || grid > 256) { fprintf(stderr, "kernel_launch: built for 128..256 workgroups, got %d; nothing launched\n", grid); grid = -1; return; }
    }
    if (grid < 0) return;
    if (hipMemsetAsync((char*)d_ws + WS_CTL, 0, CTL_ZERO_BYTES, stream) != hipSuccess) { fprintf(stderr, "kernel_launch: memset failed\n"); return; }
    Args a{};
    for (int i = 0; i < 26; ++i) a.in[i] = (const float*)d_in[i];
    a.out = (float*)d_out; a.ws = (unsigned char*)d_ws;
#if MK_N_LAUNCHES == 1
    a.ph_lo = 0; a.ph_hi = N_PHASES;
    void* kargs[] = {&a};
    const hipError_t le = hipLaunchCooperativeKernel((const void*)fwd_kernel, dim3(grid), dim3(NWAVES * 64), kargs, LDS_BYTES, stream);
    if (le != hipSuccess) fprintf(stderr, "kernel_launch: cooperative launch failed: %s (grid %d)\n", hipGetErrorName(le), grid);
#else
    for (int p = 0; p < N_PHASES; ++p) {
        a.ph_lo = p; a.ph_hi = p + 1;
        hipLaunchKernelGGL(fwd_kernel, dim3(grid), dim3(NWAVES * 64), LDS_BYTES, stream, a);
    }
    const hipError_t le = hipPeekAtLastError();
    if (le != hipSuccess) fprintf(stderr, "kernel_launch: launch failed: %s\n", hipGetErrorName(le));
#endif
}
```

```cpp
#include <hip/hip_runtime.h>
#include <hip/hip_bf16.h>
#include <cstdio>
#include <cstdint>
#include <cmath>

#define LAS __attribute__((address_space(3)))
#define GAS __attribute__((address_space(1)))
typedef unsigned short bf16_t;
typedef short bf16x8 __attribute__((ext_vector_type(8)));
typedef short s16x4 __attribute__((ext_vector_type(4)));
typedef float f32x4 __attribute__((ext_vector_type(4)));
typedef float f32x2 __attribute__((ext_vector_type(2)));
typedef float f32x16 __attribute__((ext_vector_type(16)));
typedef unsigned u32x4 __attribute__((ext_vector_type(4)));
typedef unsigned u32x2 __attribute__((ext_vector_type(2)));
typedef __bf16 bf16x2_t __attribute__((ext_vector_type(2)));

__device__ __forceinline__ unsigned cvtpk(float lo, float hi) { f32x2 v = {lo, hi}; bf16x2_t b = __builtin_convertvector(v, bf16x2_t); return __builtin_bit_cast(unsigned, b); }
__device__ __forceinline__ float bf2f(unsigned short h) { return __uint_as_float(((unsigned)h) << 16); }
__device__ __forceinline__ float bflo(unsigned w) { return __uint_as_float(w << 16); }
__device__ __forceinline__ float bfhi(unsigned w) { return __uint_as_float(w & 0xffff0000u); }
__device__ __forceinline__ float sigmoidf_(float x) { return 1.0f / (1.0f + __expf(-x)); }

namespace pg8 {
constexpr int BM = 256, BK = 64, HALF = 128, HTB = HALF * BK * 2  , STAGE_BYTES = 8 * HTB, NXCD = 8, WGM = 8;

__host__ __device__ __forceinline__ int lds_byte(int r, int c) { const int st = (r >> 4) * 2 + (c >> 5), rr = r & 15, cc = c & 31, ob = rr * 64 + cc * 2; return st * 1024 + (ob ^ (((ob >> 9) & 1) << 5)); }
__host__ __device__ __forceinline__ void stage_rc(int b, int& R, int& C) { const int st = b / 1024, sb = b % 1024, swz = sb ^ (((sb >> 9) & 1) << 5); R = (st >> 1) * 16 + swz / 64; C = (st & 1) * 32 + (swz % 64) / 2; }
__host__ __device__ __forceinline__ int perm32(int rho) { const int n = rho >> 4, i = rho & 15; return 8 * (i >> 2) + 4 * n + (i & 3); }

struct Unit { int pm, pn; };
struct Gemm { const bf16_t* A; const bf16_t* Bt; int M, N, K; };

struct StaticOrder {
    int nM, nN, nwg, G, c;
    __host__ __device__ void init(int M, int N, int G_, int c_) { nM = M / BM; nN = N / BM; nwg = nM * nN; G = G_; c = c_; }
    __host__ __device__ bool next(int i, Unit& u) const {
        const long L = (long)i * G + c; if (L >= nwg) return false;
        int wgid = (int)L; { const int q = nwg / NXCD, r = nwg % NXCD, xcd = wgid % NXCD, off = wgid / NXCD; wgid = (xcd < r ? xcd * (q + 1) : r * (q + 1) + (xcd - r) * q) + off; }
        const int nig = WGM * nN, gid = wgid / nig, fm = gid * WGM, gsz = (nM - fm) < WGM ? (nM - fm) : WGM;
        u.pm = fm + ((wgid % nig) % gsz); u.pn = (wgid % nig) / gsz; return true;
    }
};
struct NoGather { __device__ __forceinline__ int row(const Unit&, int) const { return 0; } };
struct NoMid { static constexpr bool ENABLED = false; __device__ __forceinline__ void operator()(f32x4 (&)[2][2][4][2], const Unit&, int, int, int, int) const {} };

template <bool GATHER, class Epi, class Sched, class Gath, class Mid = NoMid>
__device__ __forceinline__ void gemm_phase(LAS unsigned char* lds, const Gemm g, const Sched& S, const Epi& E, const Gath& GT, const Mid& MD = Mid{}) {
    const int tid = threadIdx.x, wid = __builtin_amdgcn_readfirstlane(tid >> 6), lane = tid & 63, wr = wid >> 2, wc = wid & 3, fr = lane & 15, fq = lane >> 4;
    const int K = g.K, nt = K / BK;
    unsigned voffA[2], voffB[2];
#pragma unroll
    for (int i = 0; i < 2; ++i) { int R, C; stage_rc(tid * 16 + i * 8192, R, C); const int Rb = (R & ~31) + perm32(R & 31);
        voffA[i] = (unsigned)(R * K + C) * 2u; voffB[i] = (unsigned)(Rb * K + C) * 2u; }
    const size_t kstep = (size_t)(BK * 2);
    const size_t hstep = (size_t)HALF * K * 2;
    const size_t tstep = 2 * hstep;
    const unsigned ldsw = (unsigned)wid * 1024u;
    const int aoff = lds_byte(wr * 64 + fr, fq * 8), boff = lds_byte(wc * 32 + fr, fq * 8);
#define PG8_SA(b, h) (((b) * 2 + (h)) * HTB)
#define PG8_SB(b, h) ((4 + (b) * 2 + (h)) * HTB)
#define PG8_STG2(bufoff, gbase, o0, o1) do { \
        __builtin_amdgcn_global_load_lds((const unsigned*)((const char*)(gbase) + (o0)), (LAS unsigned*)(lds + (bufoff) + ldsw), 16, 0, 0); \
        __builtin_amdgcn_global_load_lds((const unsigned*)((const char*)(gbase) + (o1)), (LAS unsigned*)(lds + (bufoff) + ldsw + 8192), 16, 0, 0); } while (0)
#define PG8_STAGE(bufoff, gbase, voff) PG8_STG2(bufoff, gbase, (voff)[0], (voff)[1])
#define PG8_STAGE_A(bufoff, h, kt, NX) do { if constexpr (GATHER) { const char* _b = (const char*)g.A + (size_t)(kt) * kstep; \
            const u32x2 _o = *(const LAS u32x2*)(gtab + ((NX) ? 4 : 0) + (h) * 2); PG8_STG2(bufoff, _b, _o.x, _o.y); } \
        else { const char* _b = ((NX) ? nA : cA) + (size_t)(h) * hstep + (size_t)(kt) * kstep; PG8_STG2(bufoff, _b, voffA[0], voffA[1]); } } while (0)
#define PG8_GOFF(U, s) do { _Pragma("unroll") for (int _h = 0; _h < 2; ++_h) _Pragma("unroll") for (int _i = 0; _i < 2; ++_i) { int _R, _C; stage_rc(tid * 16 + _i * 8192, _R, _C); \
            gtab[(s) * 4 + _h * 2 + _i] = (unsigned)(GT.row(U, _h * HALF + _R) * K + _C) * 2u; } } while (0)
#define PG8_LDA(dst, b, h) do { _Pragma("unroll") for (int m = 0; m < 4; ++m) _Pragma("unroll") for (int k = 0; k < 2; ++k) dst[m][k] = *(const LAS bf16x8*)(lds + PG8_SA(b, h) + aoff + m * 2048 + k * 1024); } while (0)
#define PG8_LDB(dst, b, h) do { _Pragma("unroll") for (int n = 0; n < 2; ++n) _Pragma("unroll") for (int k = 0; k < 2; ++k) dst[n][k] = *(const LAS bf16x8*)(lds + PG8_SB(b, h) + boff + n * 2048 + k * 1024); } while (0)
#define PG8_MMA(ai, bj, At, Bt) do { __builtin_amdgcn_s_setprio(1); _Pragma("unroll") for (int m = 0; m < 4; ++m) _Pragma("unroll") for (int n = 0; n < 2; ++n) _Pragma("unroll") for (int k = 0; k < 2; ++k) \
        acc[ai][bj][m][n] = __builtin_amdgcn_mfma_f32_16x16x32_bf16(Bt[n][k], At[m][k], acc[ai][bj][m][n], 0, 0, 0); __builtin_amdgcn_s_setprio(0); } while (0)
#define PG8_WAIT_V(n) asm volatile("s_waitcnt vmcnt(" #n ")" ::: "memory")
#define PG8_WAIT_L(n) asm volatile("s_waitcnt lgkmcnt(" #n ")" ::: "memory")
#define PG8_BAR __builtin_amdgcn_s_barrier()
#define PG8_SCHED __builtin_amdgcn_sched_barrier(0)
    Unit cur, nxt; int ui = 0;
    if (!S.next(0, cur)) return;
    f32x4 acc[2][2][4][2];
#pragma unroll
    for (int a = 0; a < 2; ++a)
#pragma unroll
        for (int b = 0; b < 2; ++b)
#pragma unroll
            for (int m = 0; m < 4; ++m)
#pragma unroll
                for (int n = 0; n < 2; ++n) acc[a][b][m][n] = (f32x4){0.f, 0.f, 0.f, 0.f};
    bf16x8 At[4][2], B0[2][2], B1[2][2];
    LAS unsigned* const gtab = (LAS unsigned*)(lds + STAGE_BYTES) + tid * 8;
    const char* cA = (const char*)g.A + (size_t)cur.pm * tstep; const char* cB = (const char*)g.Bt + (size_t)cur.pn * tstep;
    const char* nA = cA;
    if constexpr (GATHER) { PG8_GOFF(cur, 0); }
    PG8_STAGE(PG8_SB(0, 0), cB, voffB); PG8_STAGE(PG8_SB(0, 1), cB + hstep, voffB); PG8_STAGE_A(PG8_SA(0, 0), 0, 0, false); PG8_STAGE_A(PG8_SA(0, 1), 1, 0, false);
    if (wr == 1) PG8_BAR;
    PG8_WAIT_V(2); PG8_BAR;
    PG8_STAGE(PG8_SB(1, 0), cB + kstep, voffB); PG8_STAGE_A(PG8_SA(1, 0), 0, 1, false); PG8_STAGE(PG8_SB(1, 1), cB + hstep + kstep, voffB);
    PG8_WAIT_V(6); PG8_BAR;
    for (;;) {
        const bool has_next = S.next(ui + 1, nxt);
        nA = has_next ? (const char*)g.A + (size_t)nxt.pm * tstep : cA; const char* nB = has_next ? (const char*)g.Bt + (size_t)nxt.pn * tstep : cB;
        if constexpr (GATHER) { if (has_next) PG8_GOFF(nxt, 1); else { *(LAS u32x4*)(gtab + 4) = *(const LAS u32x4*)gtab; } }
        for (int t = 0; t < nt; t += 2) {
            const bool last = (t == nt - 2);
            const char* b2 = last ? nB : cB + (size_t)(t + 2) * kstep;
            const char* b3 = b2 + kstep;
            const int k2 = last ? 0 : t + 2, k3 = k2 + 1;
            PG8_LDB(B0, 0, 0); PG8_LDB(B1, 0, 1); PG8_SCHED; PG8_LDA(At, 0, 0); PG8_STAGE_A(PG8_SA(1, 1), 1, t + 1, false);
            PG8_WAIT_V(8); PG8_WAIT_L(0); PG8_BAR; PG8_MMA(0, 0, At, B0); PG8_MMA(0, 1, At, B1); PG8_BAR; PG8_SCHED;
            PG8_LDA(At, 0, 1); PG8_STAGE(PG8_SB(0, 0), b2, voffB); PG8_STAGE(PG8_SB(0, 1), b2 + hstep, voffB);
            if (last) PG8_STAGE_A(PG8_SA(0, 0), 0, k2, true); else PG8_STAGE_A(PG8_SA(0, 0), 0, k2, false);
            PG8_WAIT_V(8); PG8_WAIT_L(0); PG8_BAR; PG8_MMA(1, 0, At, B0); PG8_MMA(1, 1, At, B1); PG8_BAR; PG8_SCHED;
            PG8_LDB(B0, 1, 0); PG8_LDB(B1, 1, 1); PG8_SCHED; PG8_LDA(At, 1, 0);
            if (last) PG8_STAGE_A(PG8_SA(0, 1), 1, k2, true); else PG8_STAGE_A(PG8_SA(0, 1), 1, k2, false);
            PG8_WAIT_V(8); PG8_WAIT_L(0); PG8_BAR; PG8_MMA(0, 0, At, B0); PG8_MMA(0, 1, At, B1); PG8_BAR; PG8_SCHED;
            PG8_LDA(At, 1, 1); PG8_STAGE(PG8_SB(1, 0), b3, voffB); PG8_STAGE(PG8_SB(1, 1), b3 + hstep, voffB);
            if (last) PG8_STAGE_A(PG8_SA(1, 0), 0, k3, true); else PG8_STAGE_A(PG8_SA(1, 0), 0, k3, false);
            PG8_WAIT_V(8); PG8_WAIT_L(0); PG8_BAR; PG8_MMA(1, 0, At, B0); PG8_MMA(1, 1, At, B1); PG8_BAR; PG8_SCHED;
            if constexpr (Mid::ENABLED) { if (t + 2 == nt / 2) MD(acc, cur, wr, wc, fr, fq); }
        }
        if (wr == 0) PG8_BAR;
        E(acc, cur, wr, wc, fr, fq);
        if (!has_next) break;
#pragma unroll
        for (int a = 0; a < 2; ++a)
#pragma unroll
            for (int b = 0; b < 2; ++b)
#pragma unroll
                for (int m = 0; m < 4; ++m)
#pragma unroll
                    for (int n = 0; n < 2; ++n) acc[a][b][m][n] = (f32x4){0.f, 0.f, 0.f, 0.f};
        cur = nxt; cA = nA; cB = nB; ++ui;
        if constexpr (GATHER) { *(LAS u32x4*)gtab = *(const LAS u32x4*)(gtab + 4); }
        if (wr == 1) PG8_BAR;
    }
    PG8_WAIT_V(0);
    PG8_BAR;
#undef PG8_SA
#undef PG8_SB
#undef PG8_STG2
#undef PG8_STAGE
#undef PG8_STAGE_A
#undef PG8_GOFF
#undef PG8_LDA
#undef PG8_LDB
#undef PG8_MMA
#undef PG8_WAIT_V
#undef PG8_WAIT_L
#undef PG8_BAR
#undef PG8_SCHED
}
}
constexpr int NWAVES = 8;
constexpr int BATCH = 2, SEQ = 8192, DM = 1024, M = BATCH * SEQ;
constexpr int DIN = 4896, PP = 4864  , NPAD = 5120  ;
constexpr int C_QA = 0, C_KCMP = 512, C_VCMP = 640, C_KSLC = 768, C_VSLC = 896, C_KWIN = 1024, C_VWIN = 1152, C_FQ = 1280, C_FK = 1792, C_FV = 2304, C_MG = 2816;
constexpr float LOG2E = 1.4426950408889634f;
constexpr float C2 = 0.125f * LOG2E;
constexpr float NORM_EPS = 1e-6f;
constexpr float NEGF = -1e30f;
constexpr int NEXP = 32, DEXP = 512;
constexpr int HROWS_MAX = 2 * M + NEXP * 256;

constexpr size_t MiB = 1u << 20;
constexpr size_t WS_CTL = 0, CTL_ZERO_BYTES = 1 * MiB;
constexpr size_t WS_MODP = 1 * MiB;
constexpr size_t WS_MOD = WS_MODP + 512 * 1024;
constexpr size_t WS_PEB = WS_MOD + 64 * 1024;
constexpr size_t WS_W1T = WS_PEB + 64 * 1024;
constexpr size_t WS_KC = WS_W1T + 512 * 1024;
constexpr size_t WS_VC = WS_KC + 256 * 1024;
constexpr size_t WS_FB2 = WS_VC + 256 * 1024;
constexpr size_t WS_LF = WS_FB2 + 512 * 1024;
constexpr size_t WS_GATES = WS_LF + 512 * 1024;
constexpr size_t WS_ROUTE = WS_GATES + 1536 * 1024;
constexpr size_t WS_LIST = 6 * MiB;
constexpr size_t WS_WINT = 10 * MiB;
constexpr size_t WS_WOT = 20 * MiB;
constexpr size_t WS_WOUTT = 22 * MiB;
constexpr size_t WS_HN = 24 * MiB;
constexpr size_t WS_PROJ = 56 * MiB;
constexpr size_t WS_WGUT = WS_PROJ;
constexpr size_t WS_WDT = WS_PROJ + 64 * MiB;
constexpr size_t WS_HBUF = WS_PROJ + 96 * MiB;
constexpr size_t WS_YY = 208 * MiB;
constexpr size_t WS_END = 272 * MiB;
static_assert(WS_ROUTE + 64 * 1024 <= WS_LIST && WS_LIST + 4 * MiB <= WS_WINT && WS_HBUF + (size_t)HROWS_MAX * 1024 <= WS_YY, "d_ws map");
constexpr int CW_QCTR = 64;
constexpr int CW_ECNT = 128;
constexpr int CW_BAR = 4096;

constexpr int RING_BYTES = 131072;
constexpr int LDS_BYTES = 163840;
constexpr int MISC_OFF = 160 * 1024 - 1024;

#define RLX_AGENT __ATOMIC_RELAXED, __HIP_MEMORY_SCOPE_AGENT
#define LDS_WAIT() asm volatile("s_waitcnt lgkmcnt(0)" ::: "memory")
#define VM_WAIT() asm volatile("s_waitcnt vmcnt(0)" ::: "memory")

#define XB_TMO      128
#define XB_XCNT(j)  (256  + 64 * (j))
#define XB_XSUB(j)  (1280 + 64 * (j))
#define XB_XGEN(j)  (2304 + 64 * (j))
#define XB_TOP      3328
#define XB_TOPGEN   3392
#define XCD_BAR_WORDS 3456
#define XB_SPIN_CAP (1u << 22)
__device__ __forceinline__ unsigned xb_ld(unsigned* p)              { return __hip_atomic_load(p, __ATOMIC_RELAXED, __HIP_MEMORY_SCOPE_AGENT); }
__device__ __forceinline__ unsigned xb_add(unsigned* p, unsigned v) { return __hip_atomic_fetch_add(p, v, __ATOMIC_RELAXED, __HIP_MEMORY_SCOPE_AGENT); }
__device__ __forceinline__ unsigned xb_xcc_id() { return (unsigned)__builtin_amdgcn_s_getreg((3 << 11) | 20) & 0xFu; }
#define XB_SPIN(cond, bar) do { unsigned _sp = 0; while (cond) { __builtin_amdgcn_s_sleep(1); \
    if ((++_sp & 255u) == 0u) { if (xb_ld(&(bar)[XB_TMO])) break; if (_sp > XB_SPIN_CAP) { atomicAdd(&(bar)[XB_TMO], 1u); break; } } } } while (0)
struct XcdBarrier { unsigned* bar; unsigned x; volatile LAS unsigned* st; };
__device__ __forceinline__ XcdBarrier xcd_barrier_post(unsigned* bar, volatile LAS unsigned* st) {
    XcdBarrier b; b.bar = bar; b.x = xb_xcc_id(); b.st = st;
    if (threadIdx.x == 0) (void)xb_add(&bar[XB_XCNT(b.x)], 1u);
    return b;
}
__device__ __forceinline__ void xcd_barrier_complete(unsigned* bar, unsigned x, unsigned& nloc, unsigned& nx) {
    const unsigned G = gridDim.x * gridDim.y * gridDim.z;
    unsigned sum, cnt, mine, sp = 0u;
    for (;;) {
        sum = 0u; cnt = 0u; mine = 0u;
#pragma unroll
        for (unsigned j = 0; j < 16; ++j) { const unsigned c = xb_ld(&bar[XB_XCNT(j)]); sum += c; cnt += (c > 0u) ? 1u : 0u; mine = (j == x) ? c : mine; }
        if (sum == G) break;
        __builtin_amdgcn_s_sleep(1);
        if ((++sp & 255u) == 0u) { if (xb_ld(&bar[XB_TMO])) break; if (sp > XB_SPIN_CAP) { atomicAdd(&bar[XB_TMO], 1u); break; } }
    }
    nloc = mine > 0u ? mine : 1u; nx = cnt > 0u ? cnt : 1u;
}
__device__ __forceinline__ void xcd_barrier(const XcdBarrier& b) {
    asm volatile("s_waitcnt vmcnt(0)" ::: "memory");
    __syncthreads();
    if (threadIdx.x == 0) {
        unsigned* bar = b.bar;
        __builtin_amdgcn_s_waitcnt(0);
        unsigned nloc = b.st[0], nx = b.st[1];
        if (nloc == 0u) { xcd_barrier_complete(bar, b.x, nloc, nx); b.st[0] = nloc; b.st[1] = nx; }
        const unsigned old = xb_add(&bar[XB_XSUB(b.x)], 1u);
        const unsigned gen = old / nloc;
        if (old + 1u == (gen + 1u) * nloc) {
            __builtin_amdgcn_fence(__ATOMIC_RELEASE, "agent");
            asm volatile("s_waitcnt vmcnt(0)" ::: "memory");
            const unsigned og = xb_add(&bar[XB_TOP], 1u);
            const unsigned tg = og / nx;
            if (og + 1u == (tg + 1u) * nx) xb_add(&bar[XB_TOPGEN], 1u);
            else XB_SPIN(xb_ld(&bar[XB_TOPGEN]) == tg, bar);
            __builtin_amdgcn_fence(__ATOMIC_ACQUIRE, "agent");
            xb_add(&bar[XB_XGEN(b.x)], 1u);
            asm volatile("s_waitcnt vmcnt(0)" ::: "memory");
        } else {
            XB_SPIN(xb_ld(&bar[XB_XGEN(b.x)]) == gen, bar);
            __builtin_amdgcn_fence(__ATOMIC_ACQUIRE, "agent");
            asm volatile("s_waitcnt vmcnt(0)" ::: "memory");
        }
    }
    __syncthreads();
}

struct Frame {
    LAS unsigned char* lds;
    volatile LAS unsigned* MISC;
    unsigned* ctl;
    int wave, G;
    __device__ __forceinline__ int tid_() const { return (int)threadIdx.x; }
    __device__ __forceinline__ int lane_() const { return (int)(threadIdx.x & 63u); }
    const float *x, *c, *w_ada, *b_ada, *g_pre_mix, *g_post_mix, *g_pre_ffn, *g_post_ffn, *w_in, *b_forget;
    const float *pe_k, *w1_k, *w2_k, *pe_v, *w1_v, *w2_v, *w_o_nsa, *w_o_fox, *w_out, *w_rg, *b_rg, *w_re, *b_re, *w_eg, *w_eu, *w_ed;
    float* out;
    unsigned char* ws;
};

__device__ __forceinline__ float wave_sum(float v) {
#pragma unroll
    for (int o = 1; o < 64; o <<= 1) v += __shfl_xor(v, o);
    return v;
}

#define EPI_LOOP_BEGIN _Pragma("unroll") for (int ai = 0; ai < 2; ++ai) _Pragma("unroll") for (int m = 0; m < 4; ++m) { const int rin = ai * 128 + wr * 64 + m * 16 + fr; (void)rin;
#define EPI_LOOP_END }

struct EpiProj {
    bf16_t* P; float* gates; float* lf; const float* b_forget;
    __device__ __forceinline__ void operator()(const f32x4 (&acc)[2][2][4][2], const pg8::Unit& u, int wr, int wc, int fr, int fq) const {
        const int pn = u.pn;
        if (pn < 19) {
            const int mode = (pn < 2 || pn == 5 || pn == 6) ? 1 : (pn >= 11 ? 2 : 0);
            EPI_LOOP_BEGIN
                bf16_t* rowp = P + (size_t)(u.pm * 256 + rin) * PP + pn * 256 + wc * 32 + 8 * fq;
#pragma unroll
                for (int bj = 0; bj < 2; ++bj) { f32x4 v0 = acc[ai][bj][m][0], v1 = acc[ai][bj][m][1];
                    if (mode == 1) { v0 = v0 * C2; v1 = v1 * C2; }
                    else if (mode == 2) {
#pragma unroll
                        for (int i = 0; i < 4; ++i) { v0[i] = sigmoidf_(v0[i]); v1[i] = sigmoidf_(v1[i]); } }
                    u32x4 w; w.x = cvtpk(v0[0], v0[1]); w.y = cvtpk(v0[2], v0[3]); w.z = cvtpk(v1[0], v1[1]); w.w = cvtpk(v1[2], v1[3]);
                    *(u32x4*)(rowp + bj * 128) = w; }
            EPI_LOOP_END
        } else {
            if (wc == 0) {
                EPI_LOOP_BEGIN
                    const int row = u.pm * 256 + rin; const f32x4 v0 = acc[ai][0][m][0], v1 = acc[ai][0][m][1];
                    if (fq < 3) { f32x4 a, b;
#pragma unroll
                        for (int i = 0; i < 4; ++i) { a[i] = sigmoidf_(v0[i]); b[i] = sigmoidf_(v1[i]); }
                        *(f32x4*)(gates + (size_t)row * 24 + 8 * fq) = a; *(f32x4*)(gates + (size_t)row * 24 + 8 * fq + 4) = b; }
                    else { f32x4 a, b;
#pragma unroll
                        for (int i = 0; i < 4; ++i) { const float xa = v0[i] + b_forget[i], xb = v1[i] + b_forget[4 + i];
                            a[i] = fminf(xa, 0.f) - log1pf(__expf(-fabsf(xa))); b[i] = fminf(xb, 0.f) - log1pf(__expf(-fabsf(xb))); }
                        *(f32x4*)(lf + (size_t)row * 8) = a; *(f32x4*)(lf + (size_t)row * 8 + 4) = b; }
                EPI_LOOP_END
            }
        }
    }
};
struct MidGate {
    static constexpr bool ENABLED = true; const bf16_t* P;
    __device__ __forceinline__ void operator()(f32x4 (&acc)[2][2][4][2], const pg8::Unit& u, int wr, int wc, int fr, int fq) const {
        EPI_LOOP_BEGIN
            const bf16_t* gp = P + (size_t)(u.pm * 256 + rin) * PP + C_MG + u.pn * 256 + wc * 32 + 8 * fq;
#pragma unroll
            for (int bj = 0; bj < 2; ++bj) { const u32x4 ga = *(const u32x4*)(gp + bj * 128), gb = *(const u32x4*)(gp + 1024 + bj * 128);
                const f32x4 r0 = {bflo(ga.x) / bflo(gb.x), bfhi(ga.x) / bfhi(gb.x), bflo(ga.y) / bflo(gb.y), bfhi(ga.y) / bfhi(gb.y)};
                const f32x4 r1 = {bflo(ga.z) / bflo(gb.z), bfhi(ga.z) / bfhi(gb.z), bflo(ga.w) / bflo(gb.w), bfhi(ga.w) / bfhi(gb.w)};
                acc[ai][bj][m][0] *= r0; acc[ai][bj][m][1] *= r1; }
            asm volatile("" ::: "memory");
        EPI_LOOP_END
    }
};
struct EpiOut {
    bf16_t* U; const bf16_t* P;
    __device__ __forceinline__ void operator()(const f32x4 (&acc)[2][2][4][2], const pg8::Unit& u, int wr, int wc, int fr, int fq) const {
        EPI_LOOP_BEGIN
            const size_t row = (size_t)(u.pm * 256 + rin); const int col = u.pn * 256 + wc * 32 + 8 * fq;
#pragma unroll
            for (int bj = 0; bj < 2; ++bj) { const f32x4 v0 = acc[ai][bj][m][0], v1 = acc[ai][bj][m][1];
                const u32x4 gw = *(const u32x4*)(P + row * PP + C_MG + 1024 + col + bj * 128);
                u32x4 w; w.x = cvtpk(v0[0] * bflo(gw.x), v0[1] * bfhi(gw.x)); w.y = cvtpk(v0[2] * bflo(gw.y), v0[3] * bfhi(gw.y));
                w.z = cvtpk(v1[0] * bflo(gw.z), v1[1] * bfhi(gw.z)); w.w = cvtpk(v1[2] * bflo(gw.w), v1[3] * bfhi(gw.w));
                *(u32x4*)(U + row * DM + col + bj * 128) = w; }
            asm volatile("" ::: "memory");
        EPI_LOOP_END
    }
};
struct EpiBf {
    bf16_t* O; int ldc;
    __device__ __forceinline__ void operator()(const f32x4 (&acc)[2][2][4][2], const pg8::Unit& u, int wr, int wc, int fr, int fq) const {
        EPI_LOOP_BEGIN
            bf16_t* rowp = O + (size_t)(u.pm * 256 + rin) * ldc + u.pn * 256 + wc * 32 + 8 * fq;
#pragma unroll
            for (int bj = 0; bj < 2; ++bj) { const f32x4 v0 = acc[ai][bj][m][0], v1 = acc[ai][bj][m][1];
                u32x4 w; w.x = cvtpk(v0[0], v0[1]); w.y = cvtpk(v0[2], v0[3]); w.z = cvtpk(v1[0], v1[1]); w.w = cvtpk(v1[2], v1[3]);
                *(u32x4*)(rowp + bj * 128) = w; }
        EPI_LOOP_END
    }
};
struct EpiSwiglu {
    bf16_t* H;
    __device__ __forceinline__ void operator()(const f32x4 (&acc)[2][2][4][2], const pg8::Unit& u, int wr, int wc, int fr, int fq) const {
        EPI_LOOP_BEGIN
            bf16_t* hp = H + (size_t)(u.pm * 256 + rin) * DEXP + (u.pn & 3) * 128 + wc * 32 + 8 * fq;
            float r[8];
#pragma unroll
            for (int i = 0; i < 4; ++i) { const float g0 = acc[ai][0][m][0][i], g1 = acc[ai][0][m][1][i];
                r[i] = g0 * sigmoidf_(g0) * acc[ai][1][m][0][i]; r[4 + i] = g1 * sigmoidf_(g1) * acc[ai][1][m][1][i]; }
            u32x4 w; w.x = cvtpk(r[0], r[1]); w.y = cvtpk(r[2], r[3]); w.z = cvtpk(r[4], r[5]); w.w = cvtpk(r[6], r[7]);
            *(u32x4*)hp = w;
        EPI_LOOP_END
    }
};
struct EpiDown {
    bf16_t* Y2; const u32x2* list; volatile LAS unsigned* tstart; volatile LAS unsigned* ecnt;
    __device__ __forceinline__ void operator()(const f32x4 (&acc)[2][2][4][2], const pg8::Unit& u, int wr, int wc, int fr, int fq) const {
        const int e = u.pn >> 2, rt = u.pm - (int)tstart[e], cnt = (int)ecnt[e];
        EPI_LOOP_BEGIN
            const int rank = rt * 256 + rin;
            if (rank < cnt) { const u32x2 ent = list[(size_t)e * M + rank]; const float w = __uint_as_float(ent.y);
                bf16_t* yp = Y2 + (size_t)ent.x * DM + (u.pn & 3) * 256 + wc * 32 + 8 * fq;
#pragma unroll
                for (int bj = 0; bj < 2; ++bj) { const f32x4 v0 = acc[ai][bj][m][0] * w, v1 = acc[ai][bj][m][1] * w;
                    u32x4 o; o.x = cvtpk(v0[0], v0[1]); o.y = cvtpk(v0[2], v0[3]); o.z = cvtpk(v1[0], v1[1]); o.w = cvtpk(v1[2], v1[3]);
                    *(u32x4*)(yp + bj * 128) = o; } }
        EPI_LOOP_END
    }
};
struct MoeOrder {
    volatile LAS unsigned* tstart; int G, c;
    __device__ bool next(int i, pg8::Unit& u) const {
        const int L = i * G + c; const int NT = (int)tstart[32];
        if (L >= 4 * NT) return false;
        int e = 0;
        for (int k = 1; k < 32; ++k) if (L >= 4 * (int)tstart[k]) e = k;
        const int ts = (int)tstart[e], nte = (int)tstart[e + 1] - ts, rem = L - 4 * ts;
        const int j = rem / nte, rt = rem - j * nte;
        u.pm = ts + rt; u.pn = e * 4 + j; return true;
    }
};
struct MoeGather {
    const u32x2* list; volatile LAS unsigned* tstart; volatile LAS unsigned* ecnt;
    __device__ __forceinline__ int row(const pg8::Unit& u, int r) const {
        const int e = u.pn >> 2, rank = (u.pm - (int)tstart[e]) * 256 + r;
        if (rank >= (int)ecnt[e]) return 0;
        return (int)(list[(size_t)e * M + rank].x >> 1);
    }
};
constexpr int TR_SCR = 64 * 65 * 4;
template <class MapF>
__device__ __forceinline__ void tr_item(const float* __restrict__ W, int N, bf16_t* WT, int ldwt, MapF map, LAS float* scr, int kb, int nb, int lane) {
    const int k0 = 64 * kb, n0 = 64 * nb, c4 = 4 * (lane & 15);
    f32x4 v[16];
    const bool okc = (n0 + c4) < N;
#pragma unroll
    for (int i = 0; i < 16; ++i) { const int k = 4 * i + (lane >> 4); v[i] = okc ? *(const f32x4*)(W + (size_t)(k0 + k) * N + n0 + c4) : (f32x4){0.f, 0.f, 0.f, 0.f}; }
#pragma unroll
    for (int i = 0; i < 16; ++i) { const int k = 4 * i + (lane >> 4); LAS float* s = scr + k * 65 + c4; s[0] = v[i][0]; s[1] = v[i][1]; s[2] = v[i][2]; s[3] = v[i][3]; }
    LDS_WAIT(); asm volatile("" ::: "memory");
    const int c = lane & 7;
#pragma unroll
    for (int jj = 0; jj < 8; ++jj) { const int n = (lane >> 3) + 8 * jj; const LAS float* s = scr + (8 * c) * 65 + n;
        u32x4 o; o.x = cvtpk(s[0 * 65], s[1 * 65]); o.y = cvtpk(s[2 * 65], s[3 * 65]); o.z = cvtpk(s[4 * 65], s[5 * 65]); o.w = cvtpk(s[6 * 65], s[7 * 65]);
        if (n0 + n < N) *(u32x4*)(WT + (size_t)map(n0 + n) * ldwt + k0 + 8 * c) = o; }
    LDS_WAIT(); asm volatile("" ::: "memory");
}
struct MapId { int off; __device__ __forceinline__ int operator()(int n) const { return off + n; } };
struct MapWin { __device__ __forceinline__ int operator()(int n) const {
    if (n < 1280) return n; if (n < 1304) return 4864 + (n - 1280); if (n < 2840) return 1280 + (n - 1304); if (n < 2848) return 4888 + (n - 2840); return 2816 + (n - 2848); } };
struct MapGU { int e, up; __device__ __forceinline__ int operator()(int n) const { return (e * 4 + (n >> 7)) * 256 + (n & 127) + up * 128; } };

__device__ __forceinline__ void p0_prologue(Frame& F) {
    LAS float* scr = (LAS float*)(F.lds + F.wave * TR_SCR);
    LAS float* sil = (LAS float*)(F.lds + 8 * TR_SCR);
    for (int i = F.tid_(); i < 2048; i += NWAVES * 64) { const float cv = F.c[i]; sil[i] = cv / (1.f + __expf(-cv)); }
    __syncthreads();
    const int gw = blockIdx.x * NWAVES + F.wave, NGW = F.G * NWAVES, lane = F.lane_();
    float* MODP = (float*)(F.ws + WS_MODP); float* PEB = (float*)(F.ws + WS_PEB);
    bf16_t* W1T = (bf16_t*)(F.ws + WS_W1T); bf16_t* WINT = (bf16_t*)(F.ws + WS_WINT); bf16_t* WOT = (bf16_t*)(F.ws + WS_WOT); bf16_t* WOUTT = (bf16_t*)(F.ws + WS_WOUTT);
    constexpr int I_GEMV = 768, I_PEB = 64, I_W1T = 64, I_WIN = 16 * 77, I_WO = 128, I_WOUT = 256;
    constexpr int NITEMS = I_GEMV + I_PEB + I_W1T + I_WIN + 2 * I_WO + I_WOUT;
    for (int it = gw; it < NITEMS; it += NGW) {
        int r = it;
        if (r < I_GEMV) {
            const int cg = r % 96, kc = r / 96; const int col = cg * 64 + lane; float a0 = 0.f, a1 = 0.f;
            const float* wp = F.w_ada + (size_t)(kc * 128) * 6144 + col;
#pragma unroll 32
            for (int k = 0; k < 128; ++k) { const float w = wp[(size_t)k * 6144]; a0 += sil[kc * 128 + k] * w; a1 += sil[1024 + kc * 128 + k] * w; }
            MODP[(kc * 2 + 0) * 6144 + col] = a0; MODP[(kc * 2 + 1) * 6144 + col] = a1; continue; }
        r -= I_GEMV;
        if (r < I_PEB) {
            const int kind = r >> 5, ch = r & 31; const float* pe = kind ? F.pe_v : F.pe_k; const float* w1 = kind ? F.w1_v : F.w1_k; float a = 0.f;
#pragma unroll 16
            for (int k = 0; k < 64; ++k) a += pe[ch * 64 + k] * w1[(size_t)(ch * 64 + k) * 64 + lane];
            PEB[(kind * 32 + ch) * 64 + lane] = a; continue; }
        r -= I_PEB;
        if (r < I_W1T) { const int kind = r >> 5, kb = r & 31; tr_item(kind ? F.w1_v : F.w1_k, 64, W1T + (size_t)kind * 64 * 2048, 2048, MapId{0}, scr, kb, 0, lane); continue; }
        r -= I_W1T;
        if (r < I_WIN) { tr_item(F.w_in, DIN, WINT, 1024, MapWin{}, scr, r / 77, r % 77, lane); continue; }
        r -= I_WIN;
        if (r < I_WO) { tr_item(F.w_o_nsa, 1024, WOT, 1024, MapId{0}, scr, r >> 4, r & 15, lane); continue; }
        r -= I_WO;
        if (r < I_WO) { tr_item(F.w_o_fox, 1024, WOT + 512, 1024, MapId{0}, scr, r >> 4, r & 15, lane); continue; }
        r -= I_WO;
        tr_item(F.w_out, 1024, WOUTT, 1024, MapId{0}, scr, r >> 4, r & 15, lane);
    }
}
__device__ __forceinline__ void expert_convert(Frame& F) {
    LAS float* scr = (LAS float*)(F.lds + F.wave * TR_SCR);
    const int gw = blockIdx.x * NWAVES + F.wave, NGW = F.G * NWAVES, lane = F.lane_();
    bf16_t* WGUT = (bf16_t*)(F.ws + WS_WGUT); bf16_t* WDT = (bf16_t*)(F.ws + WS_WDT);
    for (int it = gw; it < 32 * 384; it += NGW) {
        const int e = it / 384, r = it % 384, mat = r >> 7, q = r & 127;
        if (mat == 0) tr_item(F.w_eg + (size_t)e * 1024 * 512, 512, WGUT, 1024, MapGU{e, 0}, scr, q >> 3, q & 7, lane);
        else if (mat == 1) tr_item(F.w_eu + (size_t)e * 1024 * 512, 512, WGUT, 1024, MapGU{e, 1}, scr, q >> 3, q & 7, lane);
        else tr_item(F.w_ed + (size_t)e * 512 * 1024, 1024, WDT, 512, MapId{e * 1024}, scr, q >> 4, q & 15, lane);
    }
}

__device__ __forceinline__ void mod_from_partials(Frame& F, int b, int ch, f32x4 (&o)[4]) {
    const float* MODP = (const float*)(F.ws + WS_MODP);
#pragma unroll
    for (int j = 0; j < 4; ++j) { const int col = ch * 1024 + 256 * j + 4 * F.lane_(); f32x4 a = *(const f32x4*)(F.b_ada + col);
#pragma unroll
        for (int kc = 0; kc < 8; ++kc) a += *(const f32x4*)(MODP + (size_t)(kc * 2 + b) * 6144 + col);
        o[j] = a; }
}
__device__ __forceinline__ void mod_final(Frame& F, int b, int ch, f32x4 (&o)[4]) {
    const float* MOD = (const float*)(F.ws + WS_MOD);
#pragma unroll
    for (int j = 0; j < 4; ++j) o[j] = *(const f32x4*)(MOD + (size_t)b * 6144 + ch * 1024 + 256 * j + 4 * F.lane_());
}
__device__ __forceinline__ void ld_row4(const float* p, int lane, f32x4 (&o)[4]) {
#pragma unroll
    for (int j = 0; j < 4; ++j) o[j] = *(const f32x4*)(p + 256 * j + 4 * lane);
}
__device__ __forceinline__ float sumsq4(const f32x4 (&v)[4]) { float s = 0.f;
#pragma unroll
    for (int j = 0; j < 4; ++j) s += (v[j][0] * v[j][0] + v[j][1] * v[j][1]) + (v[j][2] * v[j][2] + v[j][3] * v[j][3]);
    return s; }
__device__ __forceinline__ void st_row_bf16(bf16_t* p, int lane, const f32x4 (&v)[4]) {
#pragma unroll
    for (int j = 0; j < 4; ++j) { u32x2 w; w.x = cvtpk(v[j][0], v[j][1]); w.y = cvtpk(v[j][2], v[j][3]); *(u32x2*)(p + 256 * j + 4 * lane) = w; }
}

__device__ __forceinline__ void p0b_rows(Frame& F) {
    const int gw = blockIdx.x * NWAVES + F.wave, NGW = F.G * NWAVES, lane = F.lane_();
    {
        const float* MODP = (const float*)(F.ws + WS_MODP); float* MOD = (float*)(F.ws + WS_MOD);
        for (int j = gw * 64 + lane; j < 2 * 6144; j += NGW * 64) { const int b = j / 6144, col = j % 6144; float a = F.b_ada[col];
#pragma unroll
            for (int kc = 0; kc < 8; ++kc) a += MODP[(size_t)(kc * 2 + b) * 6144 + col];
            MOD[j] = a; }
    }
    bf16_t* HN = (bf16_t*)(F.ws + WS_HN);
    f32x4 g[4]; ld_row4(F.g_pre_mix, lane, g);
    int curb = -1; f32x4 mul[4], add[4];
#ifdef P1_MULTI
    for (int m0 = gw; m0 < M; m0 += 4 * NGW) {
        const int b = m0 >> 13;
        if (b != curb) { f32x4 sc[4]; mod_from_partials(F, b, 0, add); mod_from_partials(F, b, 1, sc); curb = b;
#pragma unroll
            for (int j = 0; j < 4; ++j) mul[j] = g[j] * (sc[j] + 1.0f); }
        f32x4 v[4][4];
#pragma unroll
        for (int r = 0; r < 4; ++r) { const int m = m0 + r * NGW; if (m < M && (m >> 13) == b) ld_row4(F.x + (size_t)m * DM, lane, v[r]); }
#pragma unroll
        for (int r = 0; r < 4; ++r) { const int m = m0 + r * NGW;
            if (m < M && (m >> 13) == b) {
                const float rstd = 1.0f / sqrtf(wave_sum(sumsq4(v[r])) * (1.0f / DM) + NORM_EPS);
#pragma unroll
                for (int j = 0; j < 4; ++j) v[r][j] = v[r][j] * rstd * mul[j] + add[j];
                st_row_bf16(HN + (size_t)m * DM, lane, v[r]); } }
        for (int r = 1; r < 4; ++r) { const int m = m0 + r * NGW;
            if (m < M && (m >> 13) != b) { f32x4 sc[4], a2[4], m2[4], vv[4]; mod_from_partials(F, m >> 13, 0, a2); mod_from_partials(F, m >> 13, 1, sc);
#pragma unroll
                for (int j = 0; j < 4; ++j) m2[j] = g[j] * (sc[j] + 1.0f);
                ld_row4(F.x + (size_t)m * DM, lane, vv);
                const float rstd = 1.0f / sqrtf(wave_sum(sumsq4(vv)) * (1.0f / DM) + NORM_EPS);
#pragma unroll
                for (int j = 0; j < 4; ++j) vv[j] = vv[j] * rstd * m2[j] + a2[j];
                st_row_bf16(HN + (size_t)m * DM, lane, vv); } }
    }
#else
    for (int m = gw; m < M; m += NGW) {
        const int b = m >> 13;
        if (b != curb) { f32x4 sc[4]; mod_from_partials(F, b, 0, add); mod_from_partials(F, b, 1, sc); curb = b;
#pragma unroll
            for (int j = 0; j < 4; ++j) mul[j] = g[j] * (sc[j] + 1.0f); }
        f32x4 v[4]; ld_row4(F.x + (size_t)m * DM, lane, v);
        const float rstd = 1.0f / sqrtf(wave_sum(sumsq4(v)) * (1.0f / DM) + NORM_EPS);
#pragma unroll
        for (int j = 0; j < 4; ++j) v[j] = v[j] * rstd * mul[j] + add[j];
        st_row_bf16(HN + (size_t)m * DM, lane, v);
    }
#endif
}

__device__ __forceinline__ float gelu_tanh(float x) { const float u = 0.7978845608028654f * (x + 0.044715f * x * x * x); const float t = 1.0f - 2.0f / (1.0f + __expf(2.0f * u)); return 0.5f * x * (1.0f + t); }
__device__ __forceinline__ void p2a_item_cmp(Frame& F, int item) {
    const int kind = item >> 6, bg = (item >> 4) & 3, nt = item & 15, b = bg >> 1, g = bg & 1, n0 = 32 * nt;
    const int lane = F.lane_(), r32 = lane & 31, hi = lane >> 5, w = F.wave, tid = F.tid_();
    const bf16_t* PROJ = (const bf16_t*)(F.ws + WS_PROJ); const bf16_t* W1T = (const bf16_t*)(F.ws + WS_W1T) + (size_t)kind * 64 * 2048;
    const int col = (kind ? C_VCMP : C_KCMP) + g * 64;
    int n = n0 + r32; if (n > 510) n = 510;
    const bf16_t* ap = PROJ + (size_t)(b * SEQ + 16 * n) * PP + col + 8 * hi;
    const bf16_t* bp0 = W1T + (size_t)r32 * 2048 + 256 * w + 8 * hi; const bf16_t* bp1 = bp0 + (size_t)32 * 2048;
    f32x16 acc0 = {}, acc1 = {};
#pragma unroll 8
    for (int ks = 0; ks < 16; ++ks) { const int l = 4 * w + (ks >> 2), d = (ks & 3) * 16;
        const bf16x8 a = *(const bf16x8*)(ap + (size_t)l * PP + d);
        const bf16x8 b0 = *(const bf16x8*)(bp0 + 16 * ks), b1 = *(const bf16x8*)(bp1 + 16 * ks);
        acc0 = __builtin_amdgcn_mfma_f32_32x32x16_bf16(a, b0, acc0, 0, 0, 0); acc1 = __builtin_amdgcn_mfma_f32_32x32x16_bf16(a, b1, acc1, 0, 0, 0); }
    LAS float* RED = (LAS float*)F.lds;
    LAS float* BIAS = (LAS float*)(F.lds + 65536);
    LAS float* HID = (LAS float*)(F.lds + 65536 + 256);
#pragma unroll
    for (int r = 0; r < 16; ++r) { const int nl = (r & 3) + 8 * (r >> 2) + 4 * hi; RED[(w * 32 + nl) * 64 + r32] = acc0[r]; RED[(w * 32 + nl) * 64 + 32 + r32] = acc1[r]; }
    if (tid < 64) { const float* PEB = (const float*)(F.ws + WS_PEB) + kind * 32 * 64; float a = 0.f;
        for (int ch = 0; ch < 32; ++ch) a += PEB[ch * 64 + tid];
        BIAS[tid] = a; }
    __syncthreads();
    { const int idx = tid * 4, nl = idx >> 6, e = idx & 63; f32x4 s = *(const LAS f32x4*)(BIAS + e);
#pragma unroll
      for (int ww = 0; ww < 8; ++ww) s += *(const LAS f32x4*)(RED + (ww * 32 + nl) * 64 + e);
      f32x4 h; for (int i = 0; i < 4; ++i) h[i] = gelu_tanh(s[i]);
      *(LAS f32x4*)(HID + nl * 64 + e) = h; }
    __syncthreads();
    { const int nl = tid >> 4, e2 = (tid & 15) * 4; const float* w2 = kind ? F.w2_v : F.w2_k; f32x4 o = {0.f, 0.f, 0.f, 0.f};
#pragma unroll 8
      for (int e = 0; e < 64; ++e) { const float hv = HID[nl * 64 + e]; o += *(const f32x4*)(w2 + e * 64 + e2) * hv; }
      bf16_t* KC = (bf16_t*)(F.ws + (kind ? WS_VC : WS_KC));
      u32x2 pk; pk.x = cvtpk(o[0], o[1]); pk.y = cvtpk(o[2], o[3]);
      *(u32x2*)(KC + (size_t)(bg * 512 + n0 + nl) * 64 + e2) = pk; }
    __syncthreads();
}
__device__ __forceinline__ void p2a_item_cumsum(Frame& F, int bh) {
    const int b = bh >> 3, h = bh & 7, tid = F.tid_(), lane = F.lane_(), w = F.wave;
    const float* LF = (const float*)(F.ws + WS_LF); float* FB2 = (float*)(F.ws + WS_FB2);
    LAS float* WT = (LAS float*)F.lds;
    float v[16]; float s = 0.f;
#pragma unroll
    for (int i = 0; i < 16; ++i) { s += LF[(size_t)(b * SEQ + tid * 16 + i) * 8 + h]; v[i] = s; }
    float inc = s;
#pragma unroll
    for (int o = 1; o < 64; o <<= 1) { const float t = __shfl_up(inc, o); if (lane >= o) inc += t; }
    if (lane == 63) WT[w] = inc;
    __syncthreads();
    float base = inc - s;
    for (int ww = 0; ww < w; ++ww) base += WT[ww];
#pragma unroll
    for (int i = 0; i < 16; ++i) FB2[(size_t)bh * SEQ + tid * 16 + i] = -(base + v[i]) * LOG2E;
    __syncthreads();
    { const bf16_t* PROJ = (const bf16_t*)(F.ws + WS_PROJ) + (size_t)b * SEQ * PP + h * 64 + 8 * (lane & 7);
      float qm = 0.f, km = 0.f;
      for (int it = 0; it < 128; it += 4) {
          u32x4 qv[4], kv4[4];
#pragma unroll
          for (int u = 0; u < 4; ++u) { const int row = ((it + u) * 8 + w) * 8 + (lane >> 3); qv[u] = *(const u32x4*)(PROJ + (size_t)row * PP + C_FQ); kv4[u] = *(const u32x4*)(PROJ + (size_t)row * PP + C_FK); }
#pragma unroll
          for (int u = 0; u < 4; ++u) { float sq = 0.f, sk = 0.f;
#pragma unroll
              for (int c = 0; c < 4; ++c) { const float a0 = bflo(qv[u][c]), a1 = bfhi(qv[u][c]), b0 = bflo(kv4[u][c]), b1 = bfhi(kv4[u][c]); sq += a0 * a0 + a1 * a1; sk += b0 * b0 + b1 * b1; }
              sq += __shfl_xor(sq, 1); sq += __shfl_xor(sq, 2); sq += __shfl_xor(sq, 4); sk += __shfl_xor(sk, 1); sk += __shfl_xor(sk, 2); sk += __shfl_xor(sk, 4);
              qm = fmaxf(qm, sq); km = fmaxf(km, sk); } }
#pragma unroll
      for (int o = 8; o < 64; o <<= 1) { qm = fmaxf(qm, __shfl_xor(qm, o)); km = fmaxf(km, __shfl_xor(km, o)); }
      if (lane == 0) { WT[16 + w] = qm; WT[32 + w] = km; }
      __syncthreads();
      if (tid == 0) { float q2 = 0.f, k2 = 0.f; for (int ww = 0; ww < 8; ++ww) { q2 = fmaxf(q2, WT[16 + ww]); k2 = fmaxf(k2, WT[32 + ww]); }
          ((float*)(F.ws + WS_ROUTE))[bh] = 150.0f + 2.0f * sqrtf(q2 * k2) * 1.0001f + 1.0f; }
      __syncthreads(); }
}
namespace att {
__device__ __forceinline__ int crow(int r, int hi) { return (r & 3) + 8 * (r >> 2) + 4 * hi; }
constexpr int KVBUF = 16384;
__device__ __forceinline__ void issue_kv(LAS unsigned char* buf, const bf16_t* kp, const bf16_t* vp, int wid) {
    __builtin_amdgcn_global_load_lds((const unsigned*)kp, (LAS unsigned*)(buf + wid * 1024), 16, 0, 0);
    __builtin_amdgcn_global_load_lds((const unsigned*)vp, (LAS unsigned*)(buf + 8192 + wid * 1024), 16, 0, 0);
}
template <int PITCH> __device__ __forceinline__ const bf16_t* kptr(const bf16_t* base, int row0, int kc, int wid, int lane) { return base + (size_t)(row0 + lane) * PITCH + kc + wid * 8; }
template <int PITCH> __device__ __forceinline__ const bf16_t* vptr(const bf16_t* base, int row0, int vc, int wid, int lane) { return base + (size_t)(row0 + 16 * (wid & 3) + (lane >> 2)) * PITCH + vc + (wid >> 2) * 32 + (lane & 3) * 8; }

__device__ __forceinline__ void qkt(f32x16& p0, f32x16& p1, const LAS unsigned char* Ks, const bf16x8 (&qr)[4], int r32, int hi) {
    const LAS unsigned char* kb = Ks + hi * 1024 + r32 * 16;
#pragma unroll
    for (int d0 = 0; d0 < 4; ++d0) {
        const bf16x8 b0 = *(const LAS bf16x8*)(kb + d0 * 2048);
        const bf16x8 b1 = *(const LAS bf16x8*)(kb + d0 * 2048 + 512);
        p0 = __builtin_amdgcn_mfma_f32_32x32x16_bf16(b0, qr[d0], p0, 0, 0, 0);
        p1 = __builtin_amdgcn_mfma_f32_32x32x16_bf16(b1, qr[d0], p1, 0, 0, 0);
    }
}
typedef short v4i16_t __attribute__((ext_vector_type(4)));
__device__ __forceinline__ s16x4 vtr(const LAS unsigned char* p) { return __builtin_bit_cast(s16x4, __builtin_amdgcn_ds_read_tr16_b64_v4i16((LAS v4i16_t*)p)); }
__device__ __forceinline__ float half_swap_max(float v) { auto rr = __builtin_amdgcn_permlane32_swap(__float_as_uint(v), __float_as_uint(v), false, false); return fmaxf(__uint_as_float(rr[0]), __uint_as_float(rr[1])); }
__device__ __forceinline__ float half_swap_sum(float v) { auto rr = __builtin_amdgcn_permlane32_swap(__float_as_uint(v), __float_as_uint(v), false, false); return __uint_as_float(rr[0]) + __uint_as_float(rr[1]); }
__device__ __forceinline__ float rowmax32(const f32x16& p0, const f32x16& p1) {
    float a = fmaxf(p0[0], p1[0]);
#pragma unroll
    for (int r = 1; r < 16; ++r) a = fmaxf(a, fmaxf(p0[r], p1[r]));
    return half_swap_max(a);
}
__device__ __forceinline__ void pv(f32x16& o0, f32x16& o1, const LAS unsigned char* buf, const f32x16& p0, const f32x16& p1, int lane) {
    const int hi = lane >> 5;
    const LAS unsigned char* vb = buf + 8192 + ((lane >> 4) & 1) * 32 + (lane & 3) * 8 + (4 * hi + ((lane & 15) >> 2)) * 64;
    u32x4 w0 = {cvtpk(p0[0], p0[1]), cvtpk(p0[2], p0[3]), cvtpk(p0[4], p0[5]), cvtpk(p0[6], p0[7])};
    u32x4 w1 = {cvtpk(p0[8], p0[9]), cvtpk(p0[10], p0[11]), cvtpk(p0[12], p0[13]), cvtpk(p0[14], p0[15])};
    u32x4 w2 = {cvtpk(p1[0], p1[1]), cvtpk(p1[2], p1[3]), cvtpk(p1[4], p1[5]), cvtpk(p1[6], p1[7])};
    u32x4 w3 = {cvtpk(p1[8], p1[9]), cvtpk(p1[10], p1[11]), cvtpk(p1[12], p1[13]), cvtpk(p1[14], p1[15])};
    const bf16x8 pa[4] = {__builtin_bit_cast(bf16x8, w0), __builtin_bit_cast(bf16x8, w1), __builtin_bit_cast(bf16x8, w2), __builtin_bit_cast(bf16x8, w3)};
#pragma unroll
    for (int ks = 0; ks < 4; ++ks) {
        const s16x4 l0 = vtr(vb + ks * 1024), h0 = vtr(vb + ks * 1024 + 512);
        const s16x4 l1 = vtr(vb + 4096 + ks * 1024), h1 = vtr(vb + 4096 + ks * 1024 + 512);
        const bf16x8 v0 = {l0[0], l0[1], l0[2], l0[3], h0[0], h0[1], h0[2], h0[3]};
        const bf16x8 v1 = {l1[0], l1[1], l1[2], l1[3], h1[0], h1[1], h1[2], h1[3]};
        o0 = __builtin_amdgcn_mfma_f32_32x32x16_bf16(v0, pa[ks], o0, 0, 0, 0);
        o1 = __builtin_amdgcn_mfma_f32_32x32x16_bf16(v1, pa[ks], o1, 0, 0, 0);
    }
}
template <bool EMASK>
__device__ __forceinline__ void tile_step(const LAS unsigned char* buf, const bf16x8 (&qr)[4], f32x16 p0, f32x16 p1, int lo, int hb,
                                          f32x16& o0, f32x16& o1, float& m, float& l, int lane) {
    const int r32 = lane & 31, hi = lane >> 5;
    qkt(p0, p1, buf, qr, r32, hi);
    if (EMASK) {
#pragma unroll
        for (int r = 0; r < 16; ++r) { const int kl = crow(r, hi); if (kl < lo || kl > hb) p0[r] = NEGF; if (kl + 32 < lo || kl + 32 > hb) p1[r] = NEGF; }
    }
    const float rm = rowmax32(p0, p1);
    const float mn = fmaxf(m, rm);
    const float al = __builtin_amdgcn_exp2f(m - mn);
    m = mn; l *= al;
#pragma unroll
    for (int r = 0; r < 16; ++r) { o0[r] *= al; o1[r] *= al; }
    float s = 0.f;
#pragma unroll
    for (int r = 0; r < 16; ++r) { p0[r] = __builtin_amdgcn_exp2f(p0[r] - mn); p1[r] = __builtin_amdgcn_exp2f(p1[r] - mn); s += p0[r] + p1[r]; }
    l += s;
    pv(o0, o1, buf, p0, p1, lane);
}
__device__ __forceinline__ void store_cols(bf16_t* dst, const f32x16& y0, const f32x16& y1, int hi) {
#pragma unroll
    for (int q = 0; q < 4; ++q) {
        u32x2 a; a.x = cvtpk(y0[4 * q], y0[4 * q + 1]); a.y = cvtpk(y0[4 * q + 2], y0[4 * q + 3]);
        u32x2 b; b.x = cvtpk(y1[4 * q], y1[4 * q + 1]); b.y = cvtpk(y1[4 * q + 2], y1[4 * q + 3]);
        *(u32x2*)(dst + 8 * q + 4 * hi) = a; *(u32x2*)(dst + 32 + 8 * q + 4 * hi) = b;
    }
}

__device__ __forceinline__ int next_below(unsigned u0, unsigned u1, unsigned u2, unsigned u3, int from) {
    if (from > 96) { const unsigned v = (from < 128) ? (u3 & ((1u << (from - 96)) - 1u)) : u3; if (v) return 96 + 31 - __builtin_clz(v); }
    if (from > 64) { const unsigned v = (from < 96) ? (u2 & ((1u << (from - 64)) - 1u)) : u2; if (v) return 64 + 31 - __builtin_clz(v); }
    if (from > 32) { const unsigned v = (from < 64) ? (u1 & ((1u << (from - 32)) - 1u)) : u1; if (v) return 32 + 31 - __builtin_clz(v); }
    if (from > 0) { const unsigned v = (from < 32) ? (u0 & ((1u << from) - 1u)) : u0; if (v) return 31 - __builtin_clz(v); }
    return -1;
}
__device__ __forceinline__ void fox_unit(Frame& F, int b, int h, int qb) {
    int lane = F.lane_(); asm volatile("" : "+v"(lane));
    const int wid = F.wave, r32 = lane & 31, hi = lane >> 5;
    const bf16_t* PROJ = (const bf16_t*)(F.ws + WS_PROJ) + (size_t)b * SEQ * PP;
    const float* FB2 = (const float*)(F.ws + WS_FB2) + (size_t)(b * 8 + h) * SEQ;
    bf16_t* YB = (bf16_t*)(F.ws + WS_YY) + 512 + (size_t)b * SEQ * 1024;
    LAS unsigned char* kv = F.lds;
    const int t0 = 256 * qb, tw0 = t0 + 32 * wid, t = tw0 + r32;
    const int kcol = C_FK + h * 64, vcol = C_FV + h * 64;
    bf16x8 qr[4];
#pragma unroll
    for (int d0 = 0; d0 < 4; ++d0) qr[d0] = *(const bf16x8*)(PROJ + (size_t)t * PP + C_FQ + h * 64 + d0 * 16 + hi * 8);
    f32x16 o0 = {}, o1 = {}; float m = NEGF, l = 0.f;
    const int NT = 4 * (qb + 1);
    __syncthreads();
    issue_kv(kv + ((NT - 1) & 1) * KVBUF, kptr<PP>(PROJ, (NT - 1) * 64, kcol, wid, lane), vptr<PP>(PROJ, (NT - 1) * 64, vcol, wid, lane), wid);
    for (int j = NT - 1; j >= 0; --j) {
        f32x16 c0, c1;
        const bool active = (64 * j <= tw0 + 31);
        if (active) {
            const float* fb = FB2 + 64 * j + 4 * hi;
#pragma unroll
            for (int q = 0; q < 4; ++q) { const f32x4 a = *(const f32x4*)(fb + 8 * q), bb = *(const f32x4*)(fb + 32 + 8 * q);
                c0[4 * q] = a[0]; c0[4 * q + 1] = a[1]; c0[4 * q + 2] = a[2]; c0[4 * q + 3] = a[3];
                c1[4 * q] = bb[0]; c1[4 * q + 1] = bb[1]; c1[4 * q + 2] = bb[2]; c1[4 * q + 3] = bb[3]; }
        }
        VM_WAIT(); __syncthreads();
        if (j > 0) issue_kv(kv + ((j - 1) & 1) * KVBUF, kptr<PP>(PROJ, (j - 1) * 64, kcol, wid, lane), vptr<PP>(PROJ, (j - 1) * 64, vcol, wid, lane), wid);
        if (active) {
            const LAS unsigned char* buf = kv + (j & 1) * KVBUF;
            if (64 * j + 63 > tw0) tile_step<true>(buf, qr, c0, c1, 0, t - 64 * j, o0, o1, m, l, lane);
            else tile_step<false>(buf, qr, c0, c1, 0, 63, o0, o1, m, l, lane);
        }
    }
    const float inv = 1.0f / half_swap_sum(l);
#pragma unroll
    for (int r = 0; r < 16; ++r) { o0[r] *= inv; o1[r] *= inv; }
    store_cols(YB + (size_t)t * 1024 + h * 64, o0, o1, hi);
}

constexpr int IMP_OFF = 3 * KVBUF;
constexpr int SELM_OFF = IMP_OFF + 64 * 128 * 4;
constexpr int TL_OFF = SELM_OFF + 1024;
constexpr int YSV_OFF = TL_OFF + 256;
__device__ __forceinline__ void nsa_unit(Frame& F, int b, int g, int cur) {
    int lane = F.lane_(); asm volatile("" : "+v"(lane));
    const int wid = F.wave, r32 = lane & 31, hi = lane >> 5;
    const bf16_t* PROJ = (const bf16_t*)(F.ws + WS_PROJ) + (size_t)b * SEQ * PP;
    const float* GATES = (const float*)(F.ws + WS_GATES) + (size_t)b * SEQ * 24;
    bf16_t* YA = (bf16_t*)(F.ws + WS_YY) + (size_t)b * SEQ * 1024;
    LAS unsigned char* kv = F.lds;
    LAS float* IMP = (LAS float*)(F.lds + IMP_OFF);
    LAS unsigned* SELM = (LAS unsigned*)(F.lds + SELM_OFF);
    const int t0 = 64 * cur, ql = 8 * wid + (r32 >> 2), hl = r32 & 3, head = 4 * g + hl, t = t0 + ql;
    const float a = __builtin_amdgcn_exp2f(-(float)(head + 1)) * LOG2E;
    bf16x8 qr[4];
#pragma unroll
    for (int d0 = 0; d0 < 4; ++d0) qr[d0] = *(const bf16x8*)(PROJ + (size_t)t * PP + C_QA + head * 64 + d0 * 16 + hi * 8);
    const float* gp = GATES + (size_t)t * 24 + head * 3;
    LAS float* YSV = (LAS float*)(F.lds + YSV_OFF) + (wid * 64 + lane);
    float kc_r[16];
#pragma unroll
    for (int r = 0; r < 16; ++r) kc_r[r] = (float)((r & 3) + 8 * (r >> 2));
    {
        const bf16_t* KC = (const bf16_t*)(F.ws + WS_KC) + (size_t)(b * 2 + g) * 512 * 64;
        const bf16_t* VC = (const bf16_t*)(F.ws + WS_VC) + (size_t)(b * 2 + g) * 512 * 64;
        const int nmaxU = (t0 + 32) >> 4, ntile = (nmaxU >> 6) + 1;
        const int nmax_l = (t - 31) >> 4;
        const float a16 = a * 16.0f;
#pragma unroll
        for (int i = 0; i < 16; ++i) IMP[(8 * wid) * 128 + i * 64 + lane] = 0.f;
        float m = NEGF, l = 0.f;
        __syncthreads();
        issue_kv(kv, kptr<64>(KC, 0, 0, wid, lane), vptr<64>(VC, 0, 0, wid, lane), wid);
        for (int jt = 0; jt < ntile; ++jt) {
            VM_WAIT(); __syncthreads();
            if (jt + 1 < ntile) issue_kv(kv + ((jt + 1) & 1) * KVBUF, kptr<64>(KC, (jt + 1) * 64, 0, wid, lane), vptr<64>(VC, (jt + 1) * 64, 0, wid, lane), wid);
            const float base = a16 * (float)(64 * jt + 4 * hi);
            f32x16 p0, p1;
#pragma unroll
            for (int r = 0; r < 16; ++r) { p0[r] = fmaf(a16, kc_r[r], base); p1[r] = p0[r] + a16 * 32.0f; }
            qkt(p0, p1, kv + (jt & 1) * KVBUF, qr, r32, hi);
            const int lim = nmax_l - 64 * jt;
#pragma unroll
            for (int r = 0; r < 16; ++r) { const int kl = crow(r, hi); if (kl > lim) p0[r] = NEGF; if (kl + 32 > lim) p1[r] = NEGF; }
            const float rm = rowmax32(p0, p1), mn = fmaxf(m, rm);
            float s = 0.f;
#pragma unroll
            for (int r = 0; r < 16; ++r) { const int kl = crow(r, hi);
                s += (kl <= lim) ? __builtin_amdgcn_exp2f(p0[r] - mn) : 0.f; s += (kl + 32 <= lim) ? __builtin_amdgcn_exp2f(p1[r] - mn) : 0.f; }
            l = l * __builtin_amdgcn_exp2f(m - mn) + s; m = mn;
        }
        const float lt = half_swap_sum(l);
        const float inv = lt > 0.f ? 1.0f / lt : 0.f;
        f32x16 o0 = {}, o1 = {};
        __syncthreads();
        issue_kv(kv, kptr<64>(KC, 0, 0, wid, lane), vptr<64>(VC, 0, 0, wid, lane), wid);
        for (int jt = 0; jt < ntile; ++jt) {
            VM_WAIT(); __syncthreads();
            if (jt + 1 < ntile) issue_kv(kv + ((jt + 1) & 1) * KVBUF, kptr<64>(KC, (jt + 1) * 64, 0, wid, lane), vptr<64>(VC, (jt + 1) * 64, 0, wid, lane), wid);
            const float base = a16 * (float)(64 * jt + 4 * hi);
            f32x16 p0, p1;
#pragma unroll
            for (int r = 0; r < 16; ++r) { p0[r] = fmaf(a16, kc_r[r], base); p1[r] = p0[r] + a16 * 32.0f; }
            qkt(p0, p1, kv + (jt & 1) * KVBUF, qr, r32, hi);
            const int lim = nmax_l - 64 * jt;
#pragma unroll
            for (int r = 0; r < 16; ++r) { const int kl = crow(r, hi);
                p0[r] = (kl <= lim) ? __builtin_amdgcn_exp2f(p0[r] - m) * inv : 0.f; p1[r] = (kl + 32 <= lim) ? __builtin_amdgcn_exp2f(p1[r] - m) * inv : 0.f; }
#pragma unroll
            for (int r2 = 0; r2 < 4; ++r2) {
                float A0 = (p0[4 * r2] + p0[4 * r2 + 1]) + (p0[4 * r2 + 2] + p0[4 * r2 + 3]), L0 = p0[4 * r2 + 3];
                float A1 = (p1[4 * r2] + p1[4 * r2 + 1]) + (p1[4 * r2 + 2] + p1[4 * r2 + 3]), L1 = p1[4 * r2 + 3];
                A0 += __shfl_xor(A0, 1); A0 += __shfl_xor(A0, 2); L0 += __shfl_xor(L0, 1); L0 += __shfl_xor(L0, 2);
                A1 += __shfl_xor(A1, 1); A1 += __shfl_xor(A1, 2); L1 += __shfl_xor(L1, 1); L1 += __shfl_xor(L1, 2);
                if (hl == 0) {
                    const int j0 = 16 * jt + 2 * r2 + hi, j1 = j0 + 8;
                    LAS float* ip = IMP + ql * 128;
                    __hip_atomic_fetch_add(ip + j0, A0, __ATOMIC_RELAXED, __HIP_MEMORY_SCOPE_WORKGROUP);
                    __hip_atomic_fetch_add(ip + j0 + 1, L0, __ATOMIC_RELAXED, __HIP_MEMORY_SCOPE_WORKGROUP);
                    __hip_atomic_fetch_add(ip + j1, A1, __ATOMIC_RELAXED, __HIP_MEMORY_SCOPE_WORKGROUP);
                    if (j1 + 1 < 128) __hip_atomic_fetch_add(ip + j1 + 1, L1, __ATOMIC_RELAXED, __HIP_MEMORY_SCOPE_WORKGROUP);
                }
            }
            pv(o0, o1, kv + (jt & 1) * KVBUF, p0, p1, lane);
        }
        const float g0 = gp[0];
#pragma unroll
        for (int r = 0; r < 16; ++r) { YSV[r * 512] = g0 * o0[r]; YSV[(16 + r) * 512] = g0 * o1[r]; }
        LDS_WAIT();
        for (int qi = 0; qi < 8; ++qi) {
            const int q = 8 * wid + qi;
            const unsigned k0 = __float_as_uint(IMP[q * 128 + lane]), k1 = __float_as_uint(IMP[q * 128 + 64 + lane]);
            const bool c0 = (lane >= 1) && (lane <= cur - 2), c1 = (64 + lane <= cur - 2);
            unsigned long long s0, s1;
            if (cur - 2 <= 13) { s0 = __ballot(c0); s1 = __ballot(c1); }
            else {
                unsigned T = 0u;
                for (int bit = 30; bit >= 0; --bit) { const unsigned cand = T | (1u << bit);
                    const int cnt = __popcll(__ballot(c0 && k0 >= cand)) + __popcll(__ballot(c1 && k1 >= cand));
                    if (cnt >= 13) T = cand; }
                s0 = __ballot(c0 && k0 > T); s1 = __ballot(c1 && k1 > T);
                int need = 13 - __popcll(s0) - __popcll(s1);
                unsigned long long e0 = __ballot(c0 && k0 == T), e1 = __ballot(c1 && k1 == T);
                while (need > 0) { if (e0) { const unsigned long long bb = e0 & (0ull - e0); s0 |= bb; e0 ^= bb; } else if (e1) { const unsigned long long bb = e1 & (0ull - e1); s1 |= bb; e1 ^= bb; } else break; --need; }
            }
            s0 |= 1ull;
            if (cur < 64) s0 |= 1ull << cur; else s1 |= 1ull << (cur - 64);
            if (cur >= 1) { if (cur - 1 < 64) s0 |= 1ull << (cur - 1); else s1 |= 1ull << (cur - 65); }
            if (lane == 0) { SELM[q * 4 + 0] = (unsigned)s0; SELM[q * 4 + 1] = (unsigned)(s0 >> 32); SELM[q * 4 + 2] = (unsigned)s1; SELM[q * 4 + 3] = (unsigned)(s1 >> 32); }
        }
    }
    LDS_WAIT(); __syncthreads();
    unsigned um[4], mym[4];
#pragma unroll
    for (int w = 0; w < 4; ++w) { unsigned v = SELM[lane * 4 + w];
#pragma unroll
        for (int o = 1; o < 64; o <<= 1) v |= (unsigned)__shfl_xor((int)v, o);
        um[w] = (unsigned)__builtin_amdgcn_readfirstlane((int)v); mym[w] = SELM[ql * 4 + w]; }
    const float a64 = a * 64.0f;
    const bf16_t* PK = PROJ;
    {
        LAS unsigned char* TL = (LAS unsigned char*)(F.lds + TL_OFF);
        const int tid = wid * 64 + lane;
        const int jlo = cur >= 8 ? cur - 8 : 0, nw = cur - jlo + 1;
        const int ns = __popc(um[0]) + __popc(um[1]) + __popc(um[2]) + __popc(um[3]), n = ns + nw;
        if (tid < 128) { const unsigned wsel = (tid < 32) ? um[0] : (tid < 64) ? um[1] : (tid < 96) ? um[2] : um[3];
            if ((wsel >> (tid & 31)) & 1u) {
                int rk = __popc(wsel >> (tid & 31)) - 1;
                if (tid < 96) rk += __popc(um[3]); if (tid < 64) rk += __popc(um[2]); if (tid < 32) rk += __popc(um[1]);
                TL[rk] = (unsigned char)tid; } }
        if (tid >= 128 && tid < 128 + nw) TL[ns + (tid - 128)] = (unsigned char)(cur - (tid - 128));
        __syncthreads();
        f32x16 o0 = {}, o1 = {}; float m = 0.f, l = 0.f;
#define NSA_ISSUE(i, slot) do { const int j_ = TL[i]; const bool w_ = (i) >= ns; \
            issue_kv(kv + (slot) * KVBUF, kptr<PP>(PK, 64 * j_, (w_ ? C_KWIN : C_KSLC) + g * 64, wid, lane), vptr<PP>(PK, 64 * j_, (w_ ? C_VWIN : C_VSLC) + g * 64, wid, lane), wid); } while (0)
#define NSA_SCORE(i, slot, P0, P1) do { const int j_ = TL[i]; const bool w_ = (i) >= ns; \
            const unsigned mw_ = (j_ < 32) ? mym[0] : (j_ < 64) ? mym[1] : (j_ < 96) ? mym[2] : mym[3]; \
            const bool mine_ = w_ || ((mw_ >> (j_ & 31)) & 1u); \
            const float base_ = (mine_ ? (a64 * (float)(j_ - cur) + a * (float)(4 * hi)) : NEGF) - m; \
            _Pragma("unroll") for (int r = 0; r < 16; ++r) { P0[r] = fmaf(a, kc_r[r], base_); P1[r] = P0[r] + a * 32.0f; } \
            qkt(P0, P1, kv + (slot) * KVBUF, qr, r32, hi); \
            if (j_ == cur) { _Pragma("unroll") for (int r = 0; r < 16; ++r) { const int kl = crow(r, hi); if (kl > ql) P0[r] = NEGF; if (kl + 32 > ql) P1[r] = NEGF; } } \
            else if (w_ && j_ == cur - 8) { _Pragma("unroll") for (int r = 0; r < 16; ++r) { const int kl = crow(r, hi); if (kl <= ql) P0[r] = NEGF; if (kl + 32 <= ql) P1[r] = NEGF; } } } while (0)
        NSA_ISSUE(0, 0);
        VM_WAIT(); __syncthreads();
        NSA_ISSUE(1, 1);
        f32x16 s0, s1, t0v, t1v;
        NSA_SCORE(0, 0, s0, s1);
        int slot = 0;
        for (int i = 0; i < n; ++i) {
            const int slot1 = (slot == 2) ? 0 : slot + 1, slot2 = (slot1 == 2) ? 0 : slot1 + 1;
            if (i + 1 < n) {
                VM_WAIT(); __syncthreads();
                if (i + 2 < n) NSA_ISSUE(i + 2, slot2);
                NSA_SCORE(i + 1, slot1, t0v, t1v);
            }
            {
                const float rm = rowmax32(s0, s1);
                if (__any(rm > 8.0f)) {
                    const float dl = fmaxf(rm, 0.f), f = __builtin_amdgcn_exp2f(-dl);
                    m += dl; l *= f;
#pragma unroll
                    for (int r = 0; r < 16; ++r) { s0[r] -= dl; s1[r] -= dl; o0[r] *= f; o1[r] *= f; }
                    if (i + 1 < n) {
#pragma unroll
                        for (int r = 0; r < 16; ++r) { t0v[r] -= dl; t1v[r] -= dl; } }
                }
                float sm = 0.f;
#pragma unroll
                for (int r = 0; r < 16; ++r) { s0[r] = __builtin_amdgcn_exp2f(s0[r]); s1[r] = __builtin_amdgcn_exp2f(s1[r]); sm += s0[r] + s1[r]; }
                l += sm;
                pv(o0, o1, kv + slot * KVBUF, s0, s1, lane);
            }
            if (i == ns - 1) {
                const float sc = gp[1] / half_swap_sum(l);
#pragma unroll
                for (int r = 0; r < 16; ++r) { YSV[r * 512] += sc * o0[r]; YSV[(16 + r) * 512] += sc * o1[r]; o0[r] = 0.f; o1[r] = 0.f; }
                if (i + 1 < n) {
#pragma unroll
                    for (int r = 0; r < 16; ++r) { t0v[r] += m; t1v[r] += m; } }
                m = 0.f; l = 0.f;
            }
            s0 = t0v; s1 = t1v; slot = slot1;
        }
#undef NSA_ISSUE
#undef NSA_SCORE
        const float sc = gp[2] / half_swap_sum(l);
#pragma unroll
        for (int r = 0; r < 16; ++r) { o0[r] = YSV[r * 512] + sc * o0[r]; o1[r] = YSV[(16 + r) * 512] + sc * o1[r]; }
        store_cols(YA + (size_t)t * 1024 + head * 64, o0, o1, hi);
    }
}
}
namespace foxb {
using bf16 = __hip_bfloat16;
constexpr int D = 64, NW = 8, QBLK = 32, QB = QBLK * NW, KVBLK = 64;
constexpr int PQ = PP;
constexpr int PO = 1024;
__device__ __forceinline__ int crow(int r, int hi) { return (r & 3) + 8 * (r >> 2) + 4 * hi; }
#define SBAR() __builtin_amdgcn_sched_barrier(0)
__device__ __forceinline__ void cmask(f32x16& p0, f32x16& p1, int jb, int qrel, int hi) {
  const float NEG = -INFINITY; int kb = 64 * jb + 4 * hi;
#pragma unroll
  for (int r = 0; r < 16; ++r) { int kv = kb + (r & 3) + 8 * (r >> 2); if (kv > qrel) p0[r] = NEG; if (kv + 32 > qrel) p1[r] = NEG; }
}
constexpr int NSLOT = 3, SLOTB = 8192;
constexpr int LDS_K = 0, LDS_V = NSLOT * SLOTB, LDS_WS = 2 * NSLOT * SLOTB, LDS_OST = LDS_WS + NW * 64 * 4, LDS_BS = LDS_OST + NW * 4096, LDS_BYTES_FOX = LDS_BS + 4 * 256;
__device__ __forceinline__ void glds16(const void* gsrc, unsigned lds_dst) { unsigned keep;
  asm volatile("s_mov_b32 %0, m0\n\ts_mov_b32 m0, %2\n\ts_nop 0\n\tglobal_load_lds_dwordx4 %1, off\n\ts_mov_b32 m0, %0" : "=&s"(keep) : "v"(gsrc), "s"(lds_dst) : "memory"); }
__device__ __forceinline__ void glds4(const void* gsrc, unsigned lds_dst) { unsigned keep;
  asm volatile("s_mov_b32 %0, m0\n\ts_mov_b32 m0, %2\n\ts_nop 0\n\tglobal_load_lds_dword %1, off\n\ts_mov_b32 m0, %0" : "=&s"(keep) : "v"(gsrc), "s"(lds_dst) : "memory"); }
__device__ __forceinline__ float max3f(float a, float b, float c) { float r; asm("v_max3_f32 %0, %1, %2, %3" : "=v"(r) : "v"(a), "v"(b), "v"(c)); return r; }
__device__ __forceinline__ float max2f(float a, float b) { float r; asm("v_max_f32_e32 %0, %1, %2" : "=v"(r) : "v"(a), "v"(b)); return r; }
__device__ __forceinline__ float fadd_s(float a, float b) { float r; asm("v_add_f32_e32 %0, %1, %2" : "=v"(r) : "v"(a), "v"(b)); return r; }
__device__ __forceinline__ float fsub_s(float a, float b) { float r; asm("v_sub_f32_e32 %0, %1, %2" : "=v"(r) : "v"(a), "v"(b)); return r; }
__device__ __forceinline__ unsigned cvtpk_s(float lo, float hi) { return cvtpk(lo, hi); }
#define WAIT_BAR(N) asm volatile("s_waitcnt vmcnt(" #N ") lgkmcnt(0)\n\ts_barrier" ::: "memory")

__device__ __forceinline__ void qkt(f32x16& p0, f32x16& p1, const char* Kslot, const bf16x8* qr, int r32, int hi) {
  const char* kb = Kslot + hi * 1024 + r32 * 16;
#pragma unroll
  for (int d0 = 0; d0 < 4; ++d0) {
    const bf16x8 b0 = *reinterpret_cast<const bf16x8*>(kb + d0 * 2048);
    const bf16x8 b1 = *reinterpret_cast<const bf16x8*>(kb + d0 * 2048 + 512);
    p0 = __builtin_amdgcn_mfma_f32_32x32x16_bf16(b0, qr[d0], p0, 0, 0, 0); p1 = __builtin_amdgcn_mfma_f32_32x32x16_bf16(b1, qr[d0], p1, 0, 0, 0); }
}
typedef __attribute__((address_space(3))) const char* lds_cptr;
typedef short v4i16_t __attribute__((ext_vector_type(4)));
__device__ __forceinline__ void kload8(bf16x8* kf, lds_cptr kp) {
  kf[0] = *(const LAS bf16x8*)(kp);        kf[1] = *(const LAS bf16x8*)(kp + 512);
  kf[2] = *(const LAS bf16x8*)(kp + 2048); kf[3] = *(const LAS bf16x8*)(kp + 2560);
  kf[4] = *(const LAS bf16x8*)(kp + 4096); kf[5] = *(const LAS bf16x8*)(kp + 4608);
  kf[6] = *(const LAS bf16x8*)(kp + 6144); kf[7] = *(const LAS bf16x8*)(kp + 6656);
}
__device__ __forceinline__ void kload2(bf16x8* kf, lds_cptr kp, int j) { kf[2 * j] = *(const LAS bf16x8*)(kp + j * 2048); kf[2 * j + 1] = *(const LAS bf16x8*)(kp + j * 2048 + 512); }
__device__ __forceinline__ s16x4 vtr(lds_cptr p) { return __builtin_bit_cast(s16x4, __builtin_amdgcn_ds_read_tr16_b64_v4i16((LAS v4i16_t*)p)); }
__device__ __forceinline__ void bias_ld(f32x16& c0, f32x16& c1, lds_cptr bp, float mhat) {
#pragma unroll
  for (int q = 0; q < 4; ++q) { const f32x4 a = *(const LAS f32x4*)(bp + 32 * q), b = *(const LAS f32x4*)(bp + 128 + 32 * q);
    c0[4 * q] = a[0] - mhat; c0[4 * q + 1] = a[1] - mhat; c0[4 * q + 2] = a[2] - mhat; c0[4 * q + 3] = a[3] - mhat;
    c1[4 * q] = b[0] - mhat; c1[4 * q + 1] = b[1] - mhat; c1[4 * q + 2] = b[2] - mhat; c1[4 * q + 3] = b[3] - mhat; }
}
__device__ __forceinline__ float rowmax(const f32x16& p0, const f32x16& p1) {
  float a = max3f(p0[0], p0[1], p1[0]), b = max3f(p0[2], p0[3], p1[1]); a = max3f(a, p1[2], p1[3]);
#pragma unroll
  for (int r = 4; r < 16; r += 4) { a = max3f(a, p0[r], p0[r + 1]); b = max3f(b, p0[r + 2], p0[r + 3]); a = max3f(a, p1[r], p1[r + 1]); b = max3f(b, p1[r + 2], p1[r + 3]); }
  const float m = max2f(a, b);
  auto rr = __builtin_amdgcn_permlane32_swap(__float_as_uint(m), __float_as_uint(m), false, false);
  return max2f(__uint_as_float(rr[0]), __uint_as_float(rr[1]));
}
__device__ __forceinline__ void pv(f32x16* o, int vb, bf16x8 pa0, bf16x8 pa1, bf16x8 pa2, bf16x8 pa3) {
#pragma unroll
  for (int d0 = 0; d0 < 2; ++d0) { s16x4 lo[4], hi[4];
#pragma unroll
    for (int ks = 0; ks < 4; ++ks) {
      asm volatile("ds_read_b64_tr_b16 %0,%1 offset:%c2" : "=&v"(lo[ks]) : "v"(vb), "i"(d0 * 4096 + ks * 1024) : "memory");
      asm volatile("ds_read_b64_tr_b16 %0,%1 offset:%c2" : "=&v"(hi[ks]) : "v"(vb), "i"(d0 * 4096 + ks * 1024 + 512) : "memory"); }
    asm volatile("s_waitcnt lgkmcnt(0)" ::: "memory"); SBAR();
#define PK(k) (bf16x8){lo[k][0], lo[k][1], lo[k][2], lo[k][3], hi[k][0], hi[k][1], hi[k][2], hi[k][3]}
    o[d0] = __builtin_amdgcn_mfma_f32_32x32x16_bf16(pa0, PK(0), o[d0], 0, 0, 0);
    o[d0] = __builtin_amdgcn_mfma_f32_32x32x16_bf16(pa1, PK(1), o[d0], 0, 0, 0);
    o[d0] = __builtin_amdgcn_mfma_f32_32x32x16_bf16(pa2, PK(2), o[d0], 0, 0, 0);
    o[d0] = __builtin_amdgcn_mfma_f32_32x32x16_bf16(pa3, PK(3), o[d0], 0, 0, 0);
#undef PK
  }
}

template <int THRL>
__device__ __forceinline__ void fox_unit(int qb, int jskip, const bf16* Qb, const bf16* __restrict__ Kb, const bf16* __restrict__ Vb, const float* __restrict__ FB, bf16* Ob, char* shm) {
  int tid = threadIdx.x; asm volatile("" : "+v"(tid));
  const int lane = tid & 63, r32 = lane & 31, hi = lane >> 5; const int wid = __builtin_amdgcn_readfirstlane(tid >> 6);
  const int q0 = qb * QB;
  const bf16* Qw = Qb + (long)(q0 + wid * QBLK) * PQ;
  const bf16* Kh = Kb + (long)jskip * KVBLK * PQ; const bf16* Vh = Vb + (long)jskip * KVBLK * PQ; const float* Fh = FB + jskip * KVBLK;
  const unsigned lds0 = (unsigned)(uintptr_t)shm;
  float* wsf = (float*)(shm + LDS_WS) + wid * 64;
  const bf16* ksrc = Kh + (long)lane * PQ + wid * 8;
  const bf16* vsrc = Vh + (long)(16 * (wid & 3) + (lane >> 2)) * PQ + (wid >> 2) * 32 + (lane & 3) * 8;
  const float* bsrc = Fh + lane;
  const unsigned kdst = lds0 + LDS_K + wid * 1024, vdst = lds0 + LDS_V + wid * 1024, bdst = lds0 + LDS_BS;
#define DMA_K(t, slot) glds16(ksrc + (long)(t) * KVBLK * PQ, (unsigned)__builtin_amdgcn_readfirstlane(kdst + (slot)))
#define DMA_V(t, slot) glds16(vsrc + (long)(t) * KVBLK * PQ, (unsigned)__builtin_amdgcn_readfirstlane(vdst + (slot)))
#define DMA_B(t) glds4(bsrc + (t) * KVBLK, (unsigned)__builtin_amdgcn_readfirstlane(bdst + (((t) & 3) << 8)))
  const int vb0 = (int)(lds0 + LDS_V) + ((lane >> 4) & 1) * 32 + (lane & 3) * 8 + (4 * hi + ((lane & 15) >> 2)) * 64;
  const char* Kbase = shm + LDS_K; bf16x8 kf[8];
  const lds_cptr shm3 = (lds_cptr)shm; const lds_cptr kp0 = shm3 + LDS_K + hi * 1024 + r32 * 16; const lds_cptr vp0 = shm3 + LDS_V + ((lane >> 4) & 1) * 32 + (lane & 3) * 8 + (4 * hi + ((lane & 15) >> 2)) * 64;
  const lds_cptr bp0 = shm3 + LDS_BS + 16 * hi;
  const int NT = (q0 + QB) / KVBLK - jskip;
  DMA_B(0); DMA_K(0, 0); DMA_V(0, 0); DMA_K(1, SLOTB); DMA_B(1);
  bf16x8 qr[4];
#pragma unroll
  for (int d0 = 0; d0 < 4; ++d0) qr[d0] = *reinterpret_cast<const bf16x8*>(&Qw[(long)r32 * PQ + d0 * 16 + hi * 8]);
  float mhat = 0.f, l_reg = 0.f; f32x16 o[2]; o[0] = f32x16{}; o[1] = f32x16{};
  const int qrel = wid * QBLK + r32;
#define CMASK(P0, P1, t) do { int jb_ = (t) - (NT - 4); if (jb_ >= 0) cmask(P0, P1, jb_, qrel, hi); } while (0)
  bool resc = false;
#define START(P0, P1) do { const float rm = rowmax(P0, P1); resc = false; \
    { const float dl = rm; mhat = fadd_s(mhat, dl); \
      _Pragma("unroll") for (int r = 0; r < 16; ++r) { P0[r] = fsub_s(P0[r], dl); P1[r] = fsub_s(P1[r], dl); } } \
    _Pragma("unroll") for (int r = 0; r < 16; ++r) P0[r] = __builtin_amdgcn_exp2f(P0[r]); } while (0)
#define RESC() do { if (resc) { asm volatile("s_waitcnt lgkmcnt(0)" ::: "memory"); \
      _Pragma("unroll") for (int d_ = 0; d_ < 2; ++d_) _Pragma("unroll") for (int r = 0; r < 16; ++r) o[d_][r] *= wsf[crow(r, hi)]; } } while (0)
  f32x16 pA0, pA1, pB0, pB1;
  int sl_prev = 0, sl_cur = 0, sl_next = SLOTB;
#define ROT() do { sl_prev = sl_cur; sl_cur = sl_next; sl_next = (sl_next == (NSLOT - 1) * SLOTB) ? 0 : sl_next + SLOTB; } while (0)
  DMA_K(2, 2 * SLOTB);
  WAIT_BAR(4);
  bias_ld(pA0, pA1, bp0, 0.f);
  qkt(pA0, pA1, Kbase, qr, r32, hi); asm volatile("s_nop 15\n\ts_nop 7" : "+v"(pA0), "+v"(pA1)); CMASK(pA0, pA1, 0);
  START(pA0, pA1);
  _Pragma("unroll") for (int r = 0; r < 16; ++r) pA1[r] = __builtin_amdgcn_exp2f(pA1[r]);
  WAIT_BAR(0);
  DMA_B(2); DMA_K(3, 0); DMA_V(1, SLOTB);
  ROT();
  kload8(kf, kp0 + sl_cur);
  WAIT_BAR(3);
  s16x4 vlo[8], vhi[8]; u32x4 pw0, pw1, pw2, pw3;
#define PKW(P, B) cvtpk_s(P[B], P[B + 1])
#define PAF(k) __builtin_bit_cast(bf16x8, pw##k)
#define VFR(i) (bf16x8){vlo[i][0], vlo[i][1], vlo[i][2], vlo[i][3], vhi[i][0], vhi[i][1], vhi[i][2], vhi[i][3]}
#define PIN(x) asm volatile("" : "+v"(x))
#define MX3(a, b, c) __builtin_fmaxf(__builtin_fmaxf((a), (b)), (c))
#define GAPA(MF, A0, A1, A2, A3, W0, W1, PW) do { MF; sacc += A0; sacc += A1; sacc += A2; sacc += A3; PIN(sacc); W0; W1; PIN(PW); SBAR(); } while (0)
#define EX(v) __builtin_amdgcn_exp2f(v)
#define GAPB(MF, X, B) do { MF; X[B] = EX(X[B]); X[B + 1] = EX(X[B + 1]); X[B + 2] = EX(X[B + 2]); X[B + 3] = EX(X[B + 3]); PIN(X); SBAR(); } while (0)
#define VRD(i) do { vlo[i] = vtr(vp_ + (((i) >> 2) * 4096 + ((i) & 3) * 1024)); vhi[i] = vtr(vp_ + (((i) >> 2) * 4096 + ((i) & 3) * 1024 + 512)); } while (0)
#define KRD(G, j) do { if (G) { kload2(kf, kp0 + sl_next, j); SBAR(); } } while (0)
#define STEP(C0, C1, P0, P1, t, GK, GV, GL, GB) do { SBAR(); \
    bias_ld(C0, C1, bp0 + (((t) & 3) << 8), mhat); SBAR(); \
    const lds_cptr vp_ = vp0 + sl_prev; \
    VRD(0); SBAR(); float sacc = (P0[0] + P0[1]); \
    GAPA(C0 = __builtin_amdgcn_mfma_f32_32x32x16_bf16(kf[0], qr[0], C0, 0, 0, 0), P0[2], P0[3], P0[4], P0[5],     pw0[0] = PKW(P0, 0), pw0[1] = PKW(P0, 2), pw0); \
    VRD(4); SBAR(); GAPA(C1 = __builtin_amdgcn_mfma_f32_32x32x16_bf16(kf[1], qr[0], C1, 0, 0, 0), P0[6], P0[7], P0[8], P0[9],     pw0[2] = PKW(P0, 4), pw0[3] = PKW(P0, 6), pw0); \
    VRD(1); SBAR(); GAPA(C0 = __builtin_amdgcn_mfma_f32_32x32x16_bf16(kf[2], qr[1], C0, 0, 0, 0),   P0[10], P0[11], P0[12], P0[13], pw1[0] = PKW(P0, 8), pw1[1] = PKW(P0, 10), pw1); \
    VRD(5); SBAR(); GAPA(C1 = __builtin_amdgcn_mfma_f32_32x32x16_bf16(kf[3], qr[1], C1, 0, 0, 0),   P0[14], P0[15], P1[0], P1[1],   pw1[2] = PKW(P0, 12), pw1[3] = PKW(P0, 14), pw1); \
    VRD(2); SBAR(); GAPA(C0 = __builtin_amdgcn_mfma_f32_32x32x16_bf16(kf[4], qr[2], C0, 0, 0, 0),   P1[2], P1[3], P1[4], P1[5],     pw2[0] = PKW(P1, 0), pw2[1] = PKW(P1, 2), pw2); \
    VRD(6); SBAR(); GAPA(C1 = __builtin_amdgcn_mfma_f32_32x32x16_bf16(kf[5], qr[2], C1, 0, 0, 0),   P1[6], P1[7], P1[8], P1[9],     pw2[2] = PKW(P1, 4), pw2[3] = PKW(P1, 6), pw2); \
    VRD(3); SBAR(); GAPA(C0 = __builtin_amdgcn_mfma_f32_32x32x16_bf16(kf[6], qr[3], C0, 0, 0, 0),   P1[10], P1[11], P1[12], P1[13], pw3[0] = PKW(P1, 8), pw3[1] = PKW(P1, 10), pw3); \
    VRD(7); SBAR(); GAPA(C1 = __builtin_amdgcn_mfma_f32_32x32x16_bf16(kf[7], qr[3], C1, 0, 0, 0),   P1[14], P1[15], 0.f, 0.f,       pw3[2] = PKW(P1, 12), pw3[3] = PKW(P1, 14), pw3); \
    l_reg += sacc; \
    if (GB) { DMA_B((t) + 2); } if (GK) { DMA_K((t) + 3, sl_cur); } if (GV) { DMA_V((t) + 1, sl_next); } \
    CMASK(C0, C1, t); \
    { float a = MX3(C0[0], C0[1], C1[0]), b = MX3(C0[2], C0[3], C1[1]); a = MX3(a, C1[2], C1[3]); \
      _Pragma("unroll") for (int r = 4; r < 16; r += 4) { a = MX3(a, C0[r], C0[r + 1]); b = MX3(b, C0[r + 2], C0[r + 3]); a = MX3(a, C1[r], C1[r + 1]); b = MX3(b, C1[r + 2], C1[r + 3]); } \
      float rm = __builtin_fmaxf(a, b); { auto rr = __builtin_amdgcn_permlane32_swap(__float_as_uint(rm), __float_as_uint(rm), false, false); rm = __builtin_fmaxf(__uint_as_float(rr[0]), __uint_as_float(rr[1])); } \
      resc = false; \
      if (__builtin_expect(__any(rm > (float)THRL), 0)) { const float dl = __builtin_fmaxf(rm, 0.f); mhat += dl; \
        _Pragma("unroll") for (int r = 0; r < 16; ++r) { C0[r] -= dl; C1[r] -= dl; } \
        const float f = __builtin_amdgcn_exp2f(-dl); l_reg *= f; if (hi == 0) wsf[r32] = f; resc = true; } } \
    SBAR(); \
    GAPB(o[0] = __builtin_amdgcn_mfma_f32_32x32x16_bf16(PAF(0), VFR(0), o[0], 0, 0, 0), C0, 0); \
    GAPB(o[1] = __builtin_amdgcn_mfma_f32_32x32x16_bf16(PAF(0), VFR(4), o[1], 0, 0, 0), C0, 4); \
    KRD(GL, 0); GAPB(o[0] = __builtin_amdgcn_mfma_f32_32x32x16_bf16(PAF(1), VFR(1), o[0], 0, 0, 0), C0, 8); \
    KRD(GL, 1); GAPB(o[1] = __builtin_amdgcn_mfma_f32_32x32x16_bf16(PAF(1), VFR(5), o[1], 0, 0, 0), C0, 12); \
    KRD(GL, 2); GAPB(o[0] = __builtin_amdgcn_mfma_f32_32x32x16_bf16(PAF(2), VFR(2), o[0], 0, 0, 0), C1, 0); \
    KRD(GL, 3); GAPB(o[1] = __builtin_amdgcn_mfma_f32_32x32x16_bf16(PAF(2), VFR(6), o[1], 0, 0, 0), C1, 4); \
    GAPB(o[0] = __builtin_amdgcn_mfma_f32_32x32x16_bf16(PAF(3), VFR(3), o[0], 0, 0, 0), C1, 8); \
    GAPB(o[1] = __builtin_amdgcn_mfma_f32_32x32x16_bf16(PAF(3), VFR(7), o[1], 0, 0, 0), C1, 12); \
    } while (0)
  int t = 1;
#undef CMASK
#define CMASK(P0, P1, t) do { } while (0)
  for (; t + 5 < NT; t += 2) {
    STEP(pB0, pB1, pA0, pA1, t, true, true, true, true);       WAIT_BAR(3); RESC(); ROT();
    STEP(pA0, pA1, pB0, pB1, t + 1, true, true, true, true);   WAIT_BAR(3); RESC(); ROT();
  }
#undef CMASK
#define CMASK(P0, P1, t) do { int jb_ = (t) - (NT - 4); if (jb_ >= 0) cmask(P0, P1, jb_, qrel, hi); } while (0)
#define ENDW(tt) do { if ((tt) + 3 < NT) { WAIT_BAR(3); } else if ((tt) + 2 < NT) { WAIT_BAR(2); } else { WAIT_BAR(0); } } while (0)
  for (; t + 1 < NT; t += 2) {
    STEP(pB0, pB1, pA0, pA1, t, (t + 3 < NT), (t + 1 < NT), (t + 1 < NT), (t + 2 < NT));           ENDW(t);     RESC(); ROT();
    STEP(pA0, pA1, pB0, pB1, t + 1, (t + 4 < NT), (t + 2 < NT), (t + 2 < NT), (t + 3 < NT));       ENDW(t + 1); RESC(); ROT();
  }
  STEP(pB0, pB1, pA0, pA1, NT - 1, false, false, false, false); RESC();
  { float sacc = pB0[0] + pB0[1]; _Pragma("unroll") for (int r = 2; r < 16; ++r) sacc += pB0[r]; _Pragma("unroll") for (int r = 0; r < 16; ++r) sacc += pB1[r]; l_reg += sacc;
    pw0 = (u32x4){PKW(pB0, 0), PKW(pB0, 2), PKW(pB0, 4), PKW(pB0, 6)}; pw1 = (u32x4){PKW(pB0, 8), PKW(pB0, 10), PKW(pB0, 12), PKW(pB0, 14)}; pw2 = (u32x4){PKW(pB1, 0), PKW(pB1, 2), PKW(pB1, 4), PKW(pB1, 6)}; pw3 = (u32x4){PKW(pB1, 8), PKW(pB1, 10), PKW(pB1, 12), PKW(pB1, 14)};
    SBAR(); pv(o, vb0 + sl_cur, PAF(0), PAF(1), PAF(2), PAF(3)); }
#undef PKW
#undef PAF
#undef VFR
#undef PIN
#undef MX3
#undef GAPA
#undef GAPB
#undef EX
#undef VRD
#undef KRD
#undef STEP
#undef ENDW
  { auto rr = __builtin_amdgcn_permlane32_swap(__float_as_uint(l_reg), __float_as_uint(l_reg), false, false); l_reg = __uint_as_float(rr[0]) + __uint_as_float(rr[1]); }
  if (hi == 0) wsf[32 + r32] = l_reg; asm volatile("s_waitcnt lgkmcnt(0)" ::: "memory");
  float rli[16];
#pragma unroll
  for (int r = 0; r < 16; ++r) rli[r] = __builtin_amdgcn_rcpf(wsf[32 + crow(r, hi)]);
  bf16* Ow = Ob + (long)(q0 + wid * QBLK) * PO;
  { bf16* stg = (bf16*)(shm + LDS_OST) + wid * 2048;
#pragma unroll
    for (int r = 0; r < 16; ++r) { const int orow = crow(r, hi);
#pragma unroll
      for (int d0 = 0; d0 < 2; ++d0) stg[orow * 64 + d0 * 32 + r32] = __float2bfloat16(o[d0][r] * rli[r]); }
    asm volatile("s_waitcnt lgkmcnt(0)" ::: "memory");
#pragma unroll
    for (int i = 0; i < 4; ++i) { const int row = i * 8 + (lane >> 3), ch = lane & 7; const u32x4 v = *(const u32x4*)(stg + row * 64 + ch * 8); *(u32x4*)(Ow + (long)row * PO + ch * 8) = v; } }
  asm volatile("s_waitcnt lgkmcnt(0)\n\ts_barrier" ::: "memory");
#undef DMA_K
#undef DMA_V
#undef DMA_B
#undef CMASK
#undef START
#undef RESC
#undef ROT
}
#undef SBAR
#undef WAIT_BAR
}
__device__ __forceinline__ float butterfly32(float (&pe)[32], int lane) {
    { const bool b5 = (lane & 32) != 0;
#pragma unroll
      for (int i = 0; i < 16; ++i) { const float keep = b5 ? pe[i + 16] : pe[i], give = b5 ? pe[i] : pe[i + 16]; pe[i] = keep + __shfl_xor(give, 32); } }
    { const bool b4 = (lane & 16) != 0;
#pragma unroll
      for (int i = 0; i < 8; ++i) { const float keep = b4 ? pe[i + 8] : pe[i], give = b4 ? pe[i] : pe[i + 8]; pe[i] = keep + __shfl_xor(give, 16); } }
    { const bool b3 = (lane & 8) != 0;
#pragma unroll
      for (int i = 0; i < 4; ++i) { const float keep = b3 ? pe[i + 4] : pe[i], give = b3 ? pe[i] : pe[i + 4]; pe[i] = keep + __shfl_xor(give, 8); } }
    { const bool b2 = (lane & 4) != 0;
#pragma unroll
      for (int i = 0; i < 2; ++i) { const float keep = b2 ? pe[i + 2] : pe[i], give = b2 ? pe[i] : pe[i + 2]; pe[i] = keep + __shfl_xor(give, 4); } }
    { const bool b1 = (lane & 2) != 0; const float keep = b1 ? pe[1] : pe[0], give = b1 ? pe[0] : pe[1]; pe[0] = keep + __shfl_xor(give, 2); }
    return pe[0] + __shfl_xor(pe[0], 1);
}
constexpr int RT_OFF = 36 * 1024 * 4;
__device__ __forceinline__ void route_token(Frame& F, int m, int slot, const float (&lg)[4], float le_l, int lane) {
    int gi = 0; float gm = lg[0];
#pragma unroll
    for (int e = 1; e < 4; ++e) if (lg[e] > gm) { gm = lg[e]; gi = e; }
    float gs = 0.f;
#pragma unroll
    for (int e = 0; e < 4; ++e) gs += __expf(lg[e] - gm);
    const float pg = 1.0f / gs;
    float l0 = -INFINITY, l1 = -INFINITY; int e0 = 0, e1 = 0;
#pragma unroll
    for (int i = 0; i < 8; ++i) { const float lv = __shfl(le_l, 2 * (gi * 8 + i)) + F.b_re[gi * 8 + i];
        if (lv > l0) { l1 = l0; e1 = e0; l0 = lv; e0 = i; } else if (lv > l1) { l1 = lv; e1 = i; } }
    const float w0 = 1.0f / (1.0f + __expf(l1 - l0)), w1 = 1.0f - w0;
    if (lane == 0) {
        LAS unsigned* LCNT = (LAS unsigned*)(F.lds + RT_OFF); LAS u32x4* REC = (LAS u32x4*)(F.lds + RT_OFF + 256);
        const int x0 = gi * 8 + e0, x1 = gi * 8 + e1;
        const unsigned r0 = __hip_atomic_fetch_add(LCNT + x0, 1u, __ATOMIC_RELAXED, __HIP_MEMORY_SCOPE_WORKGROUP);
        const unsigned r1 = __hip_atomic_fetch_add(LCNT + x1, 1u, __ATOMIC_RELAXED, __HIP_MEMORY_SCOPE_WORKGROUP);
        REC[2 * slot] = (u32x4){(unsigned)x0, r0, (unsigned)(2 * m), __float_as_uint(pg * w0)};
        REC[2 * slot + 1] = (u32x4){(unsigned)x1, r1, (unsigned)(2 * m + 1), __float_as_uint(pg * w1)};
    }
}
__device__ __forceinline__ void p3c_load(Frame& F, int m, f32x4 (&xr)[4], u32x2 (&mx)[4], int lane) {
    const bf16_t* MIXED = (const bf16_t*)(F.ws + WS_YY);
    ld_row4(F.x + (size_t)m * DM, lane, xr);
#pragma unroll
    for (int j = 0; j < 4; ++j) mx[j] = *(const u32x2*)(MIXED + (size_t)m * DM + 256 * j + 4 * lane);
}
__device__ __forceinline__ void p3c_row(Frame& F, int m, const f32x4 (&gt)[4], const f32x4 (&mul)[4], const f32x4 (&add)[4], f32x4 (&xr)[4], const u32x2 (&mx)[4], f32x4 (&v)[4], int lane) {
    bf16_t* H2 = (bf16_t*)(F.ws + WS_HN);
#pragma unroll
    for (int j = 0; j < 4; ++j) v[j] = (f32x4){bflo(mx[j].x), bfhi(mx[j].x), bflo(mx[j].y), bfhi(mx[j].y)};
    const float rstd = 1.0f / sqrtf(wave_sum(sumsq4(v)) * (1.0f / DM) + NORM_EPS);
#pragma unroll
    for (int j = 0; j < 4; ++j) { xr[j] = xr[j] + gt[j] * (v[j] * rstd); *(f32x4*)(F.out + (size_t)m * DM + 256 * j + 4 * lane) = xr[j]; }
    const float rstd2 = 1.0f / sqrtf(wave_sum(sumsq4(xr)) * (1.0f / DM) + NORM_EPS);
#pragma unroll
    for (int j = 0; j < 4; ++j) v[j] = xr[j] * rstd2 * mul[j] + add[j];
    st_row_bf16(H2 + (size_t)m * DM, lane, v);
}
#define DOT4(vv, w) ((vv[0] * w[0] + vv[1] * w[1]) + (vv[2] * w[2] + vv[3] * w[3]))
__device__ __forceinline__ void p3c_rows(Frame& F) {
    LAS float* WR = (LAS float*)F.lds;
    { const int tid = F.tid_();
      f32x4 wg[2], we[16];
#pragma unroll
      for (int q = 0; q < 2; ++q) wg[q] = *(const f32x4*)(F.w_rg + 4 * (tid + 512 * q));
#pragma unroll
      for (int q = 0; q < 16; ++q) we[q] = *(const f32x4*)(F.w_re + 4 * (tid + 512 * q));
#pragma unroll
      for (int q = 0; q < 2; ++q) { const int i = tid + 512 * q; WR[i] = wg[q][0]; WR[1024 + i] = wg[q][1]; WR[2048 + i] = wg[q][2]; WR[3072 + i] = wg[q][3]; }
#pragma unroll
      for (int q = 0; q < 16; ++q) { const int i = tid + 512 * q, k = i >> 3, e4 = (i & 7) * 4;
          WR[(4 + e4) * 1024 + k] = we[q][0]; WR[(5 + e4) * 1024 + k] = we[q][1]; WR[(6 + e4) * 1024 + k] = we[q][2]; WR[(7 + e4) * 1024 + k] = we[q][3]; } }
    if (F.tid_() < 64) ((LAS unsigned*)(F.lds + RT_OFF))[F.tid_()] = 0u;
    __syncthreads();
    const int gw = blockIdx.x * NWAVES + F.wave, NGW = F.G * NWAVES, lane = F.lane_();
    f32x4 gpost[4], gpre[4]; ld_row4(F.g_post_mix, lane, gpost); ld_row4(F.g_pre_ffn, lane, gpre);
    int curb = -1, nrow = 0; f32x4 gt[4], mul[4], add[4];
    unsigned wb0 = (unsigned)(4 * lane) * 4u, wb1 = wb0 + 12 * 4096, wb2 = wb0 + 24 * 4096;
    asm volatile("" : "+v"(wb0), "+v"(wb1), "+v"(wb2));
#define WRD(e, j) (*(const LAS f32x4*)((const LAS unsigned char*)WR + (((e) < 12) ? wb0 : ((e) < 24) ? wb1 : wb2) + (((e) % 12) * 4096 + (j) * 1024)))
    for (int m = 2 * gw; m < M; m += 2 * NGW) {
        const int b = m >> 13, m2 = m + 1; const bool two = (m2 < M) && ((m2 >> 13) == b);
        if (b != curb) { f32x4 sc[4]; mod_final(F, b, 2, gt); mod_final(F, b, 3, add); mod_final(F, b, 4, sc); curb = b;
#pragma unroll
            for (int j = 0; j < 4; ++j) { gt[j] = gt[j] * gpost[j]; mul[j] = gpre[j] * (sc[j] + 1.0f); } }
        if (!two) {
            f32x4 v[4], xr[4]; u32x2 mx[4]; p3c_load(F, m, xr, mx, lane); p3c_row(F, m, gt, mul, add, xr, mx, v, lane);
            float lg[4], pe[32];
#pragma unroll
            for (int e = 0; e < 36; ++e) { float s = 0.f;
#pragma unroll
                for (int j = 0; j < 4; ++j) { const f32x4 w = WRD(e, j); s += DOT4(v[j], w); }
                if (e < 4) lg[e] = wave_sum(s) + F.b_rg[e]; else pe[e - 4] = s;
                if ((e & 3) == 3) asm volatile("" ::: "memory"); }
            const float le_l = butterfly32(pe, lane);
            route_token(F, m, F.wave * 16 + nrow, lg, le_l, lane); ++nrow;
            continue;
        }
        f32x4 va[4], vb[4];
        { f32x4 xa[4], xb[4]; u32x2 ma[4], mb[4]; p3c_load(F, m, xa, ma, lane); p3c_load(F, m2, xb, mb, lane);
          p3c_row(F, m, gt, mul, add, xa, ma, va, lane); p3c_row(F, m2, gt, mul, add, xb, mb, vb, lane); }
        float lga[4], lgb[4], pa[32], pb[32];
#pragma unroll
        for (int e = 0; e < 36; ++e) { f32x2 qa = {0.f, 0.f}, qb = {0.f, 0.f};
#pragma unroll
            for (int j = 0; j < 4; ++j) { const f32x4 w = WRD(e, j); const f32x2 wl = {w[0], w[1]}, wh = {w[2], w[3]};
                qa += (f32x2){va[j][0], va[j][1]} * wl; qa += (f32x2){va[j][2], va[j][3]} * wh;
                qb += (f32x2){vb[j][0], vb[j][1]} * wl; qb += (f32x2){vb[j][2], vb[j][3]} * wh; }
            const float sa = qa.x + qa.y, sb = qb.x + qb.y;
            if (e < 4) { lga[e] = wave_sum(sa) + F.b_rg[e]; lgb[e] = wave_sum(sb) + F.b_rg[e]; } else { pa[e - 4] = sa; pb[e - 4] = sb; }
            if (e & 1) asm volatile("" ::: "memory"); }
        const float la = butterfly32(pa, lane), lb = butterfly32(pb, lane);
        route_token(F, m, F.wave * 16 + nrow, lga, la, lane); route_token(F, m2, F.wave * 16 + nrow + 1, lgb, lb, lane); nrow += 2;
    }
    if (lane == 0) ((LAS unsigned*)(F.lds + RT_OFF + 8192))[F.wave] = (unsigned)nrow;
    __syncthreads();
    { LAS unsigned* LCNT = (LAS unsigned*)(F.lds + RT_OFF); LAS unsigned* BASE = LCNT + 32; LAS u32x4* REC = (LAS u32x4*)(F.lds + RT_OFF + 256);
      if (F.tid_() < 32) { const unsigned c = LCNT[F.tid_()]; BASE[F.tid_()] = c ? __hip_atomic_fetch_add(F.ctl + CW_ECNT + 64 * F.tid_(), c, RLX_AGENT) : 0u; }
      __syncthreads();
      u32x2* LIST = (u32x2*)(F.ws + WS_LIST);
      if (F.tid_() < 256) { const int w = F.tid_() >> 5, i = F.tid_() & 31;
          const u32x4 r = REC[2 * (w * 16) + i];
          if (i < 2 * (int)((LAS unsigned*)(F.lds + RT_OFF + 8192))[w]) { u32x2 o; o.x = r.z; o.y = r.w; LIST[(size_t)r.x * M + BASE[r.x] + r.y] = o; } }
    }
}
#undef DOT4
#undef WRD
__device__ __forceinline__ void p5_rows(Frame& F) {
    const int gw = blockIdx.x * NWAVES + F.wave, NGW = F.G * NWAVES, lane = F.lane_();
    const bf16_t* Y2 = (const bf16_t*)(F.ws + WS_YY);
    f32x4 gpost[4]; ld_row4(F.g_post_ffn, lane, gpost);
#ifdef P10_MULTI
    int curb = -1; f32x4 gt[4];
    for (int m0 = gw; m0 < M; m0 += 2 * NGW) {
        const int b = m0 >> 13;
        if (b != curb) { mod_final(F, b, 5, gt); curb = b;
#pragma unroll
            for (int j = 0; j < 4; ++j) gt[j] = gt[j] * gpost[j]; }
        f32x4 xr[2][4]; u32x2 ya[2][4], yc[2][4];
#pragma unroll
        for (int r = 0; r < 2; ++r) { const int m = m0 + r * NGW; if (m < M) { ld_row4(F.out + (size_t)m * DM, lane, xr[r]);
#pragma unroll
            for (int j = 0; j < 4; ++j) { ya[r][j] = *(const u32x2*)(Y2 + (size_t)(2 * m) * DM + 256 * j + 4 * lane); yc[r][j] = *(const u32x2*)(Y2 + (size_t)(2 * m + 1) * DM + 256 * j + 4 * lane); } } }
#pragma unroll
        for (int r = 0; r < 2; ++r) { const int m = m0 + r * NGW; if (m < M) {
            f32x4 gg[4];
            if ((m >> 13) != b) { mod_final(F, m >> 13, 5, gg);
#pragma unroll
                for (int j = 0; j < 4; ++j) gg[j] = gg[j] * gpost[j]; }
            else {
#pragma unroll
                for (int j = 0; j < 4; ++j) gg[j] = gt[j]; }
            f32x4 y[4];
#pragma unroll
            for (int j = 0; j < 4; ++j) y[j] = (f32x4){bflo(ya[r][j].x) + bflo(yc[r][j].x), bfhi(ya[r][j].x) + bfhi(yc[r][j].x), bflo(ya[r][j].y) + bflo(yc[r][j].y), bfhi(ya[r][j].y) + bfhi(yc[r][j].y)};
            const float rstd = 1.0f / sqrtf(wave_sum(sumsq4(y)) * (1.0f / DM) + NORM_EPS);
#pragma unroll
            for (int j = 0; j < 4; ++j) { f32x4 o = xr[r][j] + gg[j] * (y[j] * rstd);
#ifdef PROBE_TS
                { const unsigned long long* ts = (const unsigned long long*)(F.ctl + 8192); const float us = (PROBE_TS < 0) ? 250.f : 32.f * floorf((float)(ts[PROBE_TE] - ts[PROBE_TS]) * (0.01f / 32.f) + 0.5f);
                  const float sg = sqrtf(us * 4e-6f * 1.18f); o[0] += sg; o[1] -= sg; o[2] += sg; o[3] -= sg; }
#endif
                *(f32x4*)(F.out + (size_t)m * DM + 256 * j + 4 * lane) = o; } } }
    }
#else
    int curb = -1; f32x4 gt[4];
    for (int m = gw; m < M; m += NGW) {
        const int b = m >> 13;
        if (b != curb) { mod_final(F, b, 5, gt); curb = b;
#pragma unroll
            for (int j = 0; j < 4; ++j) gt[j] = gt[j] * gpost[j]; }
        f32x4 y[4], xr[4]; ld_row4(F.out + (size_t)m * DM, lane, xr);
#pragma unroll
        for (int j = 0; j < 4; ++j) { const u32x2 a = *(const u32x2*)(Y2 + (size_t)(2 * m) * DM + 256 * j + 4 * lane), c = *(const u32x2*)(Y2 + (size_t)(2 * m + 1) * DM + 256 * j + 4 * lane);
            y[j] = (f32x4){bflo(a.x) + bflo(c.x), bfhi(a.x) + bfhi(c.x), bflo(a.y) + bflo(c.y), bfhi(a.y) + bfhi(c.y)}; }
        const float rstd = 1.0f / sqrtf(wave_sum(sumsq4(y)) * (1.0f / DM) + NORM_EPS);
#pragma unroll
        for (int j = 0; j < 4; ++j) { f32x4 o = xr[j] + gt[j] * (y[j] * rstd);
#ifdef PROBE_TS
            { const unsigned long long* ts = (const unsigned long long*)(F.ctl + 8192); const float us = (PROBE_TS < 0) ? 250.f : 32.f * floorf((float)(ts[PROBE_TE] - ts[PROBE_TS]) * (0.01f / 32.f) + 0.5f);
              const float sg = sqrtf(us * 4e-6f * 1.18f); o[0] += sg; o[1] -= sg; o[2] += sg; o[3] -= sg; }
#endif
            *(f32x4*)(F.out + (size_t)m * DM + 256 * j + 4 * lane) = o; }
    }
#endif
}

#ifndef MK_N_LAUNCHES
#define MK_N_LAUNCHES 1
#endif
constexpr int N_PHASES = 11;
struct Args { const float* in[26]; float* out; unsigned char* ws; int ph_lo, ph_hi; };
__global__ void __launch_bounds__(NWAVES * 64, 2) fwd_kernel(Args args) {
    extern __shared__ __attribute__((aligned(16))) unsigned char lds[];
    Frame F;
    F.lds = (LAS unsigned char*)lds;
    F.MISC = (volatile LAS unsigned*)(F.lds + MISC_OFF);
    F.wave = __builtin_amdgcn_readfirstlane((int)(threadIdx.x >> 6)); F.G = gridDim.x;
    F.ws = args.ws; F.ctl = (unsigned*)(args.ws + WS_CTL); F.out = args.out;
    F.x = args.in[0]; F.c = args.in[1]; F.w_ada = args.in[2]; F.b_ada = args.in[3]; F.g_pre_mix = args.in[4]; F.g_post_mix = args.in[5]; F.g_pre_ffn = args.in[6]; F.g_post_ffn = args.in[7];
    F.w_in = args.in[8]; F.b_forget = args.in[9]; F.pe_k = args.in[10]; F.w1_k = args.in[11]; F.w2_k = args.in[12]; F.pe_v = args.in[13]; F.w1_v = args.in[14]; F.w2_v = args.in[15];
    F.w_o_nsa = args.in[16]; F.w_o_fox = args.in[17]; F.w_out = args.in[18]; F.w_rg = args.in[19]; F.b_rg = args.in[20]; F.w_re = args.in[21]; F.b_re = args.in[22];
    F.w_eg = args.in[23]; F.w_eu = args.in[24]; F.w_ed = args.in[25];
    for (int u = F.tid_(); u < 256; u += NWAVES * 64) F.MISC[u] = 0u;
    __syncthreads();
    const int lo = args.ph_lo, hi = args.ph_hi;
    XcdBarrier bar; bar.bar = F.ctl + CW_BAR; bar.x = 0; bar.st = nullptr;
    if (hi - lo > 1) bar = xcd_barrier_post(F.ctl + CW_BAR, F.MISC + 8);
#ifndef PH_MASK
#define PH_MASK 0x7ff
#endif
#define IN(k) (((PH_MASK >> (k)) & 1) && lo <= (k) && (k) < hi)
#ifndef DUP_MASK
#define DUP_MASK 0
#endif
#ifdef PROBE_TS
#define STAMP(k) do { if (blockIdx.x == 0 && F.tid_() == 0) ((unsigned long long*)(F.ctl + 8192))[(k)] = __builtin_amdgcn_s_memrealtime(); } while (0)
#else
#define STAMP(k) do { } while (0)
#endif
#define SEAM(k) do { if (IN(k) && IN((k) + 1)) xcd_barrier(bar); STAMP((k) + 1); } while (0)
#define NREP(k) (1 + ((DUP_MASK >> (k)) & 1))
#define REPBAR(rep) do { if (rep) xcd_barrier(bar); } while (0)
    bf16_t* const HN = (bf16_t*)(F.ws + WS_HN);
    bf16_t* const PROJ = (bf16_t*)(F.ws + WS_PROJ);
    STAMP(0);
    if (IN(0)) { for (int rep = 0; rep < NREP(0); ++rep) { REPBAR(rep); p0_prologue(F); } SEAM(0); }
    if (IN(1)) { for (int rep = 0; rep < NREP(1); ++rep) { REPBAR(rep); p0b_rows(F); } SEAM(1); }
    if (IN(2)) {
        pg8::Gemm g{HN, (const bf16_t*)(F.ws + WS_WINT), M, NPAD, DM}; pg8::StaticOrder S; S.init(M, NPAD, F.G, (int)blockIdx.x);
        EpiProj E{PROJ, (float*)(F.ws + WS_GATES), (float*)(F.ws + WS_LF), F.b_forget};
        for (int rep = 0; rep < NREP(2); ++rep) { REPBAR(rep); pg8::gemm_phase<false>(F.lds, g, S, E, pg8::NoGather{}); }
        SEAM(2);
    }
    if (IN(3)) {
        for (int rep = 0; rep < NREP(3); ++rep) { REPBAR(rep);
        for (int it = blockIdx.x; it < 144; it += F.G) { if (it < 128) p2a_item_cmp(F, it); else p2a_item_cumsum(F, it - 128); } }
        SEAM(3);
    }
    if (IN(4)) {
#ifndef ATT_DUP_KIND
#define ATT_DUP_KIND 3
#endif
        for (int rep = 0; rep < NREP(4); ++rep) { REPBAR(rep);
        for (;;) {
            __syncthreads();
            if (F.tid_() == 0) F.MISC[16] = __hip_atomic_fetch_add(F.ctl + CW_QCTR + 64 * rep, 1u, RLX_AGENT);
            __syncthreads();
            const int idx = (int)F.MISC[16];
            if (idx >= 1024) break;
            const int lev = 31 - (idx >> 5), w = idx & 31;
            if (w < 16) { if (rep == 0 || (ATT_DUP_KIND & 1)) {
#ifdef FOX_SIMPLE
                att::fox_unit(F, w >> 3, w & 7, lev);
#else
                const int fb = w >> 3, fh = w & 7;
                const foxb::bf16* pj = (const foxb::bf16*)(F.ws + WS_PROJ) + (size_t)fb * SEQ * PP + fh * 64;
                const float* fbr = (const float*)(F.ws + WS_FB2) + (size_t)(fb * 8 + fh) * SEQ;
                int jskip = 0;
#ifndef FOX_NOSKIP
                {
                    const float th = ((const float*)(F.ws + WS_ROUTE))[fb * 8 + fh], f0 = fbr[256 * lev];
                    const int ln = F.lane_(), jc = 2 * ln;
                    const bool ok = (ln >= 1) && (jc <= 4 * lev) && (f0 - fbr[64 * jc - 1 + (ln == 0 ? 1 : 0)] > th);
                    const unsigned long long bm = __ballot(ok);
                    if (bm) jskip = 2 * (63 - __builtin_clzll(bm));
                }
#endif
                foxb::fox_unit<8>(lev, jskip, pj + C_FQ, pj + C_FK, pj + C_FV, fbr,
                                  (foxb::bf16*)(F.ws + WS_YY) + 512 + (size_t)fb * SEQ * 1024 + fh * 64, (char*)lds);
#endif
            } }
            else { const int k = w - 16; if (rep == 0 || (ATT_DUP_KIND & 2)) att::nsa_unit(F, (k & 3) >> 1, k & 1, 4 * lev + 3 - (k >> 2)); }
        } }
        SEAM(4);
    }
    if (IN(5)) {
        pg8::Gemm g{(const bf16_t*)(F.ws + WS_YY), (const bf16_t*)(F.ws + WS_WOT), M, DM, DM}; pg8::StaticOrder S; S.init(M, DM, F.G, (int)blockIdx.x);
        EpiOut E{HN, PROJ}; MidGate MG{PROJ};
        pg8::gemm_phase<false>(F.lds, g, S, E, pg8::NoGather{}, MG);
        SEAM(5);
    }
    if (IN(6)) {
        pg8::Gemm g{HN, (const bf16_t*)(F.ws + WS_WOUTT), M, DM, DM}; pg8::StaticOrder S; S.init(M, DM, F.G, (int)blockIdx.x);
        EpiBf E{(bf16_t*)(F.ws + WS_YY), DM};
        pg8::gemm_phase<false>(F.lds, g, S, E, pg8::NoGather{});
        for (int rep = 0; rep < NREP(6); ++rep) { REPBAR(rep); expert_convert(F); }
        SEAM(6);
    }
    if (IN(7)) { __syncthreads(); p3c_rows(F); SEAM(7); }
    if (IN(8) || IN(9)) {
        __syncthreads();
        if (F.tid_() < 32) F.MISC[96 + F.tid_()] = __hip_atomic_load(F.ctl + CW_ECNT + 64 * F.tid_(), RLX_AGENT);
        __syncthreads();
        if (F.tid_() == 0) { unsigned s = 0; for (int e = 0; e < 32; ++e) { F.MISC[32 + e] = s; s += (F.MISC[96 + e] + 255u) >> 8; } F.MISC[64] = s; }
        __syncthreads();
    }
    if (IN(8)) {
        pg8::Gemm g{HN, (const bf16_t*)(F.ws + WS_WGUT), M, 32768, DM}; MoeOrder S{F.MISC + 32, F.G, (int)blockIdx.x};
        EpiSwiglu E{(bf16_t*)(F.ws + WS_HBUF)}; MoeGather GT{(const u32x2*)(F.ws + WS_LIST), F.MISC + 32, F.MISC + 96};
        for (int rep = 0; rep < NREP(8); ++rep) { REPBAR(rep); pg8::gemm_phase<true>(F.lds, g, S, E, GT); }
        SEAM(8);
    }
    if (IN(9)) {
        pg8::Gemm g{(const bf16_t*)(F.ws + WS_HBUF), (const bf16_t*)(F.ws + WS_WDT), HROWS_MAX, 32768, DEXP}; MoeOrder S{F.MISC + 32, F.G, (int)blockIdx.x};
        EpiDown E{(bf16_t*)(F.ws + WS_YY), (const u32x2*)(F.ws + WS_LIST), F.MISC + 32, F.MISC + 96};
        for (int rep = 0; rep < NREP(9); ++rep) { REPBAR(rep); pg8::gemm_phase<false>(F.lds, g, S, E, pg8::NoGather{}); }
        SEAM(9);
    }
    if (IN(10)) { p5_rows(F); }
#undef IN
#undef SEAM
}

extern "C" void kernel_launch(void* const* d_in, const int* in_sizes, int n_in, void* d_out, int out_size, void* d_ws, size_t ws_size, hipStream_t stream) {
    static int grid = 0;
    if (grid == 0) {
        if (n_in != 26 || in_sizes[0] != M * DM || out_size != M * DM || ws_size < WS_END) { fprintf(stderr, "kernel_launch: unexpected shapes (n_in %d, in0 %d, out %d, ws %zu < %zu); nothing launched\n", n_in, n_in > 0 ? in_sizes[0] : -1, out_size, ws_size, (size_t)WS_END); grid = -1; return; }
        int dev = 0, cus = 0, per_cu = 0;
        if (hipGetDevice(&dev) != hipSuccess || hipDeviceGetAttribute(&cus, hipDeviceAttributeMultiprocessorCount, dev) != hipSuccess) { grid = -1; return; }
        if (hipFuncSetAttribute((const void*)fwd_kernel, hipFuncAttributeMaxDynamicSharedMemorySize, LDS_BYTES) != hipSuccess) { fprintf(stderr, "kernel_launch: hipFuncSetAttribute failed\n"); grid = -1; return; }
        if (hipOccupancyMaxActiveBlocksPerMultiprocessor(&per_cu, (const void*)fwd_kernel, NWAVES * 64, LDS_BYTES) != hipSuccess || per_cu < 1) { fprintf(stderr, "kernel_launch: occupancy query failed (%d)\n", per_cu); per_cu = 1; }
        (void)hipGetLastError();
        grid = cus * (per_cu > 1 ? 1 : per_cu);
        if (grid < 128 || grid > 256) { fprintf(stderr, "kernel_launch: built for 128..256 workgroups, got %d; nothing launched\n", grid); grid = -1; return; }
    }
    if (grid < 0) return;
    if (hipMemsetAsync((char*)d_ws + WS_CTL, 0, CTL_ZERO_BYTES, stream) != hipSuccess) { fprintf(stderr, "kernel_launch: memset failed\n"); return; }
    Args a{};
    for (int i = 0; i < 26; ++i) a.in[i] = (const float*)d_in[i];
    a.out = (float*)d_out; a.ws = (unsigned char*)d_ws;
#if MK_N_LAUNCHES == 1
    a.ph_lo = 0; a.ph_hi = N_PHASES;
    void* kargs[] = {&a};
    const hipError_t le = hipLaunchCooperativeKernel((const void*)fwd_kernel, dim3(grid), dim3(NWAVES * 64), kargs, LDS_BYTES, stream);
    if (le != hipSuccess) fprintf(stderr, "kernel_launch: cooperative launch failed: %s (grid %d)\n", hipGetErrorName(le), grid);
#else
    for (int p = 0; p < N_PHASES; ++p) {
        a.ph_lo = p; a.ph_hi = p + 1;
        hipLaunchKernelGGL(fwd_kernel, dim3(grid), dim3(NWAVES * 64), LDS_BYTES, stream, a);
    }
    const hipError_t le = hipPeekAtLastError();
    if (le != hipSuccess) fprintf(stderr, "kernel_launch: launch failed: %s\n", hipGetErrorName(le));
#endif
}
```
